# Optimizing an MI355X kernel written in HIP

```python
import jax
import jax.numpy as jnp
from jax import lax
import numpy as np

D_MODEL = 1024
BATCH = 2
SEQ = 8192
DEPTH = 2

GRID_W = 64
CTX_LEN = 256
MLA_HEADS = 8
MLA_Q_RANK = 384
MLA_KV_RANK = 256
MLA_NOPE = 64
MLA_ROPE = 32
MLA_V = 64
MLA_W = MLA_HEADS * MLA_V
NA_HEADS = 4
NA_HEAD_DIM = 64
NA_W = NA_HEADS * NA_HEAD_DIM
NA_WIN_R = 8
NA_WIN_C = 16
POOL_WINDOWS = (2, 4, 8, 16)
POOL_GROUP = 64
POOL_WIDTH = POOL_GROUP * len(POOL_WINDOWS)
N_EXPERTS = 16
EC_CAPACITY = 2
EXPERT_FF = 2048
N_BRANCH = 3
Q_BLOCK = 128
ROPE_BASE = 10000.0
EPS = 1e-6
IN_SIZES = (MLA_Q_RANK, MLA_KV_RANK, MLA_ROPE, 3 * NA_W, POOL_WIDTH, N_BRANCH * D_MODEL)
D_IN = MLA_Q_RANK + MLA_KV_RANK + MLA_ROPE + 3 * NA_W + POOL_WIDTH + N_BRANCH * D_MODEL

kernel_name = 'hybrid_mla_natten_pool_ecmoe_dit'


def rmsnorm(x, g):
    xf = x.astype(jnp.float32)
    y = xf * lax.rsqrt(jnp.mean(xf * xf, axis=-1, keepdims=True) + EPS)
    return (y * g.astype(jnp.float32)).astype(x.dtype)


def modulate(x, g, shift, scale):
    return rmsnorm(x, g) * (1 + scale) + shift


def split_in(z):
    idx = np.cumsum(IN_SIZES)[:-1].tolist()
    return jnp.split(z, idx, axis=-1)


def axial_rope(x, pos_r, pos_c):
    half = MLA_ROPE // 2
    quarter = half // 2
    inv = ROPE_BASE ** (-jnp.arange(quarter, dtype=jnp.float32) / quarter)

    def rot(xa, pos):
        ang = pos.astype(jnp.float32)[:, None] * inv
        shape = (1, ang.shape[0]) + (1,) * (xa.ndim - 3) + (quarter,)
        cos = jnp.cos(ang).reshape(shape).astype(xa.dtype)
        sin = jnp.sin(ang).reshape(shape).astype(xa.dtype)
        x1, x2 = xa[..., :quarter], xa[..., quarter:]
        return jnp.concatenate([x1 * cos - x2 * sin, x2 * cos + x1 * sin], axis=-1)

    return jnp.concatenate([rot(x[..., :half], pos_r), rot(x[..., half:], pos_c)], axis=-1)


def attend(q, k, v, scale):
    s = jnp.einsum('bqhd,bkhd->bhqk', q, k, preferred_element_type=jnp.float32) * scale
    p = jax.nn.softmax(s, axis=-1).astype(v.dtype)
    return jnp.einsum('bhqk,bkhd->bqhd', p, v)


def blocked_attend(q, k, v, scale):
    B, N, H, dq = q.shape
    qb = q.reshape(B, N // Q_BLOCK, Q_BLOCK, H, dq).transpose(1, 0, 2, 3, 4)
    ob = lax.map(lambda qi: attend(qi, k, v, scale), qb)
    return ob.transpose(1, 0, 2, 3, 4).reshape(B, N, H, v.shape[-1])


def mla_project(cq, ckv, g_q, g_kv, w_uq, w_ukv):
    B, N, _ = cq.shape
    q = (rmsnorm(cq, g_q) @ w_uq).reshape(B, N, MLA_HEADS, MLA_NOPE + MLA_ROPE)
    kv = (rmsnorm(ckv, g_kv) @ w_ukv).reshape(B, N, MLA_HEADS, MLA_NOPE + MLA_V)
    return q[..., :MLA_NOPE], q[..., MLA_NOPE:], kv[..., :MLA_NOPE], kv[..., MLA_NOPE:]


def mla_keys(k_nope, k_rope):
    kr = jnp.broadcast_to(k_rope[:, :, None, :], k_nope.shape[:-1] + (MLA_ROPE,))
    return jnp.concatenate([k_nope, kr], axis=-1)


def na_heads(z):
    B, N, _ = z.shape
    qkv = z.reshape(B, N, 3, NA_HEADS, NA_HEAD_DIM)
    return qkv[:, :, 0], qkv[:, :, 1], qkv[:, :, 2]


def na_latent(q, k, v, k_ctx, v_ctx, rpb):
    B, N, H, d = q.shape
    rows = N // GRID_W
    wr = min(NA_WIN_R, rows)
    r = jnp.arange(rows)
    start_r = jnp.clip(r - wr // 2, 0, rows - wr)
    row_idx = start_r[:, None] + jnp.arange(wr)[None, :]
    cq = jnp.arange(GRID_W)
    start_c = jnp.clip(cq - NA_WIN_C // 2, 0, GRID_W - NA_WIN_C)
    ck = jnp.arange(GRID_W)
    col_mask = (ck[None, :] >= start_c[:, None]) & (ck[None, :] < start_c[:, None] + NA_WIN_C)
    dr = row_idx - r[:, None] + (NA_WIN_R - 1)
    dc = jnp.clip(ck[None, :] - cq[:, None], -(NA_WIN_C - 1), NA_WIN_C - 1) + (NA_WIN_C - 1)
    bias = rpb[:, dr[:, None, :, None], dc[None, :, None, :]].astype(jnp.float32)
    qg = q.reshape(B, rows, GRID_W, H, d)
    kr = k.reshape(B, rows, GRID_W, H, d)[:, row_idx]
    vr = v.reshape(B, rows, GRID_W, H, d)[:, row_idx]
    scale = d ** -0.5
    s_lat = jnp.einsum('brqhd,brwkhd->bhrqwk', qg, kr, preferred_element_type=jnp.float32) * scale + bias[None]
    s_lat = jnp.where(col_mask[:, None, :], s_lat, -jnp.inf)
    s_ctx = jnp.einsum('brqhd,bchd->bhrqc', qg, k_ctx, preferred_element_type=jnp.float32) * scale
    n_lat = wr * GRID_W
    s = jnp.concatenate([s_lat.reshape(B, H, rows, GRID_W, n_lat), s_ctx], axis=-1)
    p = jax.nn.softmax(s, axis=-1).astype(v.dtype)
    p_lat = p[..., :n_lat].reshape(B, H, rows, GRID_W, wr, GRID_W)
    o = jnp.einsum('bhrqwk,brwkhd->brqhd', p_lat, vr) + jnp.einsum('bhrqc,bchd->brqhd', p[..., n_lat:], v_ctx)
    return o.reshape(B, N, H * d)


def pool_mix(u, w_pool, pool_scale):
    B, N, _ = u.shape
    uf = u.astype(jnp.float32)
    cs = jnp.concatenate([jnp.zeros((B, 1, POOL_WIDTH), jnp.float32), lax.cumsum(uf, axis=1)], axis=1)
    t = jnp.arange(N)
    outs = []
    for gi, w in enumerate(POOL_WINDOWS):
        lo = jnp.clip(t - w // 2, 0, N)
        hi = jnp.clip(t + w // 2, 0, N)
        csg = cs[..., gi * POOL_GROUP:(gi + 1) * POOL_GROUP]
        mean = (csg[:, hi] - csg[:, lo]) / (hi - lo).astype(jnp.float32)[None, :, None]
        outs.append(mean - uf[..., gi * POOL_GROUP:(gi + 1) * POOL_GROUP])
    dlt = jnp.stack(outs, axis=2).astype(u.dtype)
    y = jnp.einsum('bngc,gce->bnge', dlt, w_pool).reshape(B, N, POOL_WIDTH)
    return y * pool_scale


def merge(z_gate, a, b, p, w_br_mla, w_br_na, w_br_pool, w_out):
    B, N, _ = a.shape
    g = jax.nn.sigmoid(z_gate.astype(jnp.float32)).astype(a.dtype).reshape(B, N, N_BRANCH, D_MODEL)
    m = g[:, :, 0] * (a @ w_br_mla) + g[:, :, 1] * (b @ w_br_na) + g[:, :, 2] * (p @ w_br_pool)
    return m @ w_out


def ec_moe(h, w_router, w_gate, w_up, w_down):
    B, N, _ = h.shape
    cap = EC_CAPACITY * N // N_EXPERTS
    aff = jax.nn.softmax(jnp.einsum('bnd,de->bne', h, w_router, preferred_element_type=jnp.float32), axis=-1)
    gval, idx = lax.top_k(aff.transpose(0, 2, 1), cap)
    bidx = jnp.arange(B)[:, None, None]
    xs = h[bidx, idx]
    a = jnp.einsum('becd,edf->becf', xs, w_gate)
    u = jnp.einsum('becd,edf->becf', xs, w_up)
    y = jnp.einsum('becf,efd->becd', jax.nn.silu(a) * u, w_down)
    y = y * gval[..., None].astype(y.dtype)
    return jnp.zeros_like(h).at[bidx, idx].add(y)


def setup_inputs(seed: int = 0) -> dict:
    key = jax.random.key(seed)
    ks = jax.random.split(key, 26)
    f32 = jnp.float32

    def nrm(k, shape, scale):
        return jax.random.normal(k, shape, f32) * scale

    L, D, E, F = DEPTH, D_MODEL, N_EXPERTS, EXPERT_FF
    return {
        'x': nrm(ks[0], (BATCH, SEQ, D), 1.0),
        'c': nrm(ks[1], (BATCH, D), 1.0),
        'ctx': nrm(ks[2], (BATCH, CTX_LEN, D), 1.0),
        'c_ctx': nrm(ks[3], (D,), 1.0),
        'norm1_g': 1.0 + nrm(ks[4], (L, D), 0.02),
        'norm2_g': 1.0 + nrm(ks[5], (L, D), 0.02),
        'w_ada': nrm(ks[6], (L, D, 6 * D), 0.5 * D ** -0.5),
        'b_ada': nrm(ks[7], (L, 6 * D), 0.02),
        'w_in': nrm(ks[8], (L, D, D_IN), D ** -0.5),
        'mla_q_norm': 1.0 + nrm(ks[9], (L, MLA_Q_RANK), 0.02),
        'mla_kv_norm': 1.0 + nrm(ks[10], (L, MLA_KV_RANK), 0.02),
        'w_uq': nrm(ks[11], (L, MLA_Q_RANK, MLA_HEADS * (MLA_NOPE + MLA_ROPE)), MLA_Q_RANK ** -0.5),
        'w_ukv': nrm(ks[12], (L, MLA_KV_RANK, MLA_HEADS * (MLA_NOPE + MLA_V)), MLA_KV_RANK ** -0.5),
        'na_rpb': nrm(ks[13], (L, NA_HEADS, 2 * NA_WIN_R - 1, 2 * NA_WIN_C - 1), 0.1),
        'w_pool': nrm(ks[14], (L, len(POOL_WINDOWS), POOL_GROUP, POOL_GROUP), POOL_GROUP ** -0.5),
        'pool_scale': 1.0 + nrm(ks[15], (L, POOL_WIDTH), 0.1),
        'w_br_mla': nrm(ks[16], (L, MLA_W, D), MLA_W ** -0.5),
        'w_br_na': nrm(ks[17], (L, NA_W, D), NA_W ** -0.5),
        'w_br_pool': nrm(ks[18], (L, POOL_WIDTH, D), POOL_WIDTH ** -0.5),
        'w_out': nrm(ks[19], (L, D, D), D ** -0.5),
        'w_router': nrm(ks[20], (L, D, E), D ** -0.5),
        'w_gate': nrm(ks[21], (L, E, D, F), D ** -0.5),
        'w_up': nrm(ks[22], (L, E, D, F), D ** -0.5),
        'w_down': nrm(ks[23], (L, E, F, D), F ** -0.5),
        'final_g': 1.0 + nrm(ks[24], (D,), 0.02),
    }


def reference(x, c, ctx, c_ctx, norm1_g, norm2_g, w_ada, b_ada, w_in, mla_q_norm, mla_kv_norm, w_uq, w_ukv,
              na_rpb, w_pool, pool_scale, w_br_mla, w_br_na, w_br_pool, w_out, w_router, w_gate, w_up, w_down,
              final_g):
    B, N, _ = x.shape
    t = jnp.arange(N)
    pos_r = t // GRID_W
    pos_c = t % GRID_W
    mla_scale = (MLA_NOPE + MLA_ROPE) ** -0.5
    na_scale = NA_HEAD_DIM ** -0.5
    xl, xc = x, ctx
    for l in range(DEPTH):
        last = l == DEPTH - 1
        mod_l = (jax.nn.silu(c) @ w_ada[l] + b_ada[l])[:, None, :]
        mod_c = (jax.nn.silu(c_ctx) @ w_ada[l] + b_ada[l])[None, None, :]
        sh1l, sc1l, g1l, sh2l, sc2l, g2l = jnp.split(mod_l, 6, axis=-1)
        sh1c, sc1c, g1c, sh2c, sc2c, g2c = jnp.split(mod_c, 6, axis=-1)

        hl = modulate(xl, norm1_g[l], sh1l, sc1l)
        hc = modulate(xc, norm1_g[l], sh1c, sc1c)
        cq_l, ckv_l, kr_l, na_l, pool_l, gate_l = split_in(hl @ w_in[l])
        cq_c, ckv_c, kr_c, na_c, pool_c, gate_c = split_in(hc @ w_in[l])

        qn_l, qr_l, kn_l, v_l = mla_project(cq_l, ckv_l, mla_q_norm[l], mla_kv_norm[l], w_uq[l], w_ukv[l])
        qn_c, qr_c, kn_c, v_c = mla_project(cq_c, ckv_c, mla_q_norm[l], mla_kv_norm[l], w_uq[l], w_ukv[l])
        q_l = jnp.concatenate([qn_l, axial_rope(qr_l, pos_r, pos_c)], axis=-1)
        k_l = mla_keys(kn_l, axial_rope(kr_l, pos_r, pos_c))
        k_c = mla_keys(kn_c, kr_c)
        a_l = blocked_attend(q_l, jnp.concatenate([k_c, k_l], axis=1), jnp.concatenate([v_c, v_l], axis=1),
                             mla_scale).reshape(B, N, MLA_W)

        nq_l, nk_l, nv_l = na_heads(na_l)
        nq_c, nk_c, nv_c = na_heads(na_c)
        b_l = na_latent(nq_l, nk_l, nv_l, nk_c, nv_c, na_rpb[l])

        p_l = pool_mix(pool_l, w_pool[l], pool_scale[l])

        xl = xl + g1l * merge(gate_l, a_l, b_l, p_l, w_br_mla[l], w_br_na[l], w_br_pool[l], w_out[l])
        if not last:
            q_c = jnp.concatenate([qn_c, qr_c], axis=-1)
            a_c = attend(q_c, k_c, v_c, mla_scale).reshape(B, -1, MLA_W)
            b_c = attend(nq_c, nk_c, nv_c, na_scale).reshape(B, -1, NA_W)
            p_c = pool_mix(pool_c, w_pool[l], pool_scale[l])
            xc = xc + g1c * merge(gate_c, a_c, b_c, p_c, w_br_mla[l], w_br_na[l], w_br_pool[l], w_out[l])

        xl = xl + g2l * ec_moe(modulate(xl, norm2_g[l], sh2l, sc2l), w_router[l], w_gate[l], w_up[l], w_down[l])
        if not last:
            xc = xc + g2c * ec_moe(modulate(xc, norm2_g[l], sh2c, sc2c), w_router[l], w_gate[l], w_up[l], w_down[l])
    return rmsnorm(xl, final_g)
```

```cpp
#include <hip/hip_runtime.h>
#include <hip/hip_cooperative_groups.h>
#include <cstdio>
#include <cstdint>
namespace cg = cooperative_groups;
#ifndef MLA_ILV
#define MLA_ILV 1
#endif
#ifndef PG_ALIGN
#define PG_ALIGN 1
#endif
#ifndef PG_SP2
#define PG_SP2 1
#endif
#ifndef MLA_V2
#define MLA_V2 1
#endif

constexpr int D = 1024, NB = 2, SEQ = 8192, DEPTH = 2, GW = 64, CTX = 256;
constexpr int TL = NB * SEQ;
constexpr int T = TL + NB * CTX;
constexpr int QR = 384, KVR = 256, ROPE = 32, NAW = 256, PW = 256;
constexpr int DIN = 4768;
constexpr int ZW = 4864;
constexpr int Z_CQ = 0, Z_CKV = 384, Z_NA = 640, Z_POOL = 1408, Z_GATE = 1664, Z_KR = 4736;
constexpr int MH = 8, QKD = 96, VD = 64, QW = MH * QKD  , AW = MH * VD  , KVW = MH * 128  ;
constexpr int NKEY = CTX + SEQ;
constexpr int NE = 16, FF = 2048, CAPL = 1024, CAPC = 32;
constexpr int ER = 2304;
constexpr int ERV = 2112;
constexpr float EPS = 1e-6f;
constexpr int NT = 512;

constexpr size_t MiB = 1u << 20;
constexpr size_t WS_MOD = 0;
constexpr size_t WS_ROPE = 512 * 1024;
constexpr size_t WS_RS = 1 * MiB;
constexpr size_t WS_AFF = 2 * MiB;
constexpr size_t WS_SLOT = 4 * MiB;
constexpr size_t WS_GVX = 6 * MiB;
constexpr size_t WS_SEL = 6 * MiB + 512 * 1024;
constexpr size_t WS_CTL = 7 * MiB;
constexpr size_t CTL_BYTES = 65536;
constexpr size_t WS_H = 8 * MiB;
constexpr size_t WS_XA = 42 * MiB;
constexpr size_t WS_Z = 108 * MiB;
constexpr size_t WS_ACT = WS_Z;
constexpr size_t WS_Q = 265 * MiB;
constexpr size_t WS_KB = 290 * MiB;
constexpr size_t WS_VB = 315 * MiB;
constexpr size_t WS_ABP = 332 * MiB;
constexpr size_t WS_XS = 265 * MiB;
constexpr size_t WS_M = 366 * MiB;
constexpr size_t WS_TMP = 400 * MiB;
constexpr size_t WS_Y = 366 * MiB;
constexpr size_t WS_SLAB = 440 * MiB;
constexpr size_t WS_W = 466 * MiB;
constexpr size_t WS_END = 880 * MiB;

typedef unsigned short bf16;
__device__ __forceinline__ bf16 f2bf(float f) { unsigned u = __float_as_uint(f); u += 0x7fffu + ((u >> 16) & 1u); return (bf16)(u >> 16); }
__device__ __forceinline__ float bf2f(bf16 b) { return __uint_as_float(((unsigned)b) << 16); }
__device__ __forceinline__ float sigmoidf_(float x) { return 1.f / (1.f + __expf(-x)); }
__device__ __forceinline__ float siluf_(float x) { return x / (1.f + __expf(-x)); }
__device__ __forceinline__ float wave_sum(float v) {
#pragma unroll
    for (int o = 1; o < 64; o <<= 1) v += __shfl_xor(v, o);
    return v;
}

struct Params {
    const float* in[25];
    float* out;
    unsigned char* ws;
};
enum { I_X = 0, I_C, I_CTX, I_CCTX, I_N1G, I_N2G, I_WADA, I_BADA, I_WIN, I_QNORM, I_KVNORM, I_WUQ, I_WUKV, I_RPB, I_WPOOL, I_PSCALE,
       I_WBRM, I_WBRN, I_WBRP, I_WOUT, I_WROUTER, I_WGATE, I_WUP, I_WDOWN, I_FINALG };

__device__ __forceinline__ int row_set(int r) { return r < TL ? (r >> 13) : 2 + ((r - TL) >> 8); }
__device__ __forceinline__ int row_modv(int r) { return r < TL ? (r >> 13) : 2; }
__device__ __forceinline__ int row_krow(int r) { return r < TL ? ((r >> 13) * NKEY + CTX + (r & 8191)) : (((r - TL) >> 8) * NKEY + ((r - TL) & 255)); }

__device__ __forceinline__ int otid() { int t = threadIdx.x; asm volatile("" : "+v"(t)); return t; }
__device__ __forceinline__ int oblk() { int b = blockIdx.x; asm volatile("" : "+s"(b)); return b; }
#define GTID ((long)blockIdx.x * NT + tid)
#define GTOT ((long)gridDim.x * NT)
#define GWAVE ((int)(blockIdx.x * (NT / 64) + (tid >> 6)))
#define GNW ((int)(gridDim.x * (NT / 64)))

__device__ __forceinline__ void ph_mod(const Params& p, unsigned char* lds_) {
    const int tid = otid();
    float* mod = (float*)(p.ws + WS_MOD);
    { float* sc = (float*)lds_;
      float* part = sc + 3 * D;
      const int lane = tid & 63, wid = tid >> 6;
      for (int i = tid; i < 3 * D; i += NT) { const int v = i >> 10, k = i & 1023; sc[i] = siluf_(v < 2 ? p.in[I_C][v * D + k] : p.in[I_CCTX][k]); }
      __syncthreads();
      for (int task = blockIdx.x; task < 2 * 96; task += gridDim.x) {
          const int l = task / 96, col = (task % 96) * 64 + lane;
          const float* w = p.in[I_WADA] + (size_t)l * D * 6144 + (size_t)(wid * 128) * 6144 + col;
          float s0 = 0.f, s1 = 0.f, s2 = 0.f;
#pragma unroll 16
          for (int k = 0; k < 128; ++k) { const float wv = w[(size_t)k * 6144]; const int kk = wid * 128 + k; s0 += sc[kk] * wv; s1 += sc[D + kk] * wv; s2 += sc[2 * D + kk] * wv; }
          part[(wid * 3 + 0) * 64 + lane] = s0; part[(wid * 3 + 1) * 64 + lane] = s1; part[(wid * 3 + 2) * 64 + lane] = s2;
          __syncthreads();
          if (tid < 192) { const int v = tid >> 6; float a = p.in[I_BADA][l * 6144 + (task % 96) * 64 + lane];
#pragma unroll
              for (int w8 = 0; w8 < 8; ++w8) a += part[(w8 * 3 + v) * 64 + lane];
              mod[(size_t)(l * 3 + v) * 6144 + (task % 96) * 64 + lane] = a; }
          __syncthreads();
      } }
    float* rope = (float*)(p.ws + WS_ROPE);
    for (long o = GTID; o < (128 + 64) * 8; o += GTOT) {
        int i = (int)(o & 7), pos = (int)(o >> 3); if (pos >= 128) pos -= 128;
        const float inv[8] = {1.0f, 0.316227766f, 0.1f, 0.0316227766f, 0.01f, 0.00316227766f, 0.001f, 0.000316227766f};
        float invv = i == 0 ? inv[0] : i == 1 ? inv[1] : i == 2 ? inv[2] : i == 3 ? inv[3] : i == 4 ? inv[4] : i == 5 ? inv[5] : i == 6 ? inv[6] : inv[7];
        float angf = (float)pos * invv;
        double a = (double)angf;
        double n = rint(a * 0.15915494309189535);
        double r = a - n * 6.283185307179586476925;
        double q = r * 0.25, q2 = q * q;
        double sn = q * (1.0 + q2 * (-1.0 / 6 + q2 * (1.0 / 120 + q2 * (-1.0 / 5040 + q2 * (1.0 / 362880 + q2 * (-1.0 / 39916800 + q2 * (1.0 / 6227020800.0)))))));
        double cs = 1.0 + q2 * (-0.5 + q2 * (1.0 / 24 + q2 * (-1.0 / 720 + q2 * (1.0 / 40320 + q2 * (-1.0 / 3628800 + q2 * (1.0 / 479001600.0 + q2 * (-1.0 / 87178291200.0)))))));
        double s2 = 2 * sn * cs, c2 = 2 * cs * cs - 1;
        double s4 = 2 * s2 * c2, c4 = 2 * c2 * c2 - 1;
        rope[o * 2] = (float)c4; rope[o * 2 + 1] = (float)s4;
    }
}

__device__ __forceinline__ void load_row4(const float* xr, int lane, float4 (&x)[4]) {
#pragma unroll
    for (int j = 0; j < 4; ++j) x[j] = *(const float4*)(xr + 4 * lane + 256 * j);
}
__device__ __forceinline__ void modulate_vals(const float4 (&x)[4], const float* g, const float* sh, const float* sc, int lane, float (&v)[16]) {
    float ss = 0.f;
#pragma unroll
    for (int j = 0; j < 4; ++j) { const float4 t = x[j]; v[4 * j] = t.x; v[4 * j + 1] = t.y; v[4 * j + 2] = t.z; v[4 * j + 3] = t.w; ss += t.x * t.x + t.y * t.y + t.z * t.z + t.w * t.w; }
    ss = wave_sum(ss);
    const float rs = rsqrtf(ss * (1.f / D) + EPS);
#pragma unroll
    for (int j = 0; j < 4; ++j) {
        const float4 gg = *(const float4*)(g + 4 * lane + 256 * j), s1 = *(const float4*)(sc + 4 * lane + 256 * j), s0 = *(const float4*)(sh + 4 * lane + 256 * j);
        v[4 * j] = v[4 * j] * rs * gg.x * (1.f + s1.x) + s0.x; v[4 * j + 1] = v[4 * j + 1] * rs * gg.y * (1.f + s1.y) + s0.y;
        v[4 * j + 2] = v[4 * j + 2] * rs * gg.z * (1.f + s1.z) + s0.z; v[4 * j + 3] = v[4 * j + 3] * rs * gg.w * (1.f + s1.w) + s0.w;
    }
}
__device__ __forceinline__ void modulate_row(const float* xr, const float* g, const float* sh, const float* sc, int lane, float (&v)[16]) {
    float4 x[4]; load_row4(xr, lane, x); modulate_vals(x, g, sh, sc, lane, v);
}
__device__ __forceinline__ void store_row_bf16(bf16* orow, int lane, const float (&v)[16]) {
#pragma unroll
    for (int j = 0; j < 4; ++j) {
        uint2 w; w.x = (unsigned)f2bf(v[4 * j]) | ((unsigned)f2bf(v[4 * j + 1]) << 16); w.y = (unsigned)f2bf(v[4 * j + 2]) | ((unsigned)f2bf(v[4 * j + 3]) << 16);
        *(uint2*)(orow + 4 * lane + 256 * j) = w;
    }
}
__device__ __forceinline__ const float* src_row(const Params& p, int l, int r) {
    if (l == 0) return r < TL ? p.in[I_X] + (size_t)r * D : p.in[I_CTX] + (size_t)(r - TL) * D;
    return (const float*)(p.ws + WS_XA) + (size_t)r * D;
}
__device__ __forceinline__ void ph_h1(const Params& p, int l) {
    const int tid = otid();
    const float* mod = (const float*)(p.ws + WS_MOD) + (size_t)l * 3 * 6144;
    bf16* h = (bf16*)(p.ws + WS_H);
    const int lane = tid & 63;
    float4 cur[4]; if (GWAVE < T) load_row4(src_row(p, l, GWAVE), lane, cur);
    for (int r = GWAVE; r < T; r += GNW) {
        float4 nx[4]; const int rn = r + GNW; if (rn < T) load_row4(src_row(p, l, rn), lane, nx);
        const float* mv = mod + row_modv(r) * 6144;
        float v[16]; modulate_vals(cur, p.in[I_N1G] + l * D, mv + 0 * D, mv + 1 * D, lane, v);
#pragma unroll
        for (int j = 0; j < 4; ++j) cur[j] = nx[j];
        store_row_bf16(h + (size_t)r * D, lane, v);
    }
}
__device__ __forceinline__ void rope_pair(const float* rope, int r, int d  , float xa, float xb  , float& out) {
    const int t = r & 8191, pos = (d < 16) ? (t >> 6) : 128 + (t & 63);
    const float cs = rope[(pos * 8 + (d & 7)) * 2], sn = rope[(pos * 8 + (d & 7)) * 2 + 1];
    out = (d & 8) ? (xa * cs + xb * sn) : (xa * cs - xb * sn);
}
__device__ __forceinline__ void ph_h2router(const Params& p, int l, unsigned char* lds_) {
    const int tid = otid();
    const float* mod = (const float*)(p.ws + WS_MOD) + (size_t)l * 3 * 6144; const float* xa = (const float*)(p.ws + WS_XA);
    bf16* h = (bf16*)(p.ws + WS_H); float* aff = (float*)(p.ws + WS_AFF); const float* wr = p.in[I_WROUTER] + (size_t)l * D * NE;
    const int lane = tid & 63;
    float* wrT = (float*)lds_;
    __syncthreads();
    for (int i = tid; i < D * NE; i += NT) { const int k = i >> 4, e = i & 15; wrT[e * D + k] = wr[i]; }
    __syncthreads();
    float4 cur[4]; if (GWAVE < T) load_row4(xa + (size_t)GWAVE * D, lane, cur);
    for (int r = GWAVE; r < T; r += GNW) {
        float4 nx[4]; const int rn = r + GNW; if (rn < T) load_row4(xa + (size_t)rn * D, lane, nx);
        const float* mv = mod + row_modv(r) * 6144;
        if (r >= TL && l != DEPTH - 1 && gridDim.x == 256) {
            const float* cin = p.in[I_CTX] + (size_t)(r - TL) * D; const float* sp = (const float*)(p.ws + WS_SLAB) + (size_t)(r - TL) * D; float* xw = (float*)(p.ws + WS_XA) + (size_t)r * D;
#pragma unroll
            for (int j = 0; j < 4; ++j) { const int c = 4 * lane + 256 * j; const float4 a = *(const float4*)(cin + c), g = *(const float4*)(mv + 2 * D + c);
                const float4 s0 = *(const float4*)(sp + c), s1 = *(const float4*)(sp + (size_t)512 * D + c), s2 = *(const float4*)(sp + (size_t)2 * 512 * D + c), s3 = *(const float4*)(sp + (size_t)3 * 512 * D + c);
                float4 t; t.x = a.x + g.x * (((s0.x + s1.x) + s2.x) + s3.x); t.y = a.y + g.y * (((s0.y + s1.y) + s2.y) + s3.y); t.z = a.z + g.z * (((s0.z + s1.z) + s2.z) + s3.z); t.w = a.w + g.w * (((s0.w + s1.w) + s2.w) + s3.w);
                cur[j] = t; *(float4*)(xw + c) = t; } }
        float v[16]; modulate_vals(cur, p.in[I_N2G] + l * D, mv + 3 * D, mv + 4 * D, lane, v);
#pragma unroll
        for (int j = 0; j < 4; ++j) cur[j] = nx[j];
        store_row_bf16(h + (size_t)r * D, lane, v);
        float lg[NE];
        const float* wl = wrT + 4 * lane; asm volatile("" : "+v"(wl));
#pragma unroll
        for (int e = 0; e < NE; ++e) { float a = 0.f;
#pragma unroll
            for (int j = 0; j < 4; ++j) { const float4 w4 = *(const float4*)(wl + e * D + 256 * j); a += v[4 * j] * w4.x + v[4 * j + 1] * w4.y + v[4 * j + 2] * w4.z + v[4 * j + 3] * w4.w; }
            lg[e] = a; }
        float r1[8], r2[4], r3[2], r4;
        { const bool up = lane & 32;
#pragma unroll
          for (int i = 0; i < 8; ++i) { const float snd = up ? lg[i] : lg[8 + i]; const float keep = up ? lg[8 + i] : lg[i]; r1[i] = keep + __shfl_xor(snd, 32); } }
        { const bool up = lane & 16;
#pragma unroll
          for (int i = 0; i < 4; ++i) { const float snd = up ? r1[i] : r1[4 + i]; const float keep = up ? r1[4 + i] : r1[i]; r2[i] = keep + __shfl_xor(snd, 16); } }
        { const bool up = lane & 8;
#pragma unroll
          for (int i = 0; i < 2; ++i) { const float snd = up ? r2[i] : r2[2 + i]; const float keep = up ? r2[2 + i] : r2[i]; r3[i] = keep + __shfl_xor(snd, 8); } }
        { const bool up = lane & 4; const float snd = up ? r3[0] : r3[1]; const float keep = up ? r3[1] : r3[0]; r4 = keep + __shfl_xor(snd, 4); }
        r4 += __shfl_xor(r4, 2); r4 += __shfl_xor(r4, 1);
        float mx = r4;
#pragma unroll
        for (int o = 4; o < 64; o <<= 1) mx = fmaxf(mx, __shfl_xor(mx, o));
        const float ex = expf(r4 - mx); float sum = ex;
#pragma unroll
        for (int o = 4; o < 64; o <<= 1) sum += __shfl_xor(sum, o);
        if ((lane & 3) == 0) aff[(size_t)r * NE + (lane >> 2)] = ex / sum;
    }
}
__device__ __forceinline__ void ph_topk(const Params& p, unsigned char* lds) {
    const int tid = otid();
    const float* aff = (const float*)(p.ws + WS_AFF); int* slotm = (int*)(p.ws + WS_SLOT); float* gvx = (float*)(p.ws + WS_GVX); int* selrow = (int*)(p.ws + WS_SEL);
    const int lane = tid & 63, wid = tid >> 6;
    unsigned* keys = (unsigned*)lds;
    unsigned* hist = keys + 8192;
    unsigned* wtot = hist + 256;
    unsigned* ctl = wtot + 8;
    for (int prob = blockIdx.x; prob < 64; prob += gridDim.x) {
        const int s = prob >> 4, e = prob & 15;
        const int N = s < 2 ? SEQ : CTX, cap = N / 8, row0 = s < 2 ? s * SEQ : TL + (s - 2) * CTX, base = s < 2 ? s * CAPL : 2 * CAPL + (s - 2) * CAPC;
        __syncthreads();
        for (int i = tid; i < N; i += NT) keys[i] = __float_as_uint(aff[(size_t)(row0 + i) * NE + e]);
        unsigned prefix = 0, mask = 0; int remaining = cap;
        for (int pass = 3; pass >= 0; --pass) {
            const int shift = pass * 8;
            if (tid < 256) hist[tid] = 0;
            __syncthreads();
            for (int i = tid; i < N; i += NT) { const unsigned k = keys[i]; if ((k & mask) == prefix) atomicAdd(&hist[(k >> shift) & 255], 1u); }
            __syncthreads();
            if (wid == 0) {
                const unsigned h0 = hist[4 * lane], h1 = hist[4 * lane + 1], h2 = hist[4 * lane + 2], h3 = hist[4 * lane + 3], tot = h0 + h1 + h2 + h3;
                unsigned inc = tot;
#pragma unroll
                for (int o = 1; o < 64; o <<= 1) { const unsigned t = __shfl_down(inc, o); if (lane + o < 64) inc += t; }
                const unsigned above = inc - tot, rem = (unsigned)remaining;
                if (above < rem && rem <= above + tot) { unsigned r = rem - above; int b;
                    if (h3 >= r) b = 3; else { r -= h3; if (h2 >= r) b = 2; else { r -= h2; if (h1 >= r) b = 1; else { r -= h1; b = 0; } } }
                    ctl[0] = (unsigned)(4 * lane + b); ctl[1] = r; }
            }
            __syncthreads();
            prefix |= ctl[0] << shift; mask |= 255u << shift; remaining = (int)ctl[1];
            __syncthreads();
        }
        const unsigned Tk = prefix; const int need = remaining;
        const int CH = N >= NT ? N / NT : 1; const bool act = tid * CH < N;
        unsigned cnt = 0;
        if (act) for (int j = 0; j < CH; ++j) { const unsigned k = keys[tid * CH + j]; cnt += (k > Tk ? 1u : 0u) + (k == Tk ? 65536u : 0u); }
        unsigned inc = cnt;
#pragma unroll
        for (int o = 1; o < 64; o <<= 1) { const unsigned t = __shfl_up(inc, o); if (lane >= o) inc += t; }
        if (lane == 63) wtot[wid] = inc;
        __syncthreads();
        unsigned off = 0; for (int w = 0; w < wid; ++w) off += wtot[w];
        unsigned excl = off + inc - cnt;
        int gtb = (int)(excl & 0xffffu), eqb = (int)(excl >> 16);
        if (act) for (int j = 0; j < CH; ++j) {
            const int i = tid * CH + j; const unsigned k = keys[i]; const int row = row0 + i; int er = -1;
            if (k > Tk) { er = base + gtb + (eqb < need ? eqb : need); ++gtb; }
            else if (k == Tk) { if (eqb < need) er = base + gtb + eqb; ++eqb; }
            slotm[(size_t)row * NE + e] = er;
            if (er >= 0) { gvx[e * ER + er] = __uint_as_float(k); selrow[e * ER + er] = row; }
        }
    }
    if (blockIdx.x >= 64 || gridDim.x <= 64) {
        const int nb = gridDim.x > 64 ? gridDim.x - 64 : gridDim.x, bi = gridDim.x > 64 ? blockIdx.x - 64 : blockIdx.x;
        for (int i = bi * NT + tid; i < NE * (ER - ERV); i += nb * NT) { const int e = i / (ER - ERV), r = ERV + i % (ER - ERV); gvx[e * ER + r] = 0.f; selrow[e * ER + r] = 0; }
    }
}
__device__ __forceinline__ void ph_combine(const Params& p, int l) {
    const int tid = otid();
    const float* modl = (const float*)(p.ws + WS_MOD) + (size_t)l * 3 * 6144;
    float* xa = (float*)(p.ws + WS_XA); const int* slotm = (const int*)(p.ws + WS_SLOT); const bf16* y = (const bf16*)(p.ws + WS_Y); bf16* h = (bf16*)(p.ws + WS_H);
    const int lane = tid & 63; const bool last = (l == DEPTH - 1); const int RN = last ? TL : T;
    float4 cur[4]; int scur = -1;
    if (GWAVE < RN) { load_row4(xa + (size_t)GWAVE * D, lane, cur); scur = slotm[(size_t)GWAVE * NE + (lane & 15)]; }
    for (int r = GWAVE; r < RN; r += GNW) {
        float4 nx[4]; int snx = -1; const int rn = r + GNW;
        if (rn < RN) { load_row4(xa + (size_t)rn * D, lane, nx); snx = slotm[(size_t)rn * NE + (lane & 15)]; }
        const float* g2 = modl + row_modv(r) * 6144 + 5 * D;
        float acc[16];
#pragma unroll
        for (int j = 0; j < 16; ++j) acc[j] = 0.f;
        const bool fromslab = (r >= TL) && !last && gridDim.x == 256;
#pragma unroll
        for (int e = 0; e < NE; ++e) {
            const int er = __builtin_amdgcn_readlane(scur, e);
            if (er >= 0) {
                if (fromslab) {
#pragma unroll
                    for (int q = 0; q < 4; ++q) { const float* sp = (const float*)(p.ws + WS_SLAB) + (((size_t)q * NE + e) * 64 + (er - 2 * CAPL)) * D;
#pragma unroll
                        for (int j = 0; j < 4; ++j) { const float4 w = *(const float4*)(sp + 4 * lane + 256 * j); acc[4 * j] += w.x; acc[4 * j + 1] += w.y; acc[4 * j + 2] += w.z; acc[4 * j + 3] += w.w; } }
                } else { const bf16* yr = y + ((size_t)e * ER + er) * D;
#pragma unroll
                for (int j = 0; j < 4; ++j) { const uint2 w = *(const uint2*)(yr + 4 * lane + 256 * j);
                    acc[4 * j] += bf2f((bf16)(w.x & 0xffff)); acc[4 * j + 1] += bf2f((bf16)(w.x >> 16)); acc[4 * j + 2] += bf2f((bf16)(w.y & 0xffff)); acc[4 * j + 3] += bf2f((bf16)(w.y >> 16)); } }
            }
        }
        float v[16]; float ss = 0.f;
        float* xr = xa + (size_t)r * D;
#pragma unroll
        for (int j = 0; j < 4; ++j) { const float4 t = cur[j], g = *(const float4*)(g2 + 4 * lane + 256 * j);
            v[4 * j] = t.x + g.x * acc[4 * j]; v[4 * j + 1] = t.y + g.y * acc[4 * j + 1]; v[4 * j + 2] = t.z + g.z * acc[4 * j + 2]; v[4 * j + 3] = t.w + g.w * acc[4 * j + 3];
            ss += v[4 * j] * v[4 * j] + v[4 * j + 1] * v[4 * j + 1] + v[4 * j + 2] * v[4 * j + 2] + v[4 * j + 3] * v[4 * j + 3]; }
        ss = wave_sum(ss); const float rs = rsqrtf(ss * (1.f / D) + EPS);
        if (last) {
            const float* fg = p.in[I_FINALG]; float* orow = p.out + (size_t)r * D;
#pragma unroll
            for (int j = 0; j < 4; ++j) { const float4 g = *(const float4*)(fg + 4 * lane + 256 * j);
                *(float4*)(orow + 4 * lane + 256 * j) = make_float4(v[4 * j] * rs * g.x, v[4 * j + 1] * rs * g.y, v[4 * j + 2] * rs * g.z, v[4 * j + 3] * rs * g.w); }
        } else {
#pragma unroll
            for (int j = 0; j < 4; ++j) *(float4*)(xr + 4 * lane + 256 * j) = make_float4(v[4 * j], v[4 * j + 1], v[4 * j + 2], v[4 * j + 3]);
            const float* mn = (const float*)(p.ws + WS_MOD) + (size_t)(l + 1) * 3 * 6144 + row_modv(r) * 6144; const float* g1n = p.in[I_N1G] + (l + 1) * D;
            float hv[16];
#pragma unroll
            for (int j = 0; j < 4; ++j) { const float4 gg = *(const float4*)(g1n + 4 * lane + 256 * j), s1 = *(const float4*)(mn + D + 4 * lane + 256 * j), s0 = *(const float4*)(mn + 4 * lane + 256 * j);
                hv[4 * j] = v[4 * j] * rs * gg.x * (1.f + s1.x) + s0.x; hv[4 * j + 1] = v[4 * j + 1] * rs * gg.y * (1.f + s1.y) + s0.y;
                hv[4 * j + 2] = v[4 * j + 2] * rs * gg.z * (1.f + s1.z) + s0.z; hv[4 * j + 3] = v[4 * j + 3] * rs * gg.w * (1.f + s1.w) + s0.w; }
            store_row_bf16(h + (size_t)r * D, lane, hv);
        }
#pragma unroll
        for (int j = 0; j < 4; ++j) cur[j] = nx[j];
        scur = snx;
    }
}


constexpr size_t WL_IN = 0;
constexpr size_t WL_UQ = WL_IN + (size_t)ZW * D;
constexpr size_t WL_UKV = WL_UQ + (size_t)QW * QR;
constexpr size_t WL_CAT = WL_UKV + (size_t)KVW * KVR;
constexpr size_t WL_OUT = WL_CAT + (size_t)D * D;
constexpr size_t WL_POOL = WL_OUT + (size_t)D * D;
constexpr size_t WL_GU = WL_POOL + 4 * 64 * 64;
constexpr size_t WL_DN = WL_GU + (size_t)NE * 2 * FF * D;
constexpr size_t WL_SIZE = WL_DN + (size_t)NE * D * FF;
static_assert(WS_W + 2 * WL_SIZE * 2 <= WS_END, "weight region");
__device__ __forceinline__ bf16* wl_ptr(const Params& p, int l, size_t off) { return (bf16*)(p.ws + WS_W) + (size_t)l * WL_SIZE + off; }

#define LAS __attribute__((address_space(3)))
struct CvtJob { const float* W; int K, N; bf16* dst; int dstride, koff, map; const float* kscale; };
constexpr int CVT_PER_LAYER = 1200 + 72 + 64 + 128 + 64 + 64 + 256 + 4 + 3 * 8192;
__device__ __forceinline__ void cvt_decode(const Params& p, int it, CvtJob& j, int& item) {
    const int l = it / CVT_PER_LAYER; int r = it % CVT_PER_LAYER;
    j.koff = 0; j.map = 0; j.kscale = nullptr;
    if (r < 1200) { j.W = p.in[I_WIN] + (size_t)l * D * DIN; j.K = D; j.N = DIN; j.dst = wl_ptr(p, l, WL_IN); j.dstride = D; j.map = 1; item = r; return; } r -= 1200;
    if (r < 72) { j.W = p.in[I_WUQ] + (size_t)l * QR * QW; j.K = QR; j.N = QW; j.dst = wl_ptr(p, l, WL_UQ); j.dstride = QR; j.kscale = p.in[I_QNORM] + l * QR; item = r; return; } r -= 72;
    if (r < 64) { j.W = p.in[I_WUKV] + (size_t)l * KVR * KVW; j.K = KVR; j.N = KVW; j.dst = wl_ptr(p, l, WL_UKV); j.dstride = KVR; j.kscale = p.in[I_KVNORM] + l * KVR; item = r; return; } r -= 64;
    if (r < 128) { j.W = p.in[I_WBRM] + (size_t)l * 512 * D; j.K = 512; j.N = D; j.dst = wl_ptr(p, l, WL_CAT); j.dstride = D; item = r; return; } r -= 128;
    if (r < 64) { j.W = p.in[I_WBRN] + (size_t)l * 256 * D; j.K = 256; j.N = D; j.dst = wl_ptr(p, l, WL_CAT); j.dstride = D; j.koff = 512; item = r; return; } r -= 64;
    if (r < 64) { j.W = p.in[I_WBRP] + (size_t)l * 256 * D; j.K = 256; j.N = D; j.dst = wl_ptr(p, l, WL_CAT); j.dstride = D; j.koff = 768; item = r; return; } r -= 64;
    if (r < 256) { j.W = p.in[I_WOUT] + (size_t)l * D * D; j.K = D; j.N = D; j.dst = wl_ptr(p, l, WL_OUT); j.dstride = D; item = r; return; } r -= 256;
    if (r < 4) { j.W = p.in[I_WPOOL] + ((size_t)l * 4 + r) * 4096; j.K = 64; j.N = 64; j.dst = wl_ptr(p, l, WL_POOL) + r * 4096; j.dstride = 64; item = 0; return; } r -= 4;
    const int which = r / 8192, rr = r % 8192, e = rr / 512; item = rr % 512;
    if (which == 0) { j.W = p.in[I_WGATE] + (size_t)(l * NE + e) * D * FF; j.K = D; j.N = FF; j.dst = wl_ptr(p, l, WL_GU) + (size_t)e * 2 * FF * D; j.dstride = D; j.map = 2; }
    else if (which == 1) { j.W = p.in[I_WUP] + (size_t)(l * NE + e) * D * FF; j.K = D; j.N = FF; j.dst = wl_ptr(p, l, WL_GU) + (size_t)e * 2 * FF * D; j.dstride = D; j.map = 3; }
    else { j.W = p.in[I_WDOWN] + (size_t)(l * NE + e) * FF * D; j.K = FF; j.N = D; j.dst = wl_ptr(p, l, WL_DN) + (size_t)e * D * FF; j.dstride = FF; }
}
__device__ __forceinline__ int cvt_maprow(int map, int n) {
    if (map == 0) return n;
    if (map == 1) { if (n < 640) return n; if (n < 672) return Z_KR + (n - 640); if (n < 1440) return Z_NA + (n - 672); if (n < 1696) return Z_POOL + (n - 1440); return Z_GATE + (n - 1696); }
    return 256 * (n >> 7) + (n & 127) + (map == 3 ? 128 : 0);
}
__device__ __forceinline__ void ph_cvt(const Params& p, unsigned char* lds_) {
    const int tid = otid();
    LAS float* scr = (LAS float*)lds_ + (tid >> 6) * (64 * 65);
    const int lane = tid & 63;
    const bool moe_in_attn = MLA_V2 && gridDim.x == 256;
    for (int it = GWAVE; it < 2 * CVT_PER_LAYER; it += GNW) {
        if (moe_in_attn && (it % CVT_PER_LAYER) >= CVT_PER_LAYER - 3 * 8192) continue;
        CvtJob j; int item; cvt_decode(p, it, j, item);
        const int nblk = (j.N + 63) / 64, kb = item / nblk, nb = item % nblk, k0 = kb * 64, n0 = nb * 64;
        const int rr = lane >> 4, c4 = lane & 15;
        const bool nv = n0 + 4 * c4 < j.N;
        const float* src = j.W + (size_t)(k0 + rr) * j.N + n0 + 4 * c4;
#pragma unroll
        for (int i = 0; i < 16; ++i) { float4 v = nv ? *(const float4*)(src + (size_t)(4 * i) * j.N) : make_float4(0.f, 0.f, 0.f, 0.f);
            if (j.kscale) { const float ks = j.kscale[k0 + 4 * i + rr]; v.x *= ks; v.y *= ks; v.z *= ks; v.w *= ks; }
            LAS float* d = scr + (4 * i + rr) * 65 + 4 * c4; d[0] = v.x; d[1] = v.y; d[2] = v.z; d[3] = v.w; }
        asm volatile("s_waitcnt lgkmcnt(0)" ::: "memory");
        const int c = lane & 7;
#pragma unroll
        for (int jj = 0; jj < 8; ++jj) {
            const int n = (lane >> 3) + 8 * jj; const LAS float* sp = scr + (8 * c) * 65 + n;
            uint4 o; o.x = (unsigned)f2bf(sp[0]) | ((unsigned)f2bf(sp[65]) << 16); o.y = (unsigned)f2bf(sp[2 * 65]) | ((unsigned)f2bf(sp[3 * 65]) << 16);
            o.z = (unsigned)f2bf(sp[4 * 65]) | ((unsigned)f2bf(sp[5 * 65]) << 16); o.w = (unsigned)f2bf(sp[6 * 65]) | ((unsigned)f2bf(sp[7 * 65]) << 16);
            if (n0 + n < j.N) *(uint4*)(j.dst + (size_t)cvt_maprow(j.map, n0 + n) * j.dstride + j.koff + k0 + 8 * c) = o;
        }
        asm volatile("s_waitcnt lgkmcnt(0)" ::: "memory");
    }
}

namespace pg {
typedef short bf16x8 __attribute__((ext_vector_type(8)));
typedef float f32x4 __attribute__((ext_vector_type(4)));
typedef unsigned u32x4 __attribute__((ext_vector_type(4)));
constexpr int BM = 256, BK = 64, HALF = 128, HTB = HALF * BK * 2, STAGE_BYTES = 8 * HTB, NXCD = 8;
__host__ __device__ __forceinline__ int lds_byte(int r, int c) { const int st = (r >> 4) * 2 + (c >> 5), rr = r & 15, cc = c & 31, ob = rr * 64 + cc * 2; return st * 1024 + (ob ^ (((ob >> 9) & 1) << 5)); }
__host__ __device__ __forceinline__ void stage_rc(int b, int& R, int& C) { const int st = b / 1024, sb = b % 1024, swz = sb ^ (((sb >> 9) & 1) << 5); R = (st >> 1) * 16 + swz / 64; C = (st & 1) * 32 + (swz % 64) / 2; }
__host__ __device__ __forceinline__ int perm32(int rho) { const int n = rho >> 4, i = rho & 15; return 8 * (i >> 2) + 4 * n + (i & 3); }
__device__ __forceinline__ unsigned cvt_pk_bf16(float lo, float hi) { unsigned r; asm volatile("v_cvt_pk_bf16_f32 %0, %1, %2" : "=v"(r) : "v"(lo), "v"(hi)); return r; }

struct GUnit { const char* A; const char* B; unsigned lda, ldb; int nt, pm, pn, aux, ord; };

struct GridOrder {
    int nM, nN, G, c, WGM;
    __device__ __forceinline__ bool tile(int i, int& pm, int& pn) const {
        const int nwg = nM * nN; const long L = (long)i * G + c; if (L >= nwg) return false;
        int wgid = (int)L; { const int q = nwg / NXCD, r = nwg % NXCD, xcd = wgid % NXCD, off = wgid / NXCD; wgid = (xcd < r ? xcd * (q + 1) : r * (q + 1) + (xcd - r) * q) + off; }
        const int nig = WGM * nN, gid = wgid / nig, fm = gid * WGM, gsz = (nM - fm) < WGM ? (nM - fm) : WGM;
        pm = fm + ((wgid % nig) % gsz); pn = (wgid % nig) / gsz; return true;
    }
};

template <class Epi, class Sched>
__device__ __forceinline__ void gemm_phase(LAS unsigned char* lds, const Sched& S, const Epi& E) {
    const int tid = otid(), wid = __builtin_amdgcn_readfirstlane(tid >> 6), lane = tid & 63, wr = wid >> 2, wc = wid & 3, fr = lane & 15, fq = lane >> 4;
    int R_, C_; stage_rc(tid * 16, R_, C_); const int Rb_ = Epi::PERM ? ((R_ & ~31) + perm32(R_ & 31)) : R_;
    const unsigned ldsw = (unsigned)wid * 1024u;
    const int aoff = lds_byte(wr * 64 + fr, fq * 8), boff = lds_byte(wc * 32 + fr, fq * 8);
    const size_t kstep = (size_t)(BK * 2);
#define PG_SA(b, h) (((b) * 2 + (h)) * HTB)
#define PG_SB(b, h) ((4 + (b) * 2 + (h)) * HTB)
#define PG_STAGE(bufoff, gbase, voff, q64) do { \
        __builtin_amdgcn_global_load_lds((const unsigned*)((const char*)(gbase) + (voff)), (LAS unsigned*)(lds + (bufoff) + ldsw), 16, 0, 0); \
        __builtin_amdgcn_global_load_lds((const unsigned*)((const char*)(gbase) + (q64) + (voff)), (LAS unsigned*)(lds + (bufoff) + ldsw + 8192), 16, 0, 0); } while (0)
#define PG_STAGE_A(bufoff, kbase, hh, VV, QQ, GG) do { if constexpr (Sched::GATHER) { \
        __builtin_amdgcn_global_load_lds((const unsigned*)((const char*)(kbase) + (GG)[hh][0]), (LAS unsigned*)(lds + (bufoff) + ldsw), 16, 0, 0); \
        __builtin_amdgcn_global_load_lds((const unsigned*)((const char*)(kbase) + (GG)[hh][1]), (LAS unsigned*)(lds + (bufoff) + ldsw + 8192), 16, 0, 0); } \
        else { PG_STAGE(bufoff, (const char*)(kbase) + (hh) * 2 * (QQ), VV, QQ); } } while (0)
#define PG_LDGATHER(GG, U) do { if constexpr (Sched::GATHER) { _Pragma("unroll") for (int hh = 0; hh < 2; ++hh) _Pragma("unroll") for (int ii = 0; ii < 2; ++ii) \
        (GG)[hh][ii] = (unsigned)S.seltab[(U).ord * 256 + hh * 128 + R_ + 64 * ii] * (U).lda + (unsigned)C_ * 2u; } } while (0)
#define PG_LDA(dst, b, h) do { _Pragma("unroll") for (int m = 0; m < 4; ++m) _Pragma("unroll") for (int k = 0; k < 2; ++k) dst[m][k] = *(const LAS bf16x8*)(lds + PG_SA(b, h) + aoff + m * 2048 + k * 1024); } while (0)
#define PG_LDB(dst, b, h) do { _Pragma("unroll") for (int n = 0; n < 2; ++n) _Pragma("unroll") for (int k = 0; k < 2; ++k) dst[n][k] = *(const LAS bf16x8*)(lds + PG_SB(b, h) + boff + n * 2048 + k * 1024); } while (0)
#define PG_MMA(ai, bj, At, Bt) do { __builtin_amdgcn_s_setprio(1); _Pragma("unroll") for (int m = 0; m < 4; ++m) _Pragma("unroll") for (int n = 0; n < 2; ++n) _Pragma("unroll") for (int k = 0; k < 2; ++k) \
        acc[ai][bj][m][n] = __builtin_amdgcn_mfma_f32_16x16x32_bf16(Bt[n][k], At[m][k], acc[ai][bj][m][n], 0, 0, 0); __builtin_amdgcn_s_setprio(0); } while (0)
#define PG_WAIT_V(n) asm volatile("s_waitcnt vmcnt(" #n ")" ::: "memory")
#define PG_WAIT_L(n) asm volatile("s_waitcnt lgkmcnt(" #n ")" ::: "memory")
#define PG_BAR __builtin_amdgcn_s_barrier()
#define PG_SCHED __builtin_amdgcn_sched_barrier(0)
    GUnit cur, nxt; int ui = 0;
    if (!S.next(0, cur)) return;
    f32x4 acc[2][2][4][2];
#pragma unroll
    for (int a = 0; a < 2; ++a)
#pragma unroll
        for (int b = 0; b < 2; ++b)
#pragma unroll
            for (int m = 0; m < 4; ++m)
#pragma unroll
                for (int n = 0; n < 2; ++n) acc[a][b][m][n] = (f32x4){0.f, 0.f, 0.f, 0.f};
    bf16x8 At[4][2], B0[2][2], B1[2][2];
    const char* cA = cur.A; const char* cB = cur.B;
    unsigned vA = (unsigned)R_ * cur.lda + (unsigned)C_ * 2u, vB = (unsigned)Rb_ * cur.ldb + (unsigned)C_ * 2u;
    size_t qA = (size_t)64 * cur.lda, qB = (size_t)64 * cur.ldb, hA = 2 * qA, hB = 2 * qB;
    unsigned gA[2][2] = {{0u, 0u}, {0u, 0u}}, ngA[2][2] = {{0u, 0u}, {0u, 0u}}; PG_LDGATHER(gA, cur);
#if PG_SP2
    PG_STAGE(PG_SB(0, 0), cB, vB, qB); PG_STAGE(PG_SB(0, 1), cB + hB, vB, qB); PG_STAGE_A(PG_SA(0, 0), cA, 0, vA, qA, gA); PG_STAGE_A(PG_SA(0, 1), cA, 1, vA, qA, gA);
    if (wr == 1) PG_BAR;
    PG_WAIT_V(2); PG_BAR;
    PG_STAGE(PG_SB(1, 0), cB + kstep, vB, qB); PG_STAGE_A(PG_SA(1, 0), cA + kstep, 0, vA, qA, gA); PG_STAGE(PG_SB(1, 1), cB + hB + kstep, vB, qB);
    PG_WAIT_V(6); PG_BAR;
#else
    PG_STAGE(PG_SB(0, 0), cB, vB, qB); PG_STAGE_A(PG_SA(0, 0), cA, 0, vA, qA, gA); PG_STAGE(PG_SB(0, 1), cB + hB, vB, qB); PG_STAGE_A(PG_SA(0, 1), cA, 1, vA, qA, gA);
    if (wr == 1) PG_BAR;
    PG_WAIT_V(4); PG_BAR;
    PG_STAGE(PG_SB(1, 0), cB + kstep, vB, qB); PG_STAGE_A(PG_SA(1, 0), cA + kstep, 0, vA, qA, gA); PG_STAGE(PG_SB(1, 1), cB + hB + kstep, vB, qB);
    PG_WAIT_V(6); PG_BAR;
#endif
    for (;;) {
        const bool has_next = S.next(ui + 1, nxt);
        const char* nA = has_next ? nxt.A : cA; const char* nB = has_next ? nxt.B : cB;
        const unsigned nvA = has_next ? (unsigned)R_ * nxt.lda + (unsigned)C_ * 2u : vA, nvB = has_next ? (unsigned)Rb_ * nxt.ldb + (unsigned)C_ * 2u : vB;
        const size_t nqA = has_next ? (size_t)64 * nxt.lda : qA, nqB = has_next ? (size_t)64 * nxt.ldb : qB;
        if (has_next) PG_LDGATHER(ngA, nxt);
        const int nt = cur.nt;
        for (int t = 0; t < nt; t += 2) {
            if constexpr (Epi::SEG) E.seg(acc, cur, t, wr, wc, fr, fq);
            const bool last = (t == nt - 2);
            const char* a1 = cA + (size_t)(t + 1) * kstep;
            const char* a2 = last ? nA : cA + (size_t)(t + 2) * kstep; const char* b2 = last ? nB : cB + (size_t)(t + 2) * kstep;
            const char* a3 = a2 + kstep; const char* b3 = b2 + kstep;
            unsigned gA2[2][2];
#pragma unroll
            for (int hh = 0; hh < 2; ++hh)
#pragma unroll
                for (int ii = 0; ii < 2; ++ii) gA2[hh][ii] = (last && has_next) ? ngA[hh][ii] : gA[hh][ii];
            const unsigned vA2 = last ? nvA : vA, vB2 = last ? nvB : vB; const size_t qA2 = last ? nqA : qA, qB2 = last ? nqB : qB, hA2 = 2 * qA2, hB2 = 2 * qB2;
#if PG_SP2
            PG_LDB(B0, 0, 0); PG_LDB(B1, 0, 1); PG_SCHED; PG_LDA(At, 0, 0); PG_STAGE_A(PG_SA(1, 1), a1, 1, vA, qA, gA);
            PG_WAIT_V(8); PG_WAIT_L(0); PG_BAR; PG_MMA(0, 0, At, B0); PG_MMA(0, 1, At, B1); PG_BAR; PG_SCHED;
            PG_LDA(At, 0, 1); PG_STAGE(PG_SB(0, 0), b2, vB2, qB2); PG_STAGE(PG_SB(0, 1), b2 + hB2, vB2, qB2); PG_STAGE_A(PG_SA(0, 0), a2, 0, vA2, qA2, gA2);
            PG_WAIT_V(8); PG_WAIT_L(0); PG_BAR; PG_MMA(1, 0, At, B0); PG_MMA(1, 1, At, B1); PG_BAR; PG_SCHED;
            PG_LDB(B0, 1, 0); PG_LDB(B1, 1, 1); PG_SCHED; PG_LDA(At, 1, 0); PG_STAGE_A(PG_SA(0, 1), a2, 1, vA2, qA2, gA2);
            PG_WAIT_V(8); PG_WAIT_L(0); PG_BAR; PG_MMA(0, 0, At, B0); PG_MMA(0, 1, At, B1); PG_BAR; PG_SCHED;
            PG_LDA(At, 1, 1); PG_STAGE(PG_SB(1, 0), b3, vB2, qB2); PG_STAGE(PG_SB(1, 1), b3 + hB2, vB2, qB2); PG_STAGE_A(PG_SA(1, 0), a3, 0, vA2, qA2, gA2);
            PG_WAIT_V(8); PG_WAIT_L(0); PG_BAR; PG_MMA(1, 0, At, B0); PG_MMA(1, 1, At, B1); PG_BAR; PG_SCHED;
#else
            PG_LDB(B0, 0, 0); PG_SCHED; PG_LDA(At, 0, 0); PG_STAGE_A(PG_SA(1, 1), a1, 1, vA, qA, gA);
            PG_WAIT_L(8); PG_BAR; PG_WAIT_L(0); PG_MMA(0, 0, At, B0); PG_BAR; PG_SCHED;
            PG_LDB(B1, 0, 1); PG_STAGE(PG_SB(0, 0), b2, vB2, qB2);
            PG_BAR; PG_WAIT_L(0); PG_MMA(0, 1, At, B1); PG_BAR;
            PG_LDA(At, 0, 1); PG_STAGE_A(PG_SA(0, 0), a2, 0, vA2, qA2, gA2);
            PG_BAR; PG_WAIT_L(0); PG_MMA(1, 0, At, B0); PG_BAR; PG_SCHED;
            PG_STAGE(PG_SB(0, 1), b2 + hB2, vB2, qB2);
            PG_WAIT_V(6); PG_BAR; PG_MMA(1, 1, At, B1); PG_BAR;
            PG_LDB(B0, 1, 0); PG_SCHED; PG_LDA(At, 1, 0); PG_STAGE_A(PG_SA(0, 1), a2, 1, vA2, qA2, gA2);
            PG_WAIT_L(8); PG_BAR; PG_WAIT_L(0); PG_MMA(0, 0, At, B0); PG_BAR; PG_SCHED;
            PG_LDB(B1, 1, 1); PG_STAGE(PG_SB(1, 0), b3, vB2, qB2);
            PG_BAR; PG_WAIT_L(0); PG_MMA(0, 1, At, B1); PG_BAR;
            PG_LDA(At, 1, 1); PG_STAGE_A(PG_SA(1, 0), a3, 0, vA2, qA2, gA2);
            PG_BAR; PG_WAIT_L(0); PG_MMA(1, 0, At, B0); PG_BAR; PG_SCHED;
            PG_STAGE(PG_SB(1, 1), b3 + hB2, vB2, qB2);
            PG_WAIT_V(6); PG_BAR; PG_MMA(1, 1, At, B1); PG_BAR;
#endif
        }
#if PG_ALIGN
        if (wr == 0) PG_BAR;
#endif
        E(acc, cur, wr, wc, fr, fq);
        if (!has_next) break;
#pragma unroll
        for (int a = 0; a < 2; ++a)
#pragma unroll
            for (int b = 0; b < 2; ++b)
#pragma unroll
                for (int m = 0; m < 4; ++m)
#pragma unroll
                    for (int n = 0; n < 2; ++n) acc[a][b][m][n] = (f32x4){0.f, 0.f, 0.f, 0.f};
#pragma unroll
        for (int hh = 0; hh < 2; ++hh)
#pragma unroll
            for (int ii = 0; ii < 2; ++ii) gA[hh][ii] = ngA[hh][ii];
        cur = nxt; cA = nA; cB = nB; vA = nvA; vB = nvB; qA = nqA; qB = nqB; hA = 2 * qA; hB = 2 * qB; ++ui;
#if PG_ALIGN
        if (wr == 1) PG_BAR;
#endif
    }
    PG_WAIT_V(0);
#if !PG_ALIGN
    if (wr == 0) PG_BAR;
#endif
    PG_BAR;
#undef PG_SA
#undef PG_SB
#undef PG_STAGE
#undef PG_STAGE_A
#undef PG_LDGATHER
#undef PG_LDA
#undef PG_LDB
#undef PG_MMA
#undef PG_WAIT_V
#undef PG_WAIT_L
#undef PG_BAR
#undef PG_SCHED
}
typedef f32x4 Acc[2][2][4][2];
__device__ __forceinline__ u32x4 pack8(const f32x4 a, const f32x4 b) { u32x4 w; w.x = cvt_pk_bf16(a[0], a[1]); w.y = cvt_pk_bf16(a[2], a[3]); w.z = cvt_pk_bf16(b[0], b[1]); w.w = cvt_pk_bf16(b[2], b[3]); return w; }
__device__ __forceinline__ float fsig(float x) { return __builtin_amdgcn_rcpf(1.f + __expf(-x)); }

struct SchedSimple {
    static constexpr bool GATHER = false; GridOrder o; const char* A; const char* B; unsigned lda, ldb; int nt;
    __device__ __forceinline__ bool next(int i, GUnit& u) const { int pm, pn; if (!o.tile(i, pm, pn)) return false; u.A = A + (size_t)pm * 256 * lda; u.B = B + (size_t)pn * 256 * ldb; u.lda = lda; u.ldb = ldb; u.nt = nt; u.pm = pm; u.pn = pn; u.aux = 0; u.ord = i; return true; }
};
struct EpiInproj { static constexpr bool PERM = true, SEG = false; bf16* z;
    __device__ __forceinline__ void operator()(const Acc& acc, const GUnit& u, int wr, int wc, int fr, int fq) const {
        asm volatile("" : "+v"(fr), "+v"(fq));
        const int row0 = u.pm * BM + wr * 64 + fr;
#pragma unroll
        for (int bj = 0; bj < 2; ++bj) { const int colb = u.pn * BM + bj * HALF; const bool sig = colb >= Z_GATE && colb < Z_KR; const int col0 = colb + wc * 32 + 8 * fq;
#pragma unroll
            for (int ai = 0; ai < 2; ++ai)
#pragma unroll
                for (int m = 0; m < 4; ++m) { f32x4 v0 = acc[ai][bj][m][0], v1 = acc[ai][bj][m][1];
                    if (sig) {
#pragma unroll
                        for (int j = 0; j < 4; ++j) { v0[j] = fsig(v0[j]); v1[j] = fsig(v1[j]); } }
                    *(u32x4*)(z + (size_t)(row0 + ai * HALF + m * 16) * ZW + col0) = pack8(v0, v1); } }
    }
};
struct SchedMla { static constexpr bool GATHER = false; int G, c; const char* z; const char* wq; const char* wkv;
    __device__ __forceinline__ bool next(int i, GUnit& u) const {
        const int L = i * G + c; constexpr int NKV = 66 * 4, NQ = 66 * 3; if (L >= NKV + NQ) return false;
        u.ord = i; u.lda = ZW * 2;
        if (L < NKV) { u.pm = L >> 2; u.pn = L & 3; u.aux = 1; u.A = z + (size_t)u.pm * 256 * ZW * 2 + Z_CKV * 2; u.B = wkv + (size_t)u.pn * 256 * KVR * 2; u.ldb = KVR * 2; u.nt = KVR / 64; }
        else { const int q = L - NKV; u.pm = q / 3; u.pn = q % 3; u.aux = 0; u.A = z + (size_t)u.pm * 256 * ZW * 2 + Z_CQ * 2; u.B = wq + (size_t)u.pn * 256 * QR * 2; u.ldb = QR * 2; u.nt = QR / 64; }
        return true; }
};
struct EpiMla { static constexpr bool PERM = true, SEG = false; bf16* q; bf16* Kb; bf16* Vb; const float* rope; const LAS float* rstab;
    __device__ __forceinline__ void operator()(const Acc& acc, const GUnit& u, int wr, int wc, int fr, int fq) const {
        asm volatile("" : "+v"(fr), "+v"(fq));
        const LAS float* rs = rstab + u.ord * 256;
        if (u.aux == 0) {
#pragma unroll
            for (int bj = 0; bj < 2; ++bj) { const int cb = u.pn * BM + bj * HALF + wc * 32; const bool isrope = (cb % QKD) == 64 && u.pm < 64; const int col0 = cb + 8 * fq;
#pragma unroll
                for (int ai = 0; ai < 2; ++ai)
#pragma unroll
                    for (int m = 0; m < 4; ++m) { const int rl = ai * HALF + wr * 64 + m * 16 + fr, row = u.pm * BM + rl; const float sc = rs[rl] * 0.14724444896f;
                        f32x4 v0 = acc[ai][bj][m][0] * sc, v1 = acc[ai][bj][m][1] * sc;
                        if (isrope) { const int t = row & 8191, pos = fq < 2 ? (t >> 6) : 128 + (t & 63); const f32x4* rp = (const f32x4*)(rope + pos * 16); const float sgn = (fq & 1) ? 1.f : -1.f;
                            const f32x4 t0 = rp[0], t1 = rp[1], t2 = rp[2], t3 = rp[3];
                            f32x4 p0, p1;
#pragma unroll
                            for (int j = 0; j < 4; ++j) { p0[j] = __shfl_xor(v0[j], 16) * sgn; p1[j] = __shfl_xor(v1[j], 16) * sgn; }
                            v0[0] = v0[0] * t0[0] + p0[0] * t0[1]; v0[1] = v0[1] * t0[2] + p0[1] * t0[3]; v0[2] = v0[2] * t1[0] + p0[2] * t1[1]; v0[3] = v0[3] * t1[2] + p0[3] * t1[3];
                            v1[0] = v1[0] * t2[0] + p1[0] * t2[1]; v1[1] = v1[1] * t2[2] + p1[1] * t2[3]; v1[2] = v1[2] * t3[0] + p1[2] * t3[1]; v1[3] = v1[3] * t3[2] + p1[3] * t3[3]; }
                        *(u32x4*)(q + (size_t)row * QW + col0) = pack8(v0, v1); asm volatile("" ::: "memory"); } }
        } else {
#pragma unroll
            for (int bj = 0; bj < 2; ++bj) { const int head = 2 * u.pn + bj;
#pragma unroll
                for (int ai = 0; ai < 2; ++ai)
#pragma unroll
                    for (int m = 0; m < 4; ++m) { const int rl = ai * HALF + wr * 64 + m * 16 + fr, row = u.pm * BM + rl; const float sc = rs[rl]; const size_t kr = (size_t)row_krow(row);
                        const u32x4 w = pack8(acc[ai][bj][m][0] * sc, acc[ai][bj][m][1] * sc);
                        if (wc < 2) *(u32x4*)(Kb + kr * QW + head * QKD + wc * 32 + 8 * fq) = w; else *(u32x4*)(Vb + kr * AW + head * VD + (wc - 2) * 32 + 8 * fq) = w; asm volatile("" ::: "memory"); } }
        }
    }
};
struct EpiMerge { static constexpr bool PERM = true, SEG = true; const bf16* z; bf16* mo;
    __device__ __forceinline__ f32x4 lo4(const u32x4 w) const { return (f32x4){__uint_as_float(w.x << 16), __uint_as_float(w.x & 0xffff0000u), __uint_as_float(w.y << 16), __uint_as_float(w.y & 0xffff0000u)}; }
    __device__ __forceinline__ f32x4 hi4(const u32x4 w) const { return (f32x4){__uint_as_float(w.z << 16), __uint_as_float(w.z & 0xffff0000u), __uint_as_float(w.w << 16), __uint_as_float(w.w & 0xffff0000u)}; }
    __device__ __forceinline__ void seg(Acc& acc, const GUnit& u, int t, int wr, int wc, int fr, int fq) const {
        if (t != 8 && t != 12) return;
        asm volatile("" : "+v"(fr), "+v"(fq));
        const int br = (t == 8) ? 0 : 1; const int row0 = u.pm * BM + wr * 64 + fr;
#pragma unroll
        for (int bj = 0; bj < 2; ++bj) { const int col0 = u.pn * BM + bj * HALF + wc * 32 + 8 * fq;
#pragma unroll
            for (int ai = 0; ai < 2; ++ai) {
                u32x4 ga[4], gb[4];
#pragma unroll
                for (int m = 0; m < 4; ++m) { const bf16* zp = z + (size_t)(row0 + ai * HALF + m * 16) * ZW + Z_GATE + br * D + col0; ga[m] = *(const u32x4*)zp; gb[m] = *(const u32x4*)(zp + D); }
#pragma unroll
                for (int m = 0; m < 4; ++m) { const f32x4 a0 = lo4(ga[m]), a1 = hi4(ga[m]), b0 = lo4(gb[m]), b1 = hi4(gb[m]);
#pragma unroll
                    for (int j = 0; j < 4; ++j) { acc[ai][bj][m][0][j] *= a0[j] * __builtin_amdgcn_rcpf(b0[j]); acc[ai][bj][m][1][j] *= a1[j] * __builtin_amdgcn_rcpf(b1[j]); } }
                asm volatile("" : "+v"(acc[ai][bj][0][0]), "+v"(acc[ai][bj][1][0]), "+v"(acc[ai][bj][2][0]), "+v"(acc[ai][bj][3][0]) :: "memory"); } }
    }
    __device__ __forceinline__ void operator()(const Acc& acc, const GUnit& u, int wr, int wc, int fr, int fq) const {
        asm volatile("" : "+v"(fr), "+v"(fq));
        const int row0 = u.pm * BM + wr * 64 + fr;
#pragma unroll
        for (int bj = 0; bj < 2; ++bj) { const int col0 = u.pn * BM + bj * HALF + wc * 32 + 8 * fq;
#pragma unroll
            for (int ai = 0; ai < 2; ++ai) {
                u32x4 g[4];
#pragma unroll
                for (int m = 0; m < 4; ++m) g[m] = *(const u32x4*)(z + (size_t)(row0 + ai * HALF + m * 16) * ZW + Z_GATE + 2 * D + col0);
#pragma unroll
                for (int m = 0; m < 4; ++m) *(u32x4*)(mo + (size_t)(row0 + ai * HALF + m * 16) * D + col0) = pack8(acc[ai][bj][m][0] * lo4(g[m]), acc[ai][bj][m][1] * hi4(g[m]));
                asm volatile("" ::: "memory"); } }
    }
};
struct SchedOut { static constexpr bool GATHER = false; const int* sel; const LAS int* seltab; GridOrder o; int ksplit; const char* A; const char* B; unsigned lda, ldb; int nt;
    __device__ __forceinline__ bool next(int i, GUnit& u) const { int pm, pn; u.lda = lda; u.ldb = ldb; u.ord = i;
        if (o.tile(i, pm, pn)) { u.A = A + (size_t)pm * 256 * lda; u.B = B + (size_t)pn * 256 * ldb; u.nt = nt; u.pm = pm; u.pn = pn; u.aux = 0; return true; }
        if (!ksplit) return false;
        const long L = (long)i * o.G + o.c - (long)o.nM * o.nN; if (L < 0 || L >= 32) return false;
        const int tile = (int)L >> 2, q = (int)L & 3, pmc = 64 + (tile >> 2), pnc = tile & 3;
        u.A = A + (size_t)pmc * 256 * lda + (size_t)q * 512; u.B = B + (size_t)pnc * 256 * ldb + (size_t)q * 512; u.nt = 4; u.pm = pmc; u.pn = pnc; u.aux = 16 + q; return true; }
};
struct EpiOut { static constexpr bool PERM = false, SEG = false; const float* x; const float* ctx; const float* xa_in; float* xa; const float* mod; int l; float* slab;
    __device__ __forceinline__ void operator()(const Acc& acc, const GUnit& u, int wr, int wc, int fr, int fq) const {
        asm volatile("" : "+v"(fr), "+v"(fq));
        if (u.aux >= 16) {
            const int rowc = (u.pm - 64) * BM + wr * 64 + fr, col0q = u.pn * BM + wc * 32 + 4 * fq; float* sp = slab + (size_t)(u.aux - 16) * 512 * D;
#pragma unroll
            for (int ai = 0; ai < 2; ++ai)
#pragma unroll
                for (int m = 0; m < 4; ++m)
#pragma unroll
                    for (int bj = 0; bj < 2; ++bj)
#pragma unroll
                        for (int n = 0; n < 2; ++n) *(f32x4*)(sp + (size_t)(rowc + ai * HALF + m * 16) * D + col0q + bj * HALF + n * 16) = acc[ai][bj][m][n];
            return; }
        const int row0 = u.pm * BM + wr * 64 + fr, col0 = u.pn * BM + wc * 32 + 4 * fq; const float* g1 = mod + (u.pm < 32 ? 0 : (u.pm < 64 ? 1 : 2)) * 6144 + 2 * D;
        f32x4 gv[2][2];
#pragma unroll
        for (int bj = 0; bj < 2; ++bj)
#pragma unroll
            for (int n = 0; n < 2; ++n) gv[bj][n] = *(const f32x4*)(g1 + col0 + bj * HALF + n * 16);
#pragma unroll
        for (int ai = 0; ai < 2; ++ai)
#pragma unroll
            for (int m = 0; m < 4; ++m) { const int row = row0 + ai * HALF + m * 16;
                const float* src = l == 0 ? (row < TL ? x + (size_t)row * D : ctx + (size_t)(row - TL) * D) : xa_in + (size_t)row * D;
#pragma unroll
                for (int bj = 0; bj < 2; ++bj)
#pragma unroll
                    for (int n = 0; n < 2; ++n) { const int c = col0 + bj * HALF + n * 16; *(f32x4*)(xa + (size_t)row * D + c) = *(const f32x4*)(src + c) + gv[bj][n] * acc[ai][bj][m][n]; } }
    }
};
template <bool GATHER_> struct SchedMoe { static constexpr bool GATHER = GATHER_; const int* sel; const LAS int* seltab; GridOrder o; int tpe  ; const char* A; const char* B; unsigned lda, ldb; size_t bstride  ; int nt;
    __device__ __forceinline__ bool next(int i, GUnit& u) const { int pm, pn; if (!o.tile(i, pm, pn)) return false; const int e = pm / tpe, tr = pm % tpe, pmg = e * 9 + tr;
        u.A = GATHER_ ? A : A + (size_t)pmg * 256 * lda; u.B = B + (size_t)e * bstride + (size_t)pn * 256 * ldb; u.lda = lda; u.ldb = ldb; u.nt = nt; u.pm = pmg; u.pn = pn; u.aux = e; u.ord = i; return true; }
};
struct EpiMoeUp { static constexpr bool PERM = true, SEG = false; bf16* act;
    __device__ __forceinline__ void operator()(const Acc& acc, const GUnit& u, int wr, int wc, int fr, int fq) const {
        asm volatile("" : "+v"(fr), "+v"(fq));
        const int row0 = u.pm * BM + wr * 64 + fr, col0 = u.pn * HALF + wc * 32 + 8 * fq;
#pragma unroll
        for (int ai = 0; ai < 2; ++ai)
#pragma unroll
            for (int m = 0; m < 4; ++m) { f32x4 o0, o1;
#pragma unroll
                for (int j = 0; j < 4; ++j) { const float g0 = acc[ai][0][m][0][j], g1 = acc[ai][0][m][1][j]; o0[j] = g0 * fsig(g0) * acc[ai][1][m][0][j]; o1[j] = g1 * fsig(g1) * acc[ai][1][m][1][j]; }
                *(u32x4*)(act + (size_t)(row0 + ai * HALF + m * 16) * FF + col0) = pack8(o0, o1); }
    }
};
struct SchedMoeDown { static constexpr bool GATHER = false; const int* sel; const LAS int* seltab; GridOrder o; int ksplit; const char* A; const char* B; unsigned lda, ldb; size_t bstride; int nt;
    __device__ __forceinline__ bool next(int i, GUnit& u) const { int pm, pn; u.lda = lda; u.ldb = ldb; u.ord = i;
        if (o.tile(i, pm, pn)) { const int e = pm / o.WGM, tr = pm % o.WGM, pmg = e * 9 + tr;
            u.A = A + (size_t)pmg * 256 * lda; u.B = B + (size_t)e * bstride + (size_t)pn * 256 * ldb; u.nt = nt; u.pm = pmg; u.pn = pn; u.aux = e; return true; }
        if (!ksplit) return false;
        const long L = (long)i * o.G + o.c - (long)o.nM * o.nN; if (L < 0 || L >= 256) return false;
        const int e = (int)L >> 4, pnq = ((int)L >> 2) & 3, q = (int)L & 3, pmg = e * 9 + 8;
        u.A = A + (size_t)pmg * 256 * lda + (size_t)q * 1024; u.B = B + (size_t)e * bstride + (size_t)pnq * 256 * ldb + (size_t)q * 1024; u.nt = 8; u.pm = pmg; u.pn = pnq; u.aux = 16 + q; return true; }
};
struct EpiMoeDown { static constexpr bool PERM = true, SEG = false; bf16* y; const float* gvx; float* slab;
    __device__ __forceinline__ void operator()(const Acc& acc, const GUnit& u, int wr, int wc, int fr, int fq) const {
        asm volatile("" : "+v"(fr), "+v"(fq));
        const int row0 = u.pm * BM + wr * 64 + fr;
        if (u.aux >= 16) {
            if (wr == 0) { const int q = u.aux - 16, e = u.pm / 9;
#pragma unroll
                for (int m = 0; m < 4; ++m) { const int r64 = m * 16 + fr; const float gv = gvx[row0 + m * 16]; float* sp = slab + (((size_t)q * NE + e) * 64 + r64) * D + u.pn * BM + wc * 32 + 8 * fq;
#pragma unroll
                    for (int bj = 0; bj < 2; ++bj) { *(f32x4*)(sp + bj * HALF) = acc[0][bj][m][0] * gv; *(f32x4*)(sp + bj * HALF + 4) = acc[0][bj][m][1] * gv; } } }
            return; }
#pragma unroll
        for (int ai = 0; ai < 2; ++ai)
#pragma unroll
            for (int m = 0; m < 4; ++m) { const int row = row0 + ai * HALF + m * 16; const float gv = gvx[row];
#pragma unroll
                for (int bj = 0; bj < 2; ++bj) *(u32x4*)(y + (size_t)row * D + u.pn * BM + bj * HALF + wc * 32 + 8 * fq) = pack8(acc[ai][bj][m][0] * gv, acc[ai][bj][m][1] * gv); }
    }
};
}

constexpr int LDS_RS_OFF = pg::STAGE_BYTES;

__device__ __forceinline__ void ph_inproj_fast(const Params& p, int l, unsigned char* lds_) {
    const int tid = otid();
    pg::SchedSimple S; S.o = pg::GridOrder{T / 256, ZW / 256, (int)gridDim.x, oblk(), 8}; S.A = (const char*)(p.ws + WS_H); S.B = (const char*)wl_ptr(p, l, WL_IN); S.lda = D * 2; S.ldb = D * 2; S.nt = D / 64;
    pg::EpiInproj E{(bf16*)(p.ws + WS_Z)};
    pg::gemm_phase(( LAS unsigned char*)lds_, S, E);
}
__device__ __forceinline__ void ph_mlaproj_fast(const Params& p, int l, unsigned char* lds_) {
    const int tid = otid();
    pg::SchedMla S{(int)gridDim.x, oblk(), (const char*)(p.ws + WS_Z), (const char*)wl_ptr(p, l, WL_UQ), (const char*)wl_ptr(p, l, WL_UKV)};
    LAS float* rstab = (LAS float*)((LAS unsigned char*)lds_ + LDS_RS_OFF);
    { pg::GUnit u; const int rl = tid >> 1, hf = tid & 1;
      for (int i = 0; i < 4 && S.next(i, u); ++i) { const int K = u.aux ? KVR : QR; const bf16* zr = (const bf16*)u.A + (size_t)rl * ZW + hf * (K / 2);
          float s = 0.f; for (int k = 0; k < K / 2; k += 8) { const uint4 w = *(const uint4*)(zr + k); const unsigned ww[4] = {w.x, w.y, w.z, w.w};
#pragma unroll
              for (int j = 0; j < 4; ++j) { const float a = __uint_as_float(ww[j] << 16), b = __uint_as_float(ww[j] & 0xffff0000u); s += a * a + b * b; } }
          s += __shfl_xor(s, 1);
          if (hf == 0) rstab[i * 256 + rl] = rsqrtf(s * (u.aux ? (1.f / KVR) : (1.f / QR)) + EPS); } }
    __syncthreads();
    pg::EpiMla E{(bf16*)(p.ws + WS_Q), (bf16*)(p.ws + WS_KB), (bf16*)(p.ws + WS_VB), (const float*)(p.ws + WS_ROPE), rstab};
    pg::gemm_phase((LAS unsigned char*)lds_, S, E);
    { bf16* Kb = (bf16*)(p.ws + WS_KB); const bf16* z = (const bf16*)(p.ws + WS_Z); const float* rope = (const float*)(p.ws + WS_ROPE);
      for (long i = GTID; i < (long)T * ROPE; i += GTOT) { const int d = (int)(i & 31), r = (int)(i >> 5);
          float v = bf2f(z[(size_t)r * ZW + Z_KR + d]);
          if (r < TL) rope_pair(rope, r, d, v, bf2f(z[(size_t)r * ZW + Z_KR + (d ^ 8)]), v);
          const bf16 o = f2bf(v); const size_t kr = (size_t)row_krow(r);
#pragma unroll
          for (int hd = 0; hd < MH; ++hd) Kb[kr * QW + hd * QKD + 64 + d] = o; } }
}
__device__ __forceinline__ void ph_merge_fast(const Params& p, int l, unsigned char* lds_) {
    const int tid = otid();
    const int nM = (l == DEPTH - 1) ? TL / 256 : T / 256;
    pg::SchedSimple S; S.o = pg::GridOrder{nM, D / 256, (int)gridDim.x, oblk(), 8}; S.A = (const char*)(p.ws + WS_ABP); S.B = (const char*)wl_ptr(p, l, WL_CAT); S.lda = D * 2; S.ldb = D * 2; S.nt = D / 64;
    pg::EpiMerge E{(const bf16*)(p.ws + WS_Z), (bf16*)(p.ws + WS_M)};
    pg::gemm_phase((LAS unsigned char*)lds_, S, E);
}
__device__ __forceinline__ void ph_outproj_fast(const Params& p, int l, unsigned char* lds_) {
    const int tid = otid();
    const bool ksplit = (l != DEPTH - 1) && gridDim.x == 256;
    const int nM = (l == DEPTH - 1 || ksplit) ? TL / 256 : T / 256;
    pg::SchedOut S; S.sel = nullptr; S.seltab = nullptr; S.o = pg::GridOrder{nM, D / 256, (int)gridDim.x, oblk(), 8}; S.ksplit = ksplit ? 1 : 0; S.A = (const char*)(p.ws + WS_M); S.B = (const char*)wl_ptr(p, l, WL_OUT); S.lda = D * 2; S.ldb = D * 2; S.nt = D / 64;
    pg::EpiOut E{p.in[I_X], p.in[I_CTX], (const float*)(p.ws + WS_XA), (float*)(p.ws + WS_XA), (const float*)(p.ws + WS_MOD) + (size_t)l * 3 * 6144, l, (float*)(p.ws + WS_SLAB)};
    pg::gemm_phase((LAS unsigned char*)lds_, S, E);
}
__device__ __forceinline__ void ph_moeup_fast(const Params& p, int l, unsigned char* lds_) {
    const int tid = otid();
    const int tpe = (l == DEPTH - 1) ? 8 : 9;
    pg::SchedMoe<true> S; S.sel = (const int*)(p.ws + WS_SEL); S.o = pg::GridOrder{NE * tpe, 2 * FF / 256, (int)gridDim.x, oblk(), 4}; S.tpe = tpe; S.A = (const char*)(p.ws + WS_H); S.B = (const char*)wl_ptr(p, l, WL_GU);
    S.lda = D * 2; S.ldb = D * 2; S.bstride = (size_t)2 * FF * D * 2; S.nt = D / 64;
    { LAS int* tab = (LAS int*)((LAS unsigned char*)lds_ + LDS_RS_OFF); S.seltab = tab; pg::GUnit u;
      __syncthreads();
      for (int i = 0; i < 12 && S.next(i, u); ++i) if (tid < 256) tab[i * 256 + tid] = S.sel[u.pm * 256 + tid];
      __syncthreads(); }
    pg::EpiMoeUp E{(bf16*)(p.ws + WS_ACT)};
    pg::gemm_phase((LAS unsigned char*)lds_, S, E);
}
__device__ __forceinline__ void ph_moedown_fast(const Params& p, int l, unsigned char* lds_) {
    const int tid = otid();
    const bool ksplit = (l != DEPTH - 1) && gridDim.x == 256;
    const int tpe = (l == DEPTH - 1 || ksplit) ? 8 : 9;
    pg::SchedMoeDown S; S.sel = nullptr; S.seltab = nullptr; S.o = pg::GridOrder{NE * tpe, D / 256, (int)gridDim.x, oblk(), tpe}; S.ksplit = ksplit ? 1 : 0; S.A = (const char*)(p.ws + WS_ACT); S.B = (const char*)wl_ptr(p, l, WL_DN);
    S.lda = FF * 2; S.ldb = FF * 2; S.bstride = (size_t)D * FF * 2; S.nt = FF / 64;
    pg::EpiMoeDown E{(bf16*)(p.ws + WS_Y), (const float*)(p.ws + WS_GVX), (float*)(p.ws + WS_SLAB)};
    pg::gemm_phase((LAS unsigned char*)lds_, S, E);
}

namespace mla {
using bf16x8 = __attribute__((ext_vector_type(8))) short;
using s16x4  = __attribute__((ext_vector_type(4))) short;
using f32x16 = __attribute__((ext_vector_type(16))) float;
using u32x4  = __attribute__((ext_vector_type(4))) unsigned;
constexpr int KVBLK = 64;
constexpr float SCALE = 0.10206207261596575f, THR = 8.f;
constexpr int SHM_V = 64 * 64 * 2, SHM_K = 64 * 256;
constexpr int LDS_BYTES = 2 * SHM_V + 2 * SHM_K + 8 * 64 * 4;
#define KSWZ(row, colB) ((row) * 256 + ((colB) ^ (((row) & 15) << 4)))
#define SBAR() __builtin_amdgcn_sched_barrier(0)
__device__ __forceinline__ int crow(int r, int hi) { return (r & 3) + 8 * (r >> 2) + 4 * hi; }
__device__ __forceinline__ unsigned cvtpk(float lo, float hi) { unsigned r; asm volatile("v_cvt_pk_bf16_f32 %0, %1, %2" : "=v"(r) : "v"(lo), "v"(hi)); return r; }
__device__ __forceinline__ void store_tile_rows(char* wl, const f32x16& o0, const f32x16& o1, bf16* dst, long stride, int lane) {
    const int r32 = lane & 31, hi = lane >> 5; unsigned short* w = (unsigned short*)wl;
#pragma unroll
    for (int r = 0; r < 16; ++r) { const unsigned v = cvtpk(o0[r], o1[r]); const int row = crow(r, hi); w[row * 72 + r32] = (unsigned short)(v & 0xffffu); w[row * 72 + 32 + r32] = (unsigned short)(v >> 16); }
    asm volatile("s_waitcnt lgkmcnt(0)" ::: "memory");
#pragma unroll
    for (int i = 0; i < 4; ++i) { const int row = i * 8 + (lane >> 3), ch = lane & 7; const u32x4 v = *(const u32x4*)(wl + row * 144 + ch * 16); *(u32x4*)(dst + (long)row * stride + ch * 8) = v; }
    asm volatile("s_waitcnt lgkmcnt(0)" ::: "memory");
}
constexpr float THR2 = THR * 1.4426950408889634f;
__device__ __forceinline__ void partialSM(f32x16& p0, f32x16& p1, float& m_reg, float& mn, float& alpha) {
    float pmax = p0[0];
#pragma unroll
    for (int r = 1; r < 16; ++r) pmax = fmaxf(pmax, p0[r]);
#pragma unroll
    for (int r = 0; r < 16; ++r) pmax = fmaxf(pmax, p1[r]);
    { auto rr = __builtin_amdgcn_permlane32_swap(__float_as_uint(pmax), __float_as_uint(pmax), false, false); pmax = fmaxf(__uint_as_float(rr[0]), __uint_as_float(rr[1])); }
    if (__builtin_expect(__all(pmax - m_reg <= THR2), 1)) { mn = m_reg; alpha = 1.f; }
    else { mn = fmaxf(m_reg, pmax); alpha = __builtin_amdgcn_exp2f(m_reg - mn); m_reg = mn; }
#pragma unroll
    for (int r = 0; r < 16; ++r) p0[r] -= mn;
#pragma unroll
    for (int r = 0; r < 16; ++r) p1[r] -= mn;
#pragma unroll
    for (int r = 0; r < 16; ++r) p0[r] = __builtin_amdgcn_exp2f(p0[r]);
}
__device__ __forceinline__ float expsum(f32x16& p0, f32x16& p1) {
#pragma unroll
    for (int r = 0; r < 16; ++r) p0[r] = __builtin_amdgcn_exp2f(p0[r]);
#pragma unroll
    for (int r = 0; r < 16; ++r) p1[r] = __builtin_amdgcn_exp2f(p1[r]);
    float sa = 0;
#pragma unroll
    for (int r = 0; r < 16; ++r) sa += p0[r];
#pragma unroll
    for (int r = 0; r < 16; ++r) sa += p1[r];
    { auto rr = __builtin_amdgcn_permlane32_swap(__float_as_uint(sa), __float_as_uint(sa), false, false); sa = __uint_as_float(rr[0]) + __uint_as_float(rr[1]); }
    return sa;
}
__device__ __forceinline__ void packP(const f32x16& p0, const f32x16& p1, bf16x8& pa0, bf16x8& pa1, bf16x8& pa2, bf16x8& pa3) {
#define PK4(P, BASE, OUT) do { unsigned a0 = cvtpk(P[BASE + 0], P[BASE + 1]), a1 = cvtpk(P[BASE + 2], P[BASE + 3]);   \
    unsigned b0 = cvtpk(P[BASE + 4], P[BASE + 5]), b1 = cvtpk(P[BASE + 6], P[BASE + 7]);                              \
    auto r0 = __builtin_amdgcn_permlane32_swap(a0, b0, false, false); auto r1 = __builtin_amdgcn_permlane32_swap(a1, b1, false, false); \
    u32x4 w = {r0[0], r1[0], r0[1], r1[1]}; OUT = *reinterpret_cast<bf16x8*>(&w); } while (0)
    PK4(p0, 0, pa0); PK4(p0, 8, pa1); PK4(p1, 0, pa2); PK4(p1, 8, pa3);
#undef PK4
}
__device__ __forceinline__ void finishSM(f32x16& p0, f32x16& p1, float alpha, float& l_reg, bf16x8& pa0, bf16x8& pa1, bf16x8& pa2, bf16x8& pa3) {
#pragma unroll
    for (int r = 0; r < 16; ++r) p1[r] = __builtin_amdgcn_exp2f(p1[r]);
    float ps = 0;
#pragma unroll
    for (int r = 0; r < 16; ++r) ps += p0[r];
#pragma unroll
    for (int r = 0; r < 16; ++r) ps += p1[r];
    { auto rr = __builtin_amdgcn_permlane32_swap(__float_as_uint(ps), __float_as_uint(ps), false, false); ps = __uint_as_float(rr[0]) + __uint_as_float(rr[1]); }
    l_reg = l_reg * alpha + ps;
#define PK4(P, BASE, OUT) do { unsigned a0 = cvtpk(P[BASE + 0], P[BASE + 1]), a1 = cvtpk(P[BASE + 2], P[BASE + 3]);   \
    unsigned b0 = cvtpk(P[BASE + 4], P[BASE + 5]), b1 = cvtpk(P[BASE + 6], P[BASE + 7]);                              \
    auto r0 = __builtin_amdgcn_permlane32_swap(a0, b0, false, false); auto r1 = __builtin_amdgcn_permlane32_swap(a1, b1, false, false); \
    u32x4 w = {r0[0], r1[0], r0[1], r1[1]}; OUT = *reinterpret_cast<bf16x8*>(&w); } while (0)
    PK4(p0, 0, pa0); PK4(p0, 8, pa1); PK4(p1, 0, pa2); PK4(p1, 8, pa3);
#undef PK4
}
__device__ __forceinline__ void qkt(f32x16& p0, f32x16& p1, const char* Ks, const bf16x8* qr, int r32, int hi) {
    p0 = f32x16{}; p1 = f32x16{};
#pragma unroll
    for (int d0 = 0; d0 < 6; ++d0) { const int cb = (d0 * 16 + hi * 8) * 2;
        bf16x8 b0 = *reinterpret_cast<const bf16x8*>(Ks + KSWZ(r32, cb));
        bf16x8 b1 = *reinterpret_cast<const bf16x8*>(Ks + KSWZ(32 + r32, cb));
        p0 = __builtin_amdgcn_mfma_f32_32x32x16_bf16(b0, qr[d0], p0, 0, 0, 0);
        p1 = __builtin_amdgcn_mfma_f32_32x32x16_bf16(b1, qr[d0], p1, 0, 0, 0); }
}
__device__ __forceinline__ int v_st(int k, int c) { const int kk = (k & ~0xC) | ((k & 4) << 1) | ((k & 8) >> 1); return ((kk >> 3) * 2 + (c >> 5)) * 512 + ((kk & 7) * 32 + (c & 31)) * 2; }
__device__ __forceinline__ int v_rd_base(int lane) { return ((lane & 3) << 3) | (((lane >> 2) & 3) << 6) | (((lane >> 4) & 1) << 5) | (((lane >> 5) & 1) << 8); }
constexpr int v_rd_off(int d0, int ks, int half) { return d0 * 512 + ks * 2048 + half * 1024; }
template <int OFF> __device__ __forceinline__ s16x4 tr_read(int vb) { s16x4 r; asm volatile("ds_read_b64_tr_b16 %0, %1 offset:%2" : "=&v"(r) : "v"(vb), "i"(OFF) : "memory"); return r; }
template <int D0> __device__ __forceinline__ void pv_one(f32x16& od, int vb, bf16x8 pa0, bf16x8 pa1, bf16x8 pa2, bf16x8 pa3) {
    const s16x4 l0 = tr_read<v_rd_off(D0, 0, 0)>(vb), h0 = tr_read<v_rd_off(D0, 0, 1)>(vb), l1 = tr_read<v_rd_off(D0, 1, 0)>(vb), h1 = tr_read<v_rd_off(D0, 1, 1)>(vb);
    const s16x4 l2 = tr_read<v_rd_off(D0, 2, 0)>(vb), h2 = tr_read<v_rd_off(D0, 2, 1)>(vb), l3 = tr_read<v_rd_off(D0, 3, 0)>(vb), h3 = tr_read<v_rd_off(D0, 3, 1)>(vb);
    asm volatile("s_waitcnt lgkmcnt(0)" ::: "memory"); SBAR();
#define PK(L, H) (bf16x8){L[0], L[1], L[2], L[3], H[0], H[1], H[2], H[3]}
    od = __builtin_amdgcn_mfma_f32_32x32x16_bf16(pa0, PK(l0, h0), od, 0, 0, 0);
    od = __builtin_amdgcn_mfma_f32_32x32x16_bf16(pa1, PK(l1, h1), od, 0, 0, 0);
    od = __builtin_amdgcn_mfma_f32_32x32x16_bf16(pa2, PK(l2, h2), od, 0, 0, 0);
    od = __builtin_amdgcn_mfma_f32_32x32x16_bf16(pa3, PK(l3, h3), od, 0, 0, 0);
#undef PK
}
__device__ __forceinline__ void pv_d0(f32x16& o0, f32x16& o1, int vb, bf16x8 pa0, bf16x8 pa1, bf16x8 pa2, bf16x8 pa3) { pv_one<0>(o0, vb, pa0, pa1, pa2, pa3); pv_one<1>(o1, vb, pa0, pa1, pa2, pa3); }

__device__ __forceinline__ void attn_unit(const bf16* __restrict__ Qb, const bf16* __restrict__ Kh, const bf16* __restrict__ Vh, bf16* __restrict__ Ob, int nkeys, char* lds, int tid) {
    asm volatile("" : "+v"(tid));
    const int wid = __builtin_amdgcn_readfirstlane(tid >> 6), lane = tid & 63, r32 = lane & 31, hi = lane >> 5;
    char* V_lds = lds; char* K_lds = lds + 2 * SHM_V;
    float* ws = (float*)(lds + 2 * SHM_V + 2 * SHM_K) + wid * 64; float* li_l = ws; float* al_l = ws + 32;
    float m_reg = -1e30f, l_reg = 0; f32x16 o0 = {}, o1 = {}; bf16x8 qr[6];
    const bf16* Qw = Qb + (long)(wid * 32 + r32) * QW + hi * 8;
#pragma unroll
    for (int d0 = 0; d0 < 6; ++d0) qr[d0] = *reinterpret_cast<const bf16x8*>(Qw + d0 * 16);
    const int kr0 = tid / 12, kc0 = tid % 12, kr1 = (tid + 512) / 12, kc1 = (tid + 512) % 12, vr = tid >> 3, vc = tid & 7;
    const bool two = wid < 4;
    const int kst0 = KSWZ(kr0, kc0 * 16), kst1 = KSWZ(kr1, kc1 * 16), vst = v_st(vr, vc * 8);
    const bf16* kg0 = Kh + (long)kr0 * QW + kc0 * 8; const bf16* kg1 = Kh + (long)kr1 * QW + kc1 * 8; const bf16* vg = Vh + (long)vr * AW + vc * 8;
    const int vb0 = (int)(uintptr_t)V_lds + v_rd_base(lane);
    bf16x8 sk0[2], sk1[2], sv[2];
#define SLOAD(i, k0) do { sv[i] = *reinterpret_cast<const bf16x8*>(vg + (long)(k0) * AW); sk0[i] = *reinterpret_cast<const bf16x8*>(kg0 + (long)(k0) * QW); if (two) sk1[i] = *reinterpret_cast<const bf16x8*>(kg1 + (long)(k0) * QW); } while (0)
#define SWRITE(b, i) do { *(bf16x8*)(V_lds + (b) * SHM_V + vst) = sv[i]; *(bf16x8*)(K_lds + (b) * SHM_K + kst0) = sk0[i]; if (two) *(bf16x8*)(K_lds + (b) * SHM_K + kst1) = sk1[i]; } while (0)
#define SWAIT() do { if (two) asm volatile("s_waitcnt vmcnt(3)" ::: "memory"); else asm volatile("s_waitcnt vmcnt(2)" ::: "memory"); } while (0)
#define RESC(a) do { if (__any((a) < 1.f)) { if (hi == 0) al_l[r32] = (a); asm volatile("s_waitcnt lgkmcnt(0)" ::: "memory"); \
    _Pragma("unroll") for (int r = 0; r < 16; ++r) { const float f = al_l[crow(r, hi)]; o0[r] *= f; o1[r] *= f; } } } while (0)
    f32x16 pA0, pA1, pB0, pB1; float mnA, mnB, alA, alB; bf16x8 pa0, pa1, pa2, pa3; const int NTL = nkeys / KVBLK;
    __syncthreads();
    SLOAD(0, 0); asm volatile("s_waitcnt vmcnt(0)" ::: "memory"); SWRITE(0, 0); __syncthreads();
    qkt(pA0, pA1, K_lds, qr, r32, hi); partialSM(pA0, pA1, m_reg, mnA, alA);
    SLOAD(1, KVBLK); if (2 < NTL) SLOAD(0, 2 * KVBLK);
    SWAIT(); SWRITE(1, 1); __syncthreads();
    for (int j = 1; j + 1 < NTL; j += 2) {
        SBAR(); qkt(pB0, pB1, K_lds + SHM_K, qr, r32, hi);
        finishSM(pA0, pA1, alA, l_reg, pa0, pa1, pa2, pa3); SBAR();
        SLOAD(1, (j + 2) * KVBLK); SBAR();
        pv_d0(o0, o1, vb0, pa0, pa1, pa2, pa3); partialSM(pB0, pB1, m_reg, mnB, alB);
        __syncthreads(); SWAIT(); SWRITE(0, 0);
        RESC(alB); __syncthreads();
        SBAR(); qkt(pA0, pA1, K_lds, qr, r32, hi);
        finishSM(pB0, pB1, alB, l_reg, pa0, pa1, pa2, pa3); SBAR();
        if (j + 3 < NTL) SLOAD(0, (j + 3) * KVBLK); SBAR();
        pv_d0(o0, o1, vb0 + SHM_V, pa0, pa1, pa2, pa3); partialSM(pA0, pA1, m_reg, mnA, alA);
        __syncthreads(); SWAIT(); SWRITE(1, 1);
        RESC(alA); __syncthreads();
    }
    SBAR(); qkt(pB0, pB1, K_lds + SHM_K, qr, r32, hi);
    finishSM(pA0, pA1, alA, l_reg, pa0, pa1, pa2, pa3); SBAR();
    pv_d0(o0, o1, vb0, pa0, pa1, pa2, pa3); partialSM(pB0, pB1, m_reg, mnB, alB);
    __syncthreads(); RESC(alB);
    finishSM(pB0, pB1, alB, l_reg, pa0, pa1, pa2, pa3); SBAR();
    pv_d0(o0, o1, vb0 + SHM_V, pa0, pa1, pa2, pa3);
    if (hi == 0) li_l[r32] = l_reg; asm volatile("s_waitcnt lgkmcnt(0)" ::: "memory");
#pragma unroll
    for (int r = 0; r < 16; ++r) { const float rl = __builtin_amdgcn_rcpf(li_l[crow(r, hi)]); o0[r] *= rl; o1[r] *= rl; }
    __syncthreads();
    store_tile_rows(lds + wid * 4608, o0, o1, Ob + (long)(wid * 32) * D, D, lane);
#undef SLOAD
#undef SWRITE
#undef SWAIT
#undef RESC
}

struct CvtSide {
    const float* wg; long du, dd; bf16* gu; bf16* dn; int on;
    __device__ __forceinline__ void setup(int e, int sub, int run, int tid, const char*& sb, char*& db, unsigned& slo, unsigned& dlo, int& sh) const {
        const int nl = (tid >> 6) * 16 + (tid & 15), kp = (tid & 63) >> 4; const bool isdn = run == 2;
        const int N = isdn ? D : FF, K = isdn ? FF : D; sh = isdn ? 12 : 13;
        const size_t so = (size_t)e * D * FF + (isdn ? (size_t)((sub & 1) * 1024) * D + (sub >> 1) * 128 : (size_t)sub * 128);
        sb = (const char*)(wg + (run == 1 ? du : 0) + (isdn ? dd : 0) + so);
        db = (char*)((isdn ? dn : gu) + (isdn ? (size_t)e * D * FF + (size_t)((sub >> 1) * 128) * FF + (sub & 1) * 1024 : (size_t)e * 2 * FF * D + (size_t)(256 * sub + 128 * run) * D));
        slo = (unsigned)(kp * 8 * N + nl) * 4u; dlo = (unsigned)(nl * K + kp * 8) * 2u;
    }
    __device__ __forceinline__ void load(const char*& sb, unsigned slo, int sh, float (&v)[8]) const {
#pragma unroll
        for (int i = 0; i < 8; ++i) v[i] = *(const float*)(sb + (slo + ((unsigned)i << sh)));
        sb += (size_t)32 << sh;
    }
    __device__ __forceinline__ void store(char*& db, unsigned dlo, const float (&v)[8]) const {
        u32x4 w; w.x = cvtpk(v[0], v[1]); w.y = cvtpk(v[2], v[3]); w.z = cvtpk(v[4], v[5]); w.w = cvtpk(v[6], v[7]);
        *(u32x4*)(db + dlo) = w; db += 64;
    }
};

template <int D0> __device__ __forceinline__ void pv_one2(f32x16& oa, f32x16& ob, int vb, bf16x8 a0, bf16x8 a1, bf16x8 a2, bf16x8 a3, bf16x8 b0, bf16x8 b1, bf16x8 b2, bf16x8 b3) {
    const s16x4 l0 = tr_read<v_rd_off(D0, 0, 0)>(vb), h0 = tr_read<v_rd_off(D0, 0, 1)>(vb), l1 = tr_read<v_rd_off(D0, 1, 0)>(vb), h1 = tr_read<v_rd_off(D0, 1, 1)>(vb);
    const s16x4 l2 = tr_read<v_rd_off(D0, 2, 0)>(vb), h2 = tr_read<v_rd_off(D0, 2, 1)>(vb), l3 = tr_read<v_rd_off(D0, 3, 0)>(vb), h3 = tr_read<v_rd_off(D0, 3, 1)>(vb);
    asm volatile("s_waitcnt lgkmcnt(0)" ::: "memory"); SBAR();
#define PK(L, H) (bf16x8){L[0], L[1], L[2], L[3], H[0], H[1], H[2], H[3]}
    const bf16x8 v0 = PK(l0, h0), v1 = PK(l1, h1), v2 = PK(l2, h2), v3 = PK(l3, h3);
    oa = __builtin_amdgcn_mfma_f32_32x32x16_bf16(a0, v0, oa, 0, 0, 0); ob = __builtin_amdgcn_mfma_f32_32x32x16_bf16(b0, v0, ob, 0, 0, 0);
    oa = __builtin_amdgcn_mfma_f32_32x32x16_bf16(a1, v1, oa, 0, 0, 0); ob = __builtin_amdgcn_mfma_f32_32x32x16_bf16(b1, v1, ob, 0, 0, 0);
    oa = __builtin_amdgcn_mfma_f32_32x32x16_bf16(a2, v2, oa, 0, 0, 0); ob = __builtin_amdgcn_mfma_f32_32x32x16_bf16(b2, v2, ob, 0, 0, 0);
    oa = __builtin_amdgcn_mfma_f32_32x32x16_bf16(a3, v3, oa, 0, 0, 0); ob = __builtin_amdgcn_mfma_f32_32x32x16_bf16(b3, v3, ob, 0, 0, 0);
#undef PK
}
__device__ __forceinline__ void attn_unit2(const bf16* __restrict__ Qb, const bf16* __restrict__ Kh, const bf16* __restrict__ Vh, bf16* __restrict__ Ob, int nkeys, char* lds, int tid, const CvtSide& side, int cbase) {
    asm volatile("" : "+v"(tid));
    const int wid = __builtin_amdgcn_readfirstlane(tid >> 6), lane = tid & 63, r32 = lane & 31, hi = lane >> 5;
    char* V_lds = lds; char* K_lds = lds + 4 * SHM_V;
    float* ws = (float*)(lds + 4 * SHM_V + 4 * SHM_K) + wid * 128; float* liA = ws; float* liB = ws + 32; float* alA_l = ws + 64; float* alB_l = ws + 96;
    float mA = 0.f, lA = 0, mB = 0.f, lB = 0; bool slow = false; f32x16 oA0 = {}, oA1 = {}, oB0 = {}, oB1 = {}; bf16x8 qA[6], qB[6];
    const bf16* Qw = Qb + (long)(wid * 64 + r32) * QW + hi * 8;
#pragma unroll
    for (int d0 = 0; d0 < 6; ++d0) { qA[d0] = *reinterpret_cast<const bf16x8*>(Qw + d0 * 16); qB[d0] = *reinterpret_cast<const bf16x8*>(Qw + 32 * QW + d0 * 16); }
    const int kr0 = tid / 12, kc0 = tid % 12, kr1 = (tid + 512) / 12, kc1 = (tid + 512) % 12, vr = tid >> 3, vc = tid & 7;
    const bool two = wid < 4;
    const int kst0 = KSWZ(kr0, kc0 * 16), kst1 = KSWZ(kr1, kc1 * 16), vst = v_st(vr, vc * 8);
    const bf16* kg0 = Kh + (long)kr0 * QW + kc0 * 8; const bf16* kg1 = Kh + (long)kr1 * QW + kc1 * 8; const bf16* vg = Vh + (long)vr * AW + vc * 8;
    const int vb0 = (int)(uintptr_t)V_lds + v_rd_base(lane);
    bf16x8 sk0, sk1, sv;
#define SLOAD2(k0) do { sv = *reinterpret_cast<const bf16x8*>(vg + (long)(k0) * AW); sk0 = *reinterpret_cast<const bf16x8*>(kg0 + (long)(k0) * QW); if (two) sk1 = *reinterpret_cast<const bf16x8*>(kg1 + (long)(k0) * QW); } while (0)
#define TBUF(t) (((((t) >> 1) & 1) << 1) | ((t) & 1))
#define SWRITE2(b) do { *(bf16x8*)(V_lds + (b) * SHM_V + vst) = sv; *(bf16x8*)(K_lds + (b) * SHM_K + kst0) = sk0; if (two) *(bf16x8*)(K_lds + (b) * SHM_K + kst1) = sk1; } while (0)
#define RESC2(a, al_l, o0, o1) do { if (__any((a) < 1.f)) { if (hi == 0) al_l[r32] = (a); asm volatile("s_waitcnt lgkmcnt(0)" ::: "memory"); \
    _Pragma("unroll") for (int r = 0; r < 16; ++r) { const float f = al_l[crow(r, hi)]; o0[r] *= f; o1[r] *= f; } } } while (0)
    const int NTL = nkeys / KVBLK;
    bf16x8 tk0, tk1, tv; SLOAD2(0);
    tv = *reinterpret_cast<const bf16x8*>(vg + (long)KVBLK * AW); tk0 = *reinterpret_cast<const bf16x8*>(kg0 + (long)KVBLK * QW); if (two) tk1 = *reinterpret_cast<const bf16x8*>(kg1 + (long)KVBLK * QW);
    __syncthreads();
    SWRITE2(TBUF(0));
    *(bf16x8*)(V_lds + TBUF(1) * SHM_V + vst) = tv; *(bf16x8*)(K_lds + TBUF(1) * SHM_K + kst0) = tk0; if (two) *(bf16x8*)(K_lds + TBUF(1) * SHM_K + kst1) = tk1;
    SLOAD2(2 * KVBLK);
    if (wid >= 4) __builtin_amdgcn_s_setprio(1);
    const char* sd_sb = nullptr; char* sd_db = nullptr; unsigned sd_slo = 0, sd_dlo = 0; int sd_sh = 12;
    for (int j = 0; j < NTL; ++j) {
        if ((j & 1) == 0) __syncthreads();
        if (j + 2 < NTL) { SWRITE2(TBUF(j + 2)); if (j + 3 < NTL) SLOAD2((j + 3) * KVBLK); }
        float cv[8]; const bool cvt_on = side.on && j < 96;
        if (cvt_on) { if ((j & 31) == 0) side.setup(cbase >> 4, cbase & 15, j >> 5, tid, sd_sb, sd_db, sd_slo, sd_dlo, sd_sh); side.load(sd_sb, sd_slo, sd_sh, cv); }
        const char* Ks = K_lds + TBUF(j) * SHM_K; const int vb = vb0 + TBUF(j) * SHM_V;
        float mn, al; bf16x8 a0, a1, a2, a3, c0, c1, c2, c3;
        if (__builtin_expect(!slow, 1)) {
            float psA, psB;
#if MLA_ILV
            {
                f32x16 pA0, pA1; qkt(pA0, pA1, Ks, qA, r32, hi);
                f32x16 pB0 = {}, pB1 = {}; float sA = 0.f;
#define BSTEP(d0) do { const int cb_ = ((d0) * 16 + hi * 8) * 2; const bf16x8 b0_ = *reinterpret_cast<const bf16x8*>(Ks + KSWZ(r32, cb_)), b1_ = *reinterpret_cast<const bf16x8*>(Ks + KSWZ(32 + r32, cb_)); \
                    pB0 = __builtin_amdgcn_mfma_f32_32x32x16_bf16(b0_, qB[d0], pB0, 0, 0, 0); pB1 = __builtin_amdgcn_mfma_f32_32x32x16_bf16(b1_, qB[d0], pB1, 0, 0, 0); } while (0)
#define ACHUNK(P, BASE, OUT) do { _Pragma("unroll") for (int r_ = 0; r_ < 8; ++r_) { P[BASE + r_] = __builtin_amdgcn_exp2f(P[BASE + r_]); sA += P[BASE + r_]; } \
                    unsigned x0_ = cvtpk(P[BASE + 0], P[BASE + 1]), x1_ = cvtpk(P[BASE + 2], P[BASE + 3]), y0_ = cvtpk(P[BASE + 4], P[BASE + 5]), y1_ = cvtpk(P[BASE + 6], P[BASE + 7]); \
                    auto r0_ = __builtin_amdgcn_permlane32_swap(x0_, y0_, false, false); auto r1_ = __builtin_amdgcn_permlane32_swap(x1_, y1_, false, false); \
                    u32x4 w_ = {r0_[0], r1_[0], r0_[1], r1_[1]}; OUT = *reinterpret_cast<bf16x8*>(&w_); } while (0)
                BSTEP(0); ACHUNK(pA0, 0, a0); SBAR();
                BSTEP(1); ACHUNK(pA0, 8, a1); SBAR();
                BSTEP(2); ACHUNK(pA1, 0, a2); SBAR();
                BSTEP(3); ACHUNK(pA1, 8, a3); SBAR();
                BSTEP(4); BSTEP(5);
#undef BSTEP
#undef ACHUNK
                { auto rr = __builtin_amdgcn_permlane32_swap(__float_as_uint(sA), __float_as_uint(sA), false, false); psA = __uint_as_float(rr[0]) + __uint_as_float(rr[1]); }
                psB = expsum(pB0, pB1); packP(pB0, pB1, c0, c1, c2, c3);
            }
#else
            { f32x16 p0, p1; qkt(p0, p1, Ks, qA, r32, hi); psA = expsum(p0, p1); packP(p0, p1, a0, a1, a2, a3); }
            { f32x16 p0, p1; qkt(p0, p1, Ks, qB, r32, hi); psB = expsum(p0, p1); packP(p0, p1, c0, c1, c2, c3); }
#endif
            const bool bad = !(psA < 1.0e12f) || !(psB < 1.0e12f) || (j == 0 && (!(psA > 1.0e-18f) || !(psB > 1.0e-18f)));
            if (__builtin_expect(__any(bad), 0)) { slow = true; if (j == 0) { mA = -1e30f; mB = -1e30f; } }
            else { lA += psA; lB += psB; }
        }
        if (__builtin_expect(slow, 0)) {
            { f32x16 p0, p1; qkt(p0, p1, Ks, qA, r32, hi); partialSM(p0, p1, mA, mn, al); RESC2(al, alA_l, oA0, oA1); finishSM(p0, p1, al, lA, a0, a1, a2, a3); }
            { f32x16 p0, p1; qkt(p0, p1, Ks, qB, r32, hi); partialSM(p0, p1, mB, mn, al); RESC2(al, alB_l, oB0, oB1); finishSM(p0, p1, al, lB, c0, c1, c2, c3); }
        }
        pv_one2<0>(oA0, oB0, vb, a0, a1, a2, a3, c0, c1, c2, c3);
        pv_one2<1>(oA1, oB1, vb, a0, a1, a2, a3, c0, c1, c2, c3);
        if (cvt_on) side.store(sd_db, sd_dlo, cv);
    }
    __builtin_amdgcn_s_setprio(0);
    if (hi == 0) { liA[r32] = lA; liB[r32] = lB; } asm volatile("s_waitcnt lgkmcnt(0)" ::: "memory");
#pragma unroll
    for (int r = 0; r < 16; ++r) { const int orow = crow(r, hi); const float ra = __builtin_amdgcn_rcpf(liA[orow]), rb = __builtin_amdgcn_rcpf(liB[orow]); oA0[r] *= ra; oA1[r] *= ra; oB0[r] *= rb; oB1[r] *= rb; }
    __syncthreads();
    store_tile_rows(lds + wid * 9216, oA0, oA1, Ob + (long)(wid * 64) * D, D, lane);
    store_tile_rows(lds + wid * 9216 + 4608, oB0, oB1, Ob + (long)(wid * 64 + 32) * D, D, lane);
#undef SLOAD2
#undef SWRITE2
#undef TBUF
#undef RESC2
}
#undef KSWZ
#undef SBAR
}

__device__ __forceinline__ void ph_mla_fast(const Params& p, int l, unsigned char* lds_) {
    const int tid = otid();
    const bf16* q = (const bf16*)(p.ws + WS_Q); const bf16* Kb = (const bf16*)(p.ws + WS_KB); const bf16* Vb = (const bf16*)(p.ws + WS_VB); bf16* abp = (bf16*)(p.ws + WS_ABP);
#if MLA_V2
    const mla::CvtSide side{p.in[I_WGATE] + (size_t)l * NE * D * FF, (long)(p.in[I_WUP] - p.in[I_WGATE]), (long)(p.in[I_WDOWN] - p.in[I_WGATE]), wl_ptr(p, l, WL_GU), wl_ptr(p, l, WL_DN), (gridDim.x == 256) ? 1 : 0};
    for (int u = blockIdx.x; u < 256; u += gridDim.x) { const int hd = u & 7, jj = u >> 3, b = jj >> 4, row0 = b * SEQ + (jj & 15) * 512;
        mla::attn_unit2(q + (size_t)row0 * QW + hd * QKD, Kb + (size_t)b * NKEY * QW + hd * QKD, Vb + (size_t)b * NKEY * AW + hd * VD, abp + (size_t)row0 * D + hd * VD, NKEY, (char*)lds_, tid, side, u); }
    if (l == 0) for (int c = blockIdx.x; c < 16; c += gridDim.x) { const int b = c >> 3, hd = c & 7, row0 = TL + b * CTX;
        mla::attn_unit(q + (size_t)row0 * QW + hd * QKD, Kb + (size_t)b * NKEY * QW + hd * QKD, Vb + (size_t)b * NKEY * AW + hd * VD, abp + (size_t)row0 * D + hd * VD, CTX, (char*)lds_, tid); }
#else
    for (int u = blockIdx.x; u < 512 + (l == 0 ? 16 : 0); u += gridDim.x) {
        int b, hd, row0, nkeys;
        if (u < 512) { const int c = u & 255; b = u >> 8; hd = c & 7; row0 = b * SEQ + (c >> 3) * 256; nkeys = NKEY; }
        else { const int c = u - 512; b = c >> 3; hd = c & 7; row0 = TL + b * CTX; nkeys = CTX; }
        mla::attn_unit(q + (size_t)row0 * QW + hd * QKD, Kb + (size_t)b * NKEY * QW + hd * QKD, Vb + (size_t)b * NKEY * AW + hd * VD, abp + (size_t)row0 * D + hd * VD, nkeys, (char*)lds_, tid);
    }
#endif
}

namespace na {
using mla::bf16x8; using mla::s16x4; using mla::f32x16; using mla::u32x4;
constexpr int TILE_B = 65536;
constexpr int OFF_RPB = 2 * TILE_B, OFF_WS = OFF_RPB + (64 + 4 * 15 * 32 + 64) * 4, LDS_BYTES = OFF_WS + 8 * 64 * 4;
#define KSWZ64(row, colB) ((row) * 128 + ((colB) ^ (((row) & 7) << 4)))
__device__ __forceinline__ void qkt64(f32x16& p0, f32x16& p1, const char* Ks, const bf16x8* qr, int r32, int hi) {
    p0 = f32x16{}; p1 = f32x16{};
#pragma unroll
    for (int d0 = 0; d0 < 4; ++d0) { const int cb = (d0 * 16 + hi * 8) * 2;
        bf16x8 b0 = *reinterpret_cast<const bf16x8*>(Ks + KSWZ64(r32, cb));
        bf16x8 b1 = *reinterpret_cast<const bf16x8*>(Ks + KSWZ64(32 + r32, cb));
        p0 = __builtin_amdgcn_mfma_f32_32x32x16_bf16(b0, qr[d0], p0, 0, 0, 0);
        p1 = __builtin_amdgcn_mfma_f32_32x32x16_bf16(b1, qr[d0], p1, 0, 0, 0); }
}
__device__ __forceinline__ void na_unit(const Params& p, int l, int qrow0, bool lat, int b, int gr0, int hp, char* lds, int tid) {
    asm volatile("" : "+v"(tid));
    const bf16* z = (const bf16*)(p.ws + WS_Z); bf16* abp = (bf16*)(p.ws + WS_ABP);
    const int wid = __builtin_amdgcn_readfirstlane(tid >> 6), lane = tid & 63, r32 = lane & 31, hi = lane >> 5, hl = wid >> 2, rsel = (wid >> 1) & 1, qh = wid & 1, hd = hp * 2 + hl;
    float* rpbs = (float*)(lds + OFF_RPB); float* ws = (float*)(lds + OFF_WS) + wid * 64; float* li_l = ws; float* al_l = ws + 32;
    const int gr = gr0 + rsel;
    int sr0 = gr0 - 4; sr0 = sr0 < 0 ? 0 : (sr0 > 120 ? 120 : sr0);
    int sr1 = gr0 - 3; sr1 = sr1 < 0 ? 0 : (sr1 > 120 ? 120 : sr1);
    const int srw = rsel ? sr1 : sr0;
    const int ntile = lat ? 12 + (sr1 != sr0 ? 1 : 0) : 4;
    const int cq = qh * 32 + r32; int sc = cq - 8; sc = sc < 0 ? 0 : (sc > 48 ? 48 : sc);
    __syncthreads();
    bf16x8 qr[4];
    const int srow = tid >> 4, sch = tid & 15, shd = sch >> 3, sc8 = sch & 7;
    bf16x8 skA[2], svA[2], skB[2], svB[2];
#define TROW(j) ((lat && (j) >= 4) ? (b * SEQ + (sr0 + (j) - 4) * GW) : (TL + b * CTX + (j) * 64))
#define NLOAD(j, SK, SV) do { const bf16* g = z + (size_t)(TROW(j) + srow) * ZW + Z_NA + 256 + hp * 128 + sch * 8; _Pragma("unroll") for (int i = 0; i < 2; ++i) { SK[i] = *reinterpret_cast<const bf16x8*>(g + (size_t)(32 * i) * ZW); SV[i] = *reinterpret_cast<const bf16x8*>(g + (size_t)(32 * i) * ZW + 256); } } while (0)
#define NWRITE(bu, SK, SV) do { char* kb = lds + (bu) * TILE_B + shd * 8192; char* vb_ = kb + 16384; _Pragma("unroll") for (int i = 0; i < 2; ++i) { const int row = srow + 32 * i; \
        *(bf16x8*)(kb + KSWZ64(row, sc8 * 16)) = SK[i]; *(bf16x8*)(vb_ + mla::v_st(row, sc8 * 8)) = SV[i]; } } while (0)
    float m_reg = -1e30f, l_reg = 0; f32x16 o0 = {}, o1 = {};
    constexpr float C = 0.125f * 1.4426950408889634f;
    NLOAD(0, skA, svA); if (2 < ntile) NLOAD(2, skB, svB);
    { const float* rpb = p.in[I_RPB] + (size_t)l * 4 * 15 * 31; for (int i = tid; i < 64 + 4 * 15 * 32 + 64; i += NT) { const int t_ = i - 64, c = t_ & 31; rpbs[i] = (t_ >= 0 && t_ < 4 * 15 * 32 && c < 31) ? rpb[(t_ >> 5) * 31 + c] : 0.f; } }
    { const bf16* Qw = z + (size_t)(qrow0 + rsel * 64 + cq) * ZW + Z_NA + hd * 64 + hi * 8;
#pragma unroll
      for (int d0 = 0; d0 < 4; ++d0) qr[d0] = *reinterpret_cast<const bf16x8*>(Qw + d0 * 16); }
    NWRITE(0, skA, svA); NLOAD(1, skA, svA); __syncthreads();
#define PK4(P, BASE, OUT) do { unsigned a0 = mla::cvtpk(P[BASE + 0], P[BASE + 1]), a1 = mla::cvtpk(P[BASE + 2], P[BASE + 3]);   \
    unsigned b0 = mla::cvtpk(P[BASE + 4], P[BASE + 5]), b1 = mla::cvtpk(P[BASE + 6], P[BASE + 7]);                              \
    auto r0 = __builtin_amdgcn_permlane32_swap(a0, b0, false, false); auto r1 = __builtin_amdgcn_permlane32_swap(a1, b1, false, false); \
    u32x4 w = {r0[0], r1[0], r0[1], r1[1]}; OUT = *reinterpret_cast<bf16x8*>(&w); } while (0)
#define NA_TILE(j, SK, SV) do { \
        const int krow = sr0 + (j) - 4;                                            \
        if (!(lat && (j) >= 4) || (krow >= srw && krow < srw + 8)) { \
        const char* Kt = lds + ((j) & 1) * TILE_B + hl * 8192; const int vb = (int)(uintptr_t)(lds + ((j) & 1) * TILE_B + 16384 + hl * 8192) + mla::v_rd_base(lane); \
        f32x16 p0, p1; qkt64(p0, p1, Kt, qr, r32, hi); \
        if (lat && (j) >= 4) { const float* brow = rpbs + 64 + (hd * 15 + (krow - gr + 7)) * 32 + (4 * hi - cq + 15); const int vb2 = 4 * hi - sc; \
_Pragma("unroll") \
            for (int r = 0; r < 16; ++r) { const int k0 = (r & 3) + 8 * (r >> 2); \
                const float b0 = brow[k0], b1 = brow[k0 + 32]; \
                p0[r] = ((unsigned)(vb2 + k0) < 16u) ? p0[r] + 8.f * b0 : -1e30f; p1[r] = ((unsigned)(vb2 + k0 + 32) < 16u) ? p1[r] + 8.f * b1 : -1e30f; } } \
        float pmax = p0[0]; \
_Pragma("unroll") \
        for (int r = 1; r < 16; ++r) pmax = fmaxf(pmax, p0[r]); \
_Pragma("unroll") \
        for (int r = 0; r < 16; ++r) pmax = fmaxf(pmax, p1[r]); \
        { auto rr = __builtin_amdgcn_permlane32_swap(__float_as_uint(pmax), __float_as_uint(pmax), false, false); pmax = fmaxf(__uint_as_float(rr[0]), __uint_as_float(rr[1])); } \
        const float mn = fmaxf(m_reg, pmax), alpha = __builtin_amdgcn_exp2f((m_reg - mn) * C); m_reg = mn; const float mnC = -mn * C; \
        float ps = 0.f; \
_Pragma("unroll") \
        for (int r = 0; r < 16; ++r) { p0[r] = __builtin_amdgcn_exp2f(fmaf(p0[r], C, mnC)); p1[r] = __builtin_amdgcn_exp2f(fmaf(p1[r], C, mnC)); ps += p0[r] + p1[r]; } \
        { auto rr = __builtin_amdgcn_permlane32_swap(__float_as_uint(ps), __float_as_uint(ps), false, false); ps = __uint_as_float(rr[0]) + __uint_as_float(rr[1]); } \
        l_reg = l_reg * alpha + ps; \
        if (hi == 0) al_l[r32] = alpha; asm volatile("s_waitcnt lgkmcnt(0)" ::: "memory"); \
_Pragma("unroll") \
        for (int r = 0; r < 16; ++r) { const float f = al_l[mla::crow(r, hi)]; o0[r] *= f; o1[r] *= f; } \
        mla::bf16x8 pa0, pa1, pa2, pa3; \
        PK4(p0, 0, pa0); PK4(p0, 8, pa1); PK4(p1, 0, pa2); PK4(p1, 8, pa3); \
        mla::pv_d0(o0, o1, vb, pa0, pa1, pa2, pa3); } \
        if ((j) + 1 < ntile) { NWRITE(((j) + 1) & 1, SK, SV); if ((j) + 3 < ntile) NLOAD((j) + 3, SK, SV); } \
        __syncthreads(); } while (0)
    for (int j = 0; j < ntile; j += 2) { NA_TILE(j, skA, svA); if (j + 1 < ntile) NA_TILE(j + 1, skB, svB); }
#undef NA_TILE
#undef PK4
    if (hi == 0) li_l[r32] = l_reg; asm volatile("s_waitcnt lgkmcnt(0)" ::: "memory");
#pragma unroll
    for (int r = 0; r < 16; ++r) { const float rl = __builtin_amdgcn_rcpf(li_l[mla::crow(r, hi)]); o0[r] *= rl; o1[r] *= rl; }
    mla::store_tile_rows(lds + wid * 4608, o0, o1, abp + (size_t)(qrow0 + rsel * 64 + qh * 32) * D + 512 + hd * 64, D, lane);
#undef TROW
#undef NLOAD
#undef NWRITE
}
#undef KSWZ64
}
__device__ __forceinline__ void ph_na_fast(const Params& p, int l, unsigned char* lds_) {
    const int tid = otid();
    for (int u = blockIdx.x; u < 256; u += gridDim.x) {
        const int v = (gridDim.x == 256) ? (u & 7) * 32 + (u >> 3) : u, hp = v & 1, rp = (v >> 1) & 63, b = v >> 7;
        na::na_unit(p, l, b * SEQ + rp * 2 * GW, true, b, rp * 2, hp, (char*)lds_, tid);
    }
    if (l == 0) {
        const int first = gridDim.x >= 24 ? 16 : 0;
        for (int c = (int)blockIdx.x - first; c >= 0 && c < 8; c += gridDim.x) { const int b = c >> 2; na::na_unit(p, l, TL + b * CTX + ((c >> 1) & 1) * 128, false, b, 0, c & 1, (char*)lds_, tid); }
    }
}
__device__ __forceinline__ void ph_pool_fast(const Params& p, int l, unsigned char* lds_) {
    const int tid = otid();
    using mla::bf16x8; using mla::f32x16;
    const bf16* z = (const bf16*)(p.ws + WS_Z); bf16* abp = (bf16*)(p.ws + WS_ABP); const bf16* wpt = wl_ptr(p, l, WL_POOL); const float* ps = p.in[I_PSCALE] + l * PW;
    const int lane = tid & 63, r32 = lane & 31, hi = lane >> 5;
    const int nrow = (l == DEPTH - 1) ? TL : T;
    for (int it = GWAVE; it < (nrow / 32) * 4; it += GNW) {
        const int g = it & 3, row0 = (it >> 2) * 32, w = 2 << g, row = row0 + r32;
        int base, n, t; if (row < TL) { base = row & ~8191; n = SEQ; t = row & 8191; } else { base = TL + ((row - TL) & ~255); n = CTX; t = (row - TL) & 255; }
        int lo = t - w / 2; lo = lo < 0 ? 0 : lo; int hi_ = t + w / 2; hi_ = hi_ > n ? n : hi_;
        const float invn = 1.f / (float)(hi_ - lo);
        f32x16 acc0 = {}, acc1 = {};
        float a8[4][8];
#pragma unroll
        for (int s4 = 0; s4 < 4; ++s4)
#pragma unroll
            for (int j = 0; j < 8; ++j) a8[s4][j] = 0.f;
        const bf16* zc = z + Z_POOL + g * 64 + 8 * hi;
        for (int i = 0; i < w; i += 2) {
            const int ta = t - w / 2 + i, tb = ta + 1;
            const float fa = (ta >= 0 && ta < n) ? 1.f : 0.f, fb = (tb >= 0 && tb < n) ? 1.f : 0.f;
            const int tac = ta < 0 ? 0 : (ta >= n ? n - 1 : ta), tbc = tb < 0 ? 0 : (tb >= n ? n - 1 : tb);
            uint4 va[4], vb[4];
#pragma unroll
            for (int s4 = 0; s4 < 4; ++s4) { va[s4] = *(const uint4*)(zc + (size_t)(base + tac) * ZW + 16 * s4); vb[s4] = *(const uint4*)(zc + (size_t)(base + tbc) * ZW + 16 * s4); }
#pragma unroll
            for (int s4 = 0; s4 < 4; ++s4) { const unsigned xa_[4] = {va[s4].x, va[s4].y, va[s4].z, va[s4].w}, xb_[4] = {vb[s4].x, vb[s4].y, vb[s4].z, vb[s4].w};
#pragma unroll
                for (int j = 0; j < 4; ++j) { a8[s4][2 * j] += fa * __uint_as_float(xa_[j] << 16) + fb * __uint_as_float(xb_[j] << 16); a8[s4][2 * j + 1] += fa * __uint_as_float(xa_[j] & 0xffff0000u) + fb * __uint_as_float(xb_[j] & 0xffff0000u); } }
        }
#pragma unroll
        for (int s4 = 0; s4 < 4; ++s4) {
            const uint4 ov = *(const uint4*)(zc + (size_t)row * ZW + 16 * s4); const unsigned oo[4] = {ov.x, ov.y, ov.z, ov.w};
            mla::u32x4 aw;
#pragma unroll
            for (int j = 0; j < 4; ++j) aw[j] = mla::cvtpk(a8[s4][2 * j] * invn - __uint_as_float(oo[j] << 16), a8[s4][2 * j + 1] * invn - __uint_as_float(oo[j] & 0xffff0000u));
            const bf16x8 af = *reinterpret_cast<bf16x8*>(&aw);
            const bf16x8 b0 = *reinterpret_cast<const bf16x8*>(wpt + (size_t)(g * 64 + r32) * 64 + 16 * s4 + 8 * hi), b1 = *reinterpret_cast<const bf16x8*>(wpt + (size_t)(g * 64 + 32 + r32) * 64 + 16 * s4 + 8 * hi);
            acc0 = __builtin_amdgcn_mfma_f32_32x32x16_bf16(af, b0, acc0, 0, 0, 0);
            acc1 = __builtin_amdgcn_mfma_f32_32x32x16_bf16(af, b1, acc1, 0, 0, 0);
        }
        const float s0 = ps[g * 64 + r32], s1 = ps[g * 64 + 32 + r32];
        acc0 = acc0 * s0; acc1 = acc1 * s1;
        mla::store_tile_rows((char*)lds_ + (tid >> 6) * 4608, acc0, acc1, abp + (size_t)row0 * D + 768 + g * 64, D, lane);
    }
}


#define XB_TMO      128
#define XB_XCNT(j)  (256  + 64 * (j))
#define XB_XSUB(j)  (1280 + 64 * (j))
#define XB_XGEN(j)  (2304 + 64 * (j))
#define XB_TOP      3328
#define XB_TOPGEN   3392
#define XCD_BAR_WORDS 3456
#define XB_SPIN_CAP (1u << 18)
__device__ __forceinline__ unsigned xb_ld(unsigned* p)              { return __hip_atomic_load(p, __ATOMIC_RELAXED, __HIP_MEMORY_SCOPE_AGENT); }
__device__ __forceinline__ unsigned xb_add(unsigned* p, unsigned v) { return __hip_atomic_fetch_add(p, v, __ATOMIC_RELAXED, __HIP_MEMORY_SCOPE_AGENT); }
__device__ __forceinline__ unsigned xb_xcc_id() { return (unsigned)__builtin_amdgcn_s_getreg((3 << 11) | 20) & 0xFu; }
#define XB_SPIN(cond, bar) do { unsigned _sp = 0; while (cond) { __builtin_amdgcn_s_sleep(1); \
    if ((++_sp & 255u) == 0u) { if (xb_ld(&(bar)[XB_TMO])) break; if (_sp > XB_SPIN_CAP) { atomicAdd(&(bar)[XB_TMO], 1u); break; } } } } while (0)
struct XcdBarrier { unsigned* bar; unsigned x; volatile LAS unsigned* st; };
__device__ __forceinline__ XcdBarrier xcd_barrier_post(unsigned* bar, volatile LAS unsigned* st) {
    XcdBarrier b; b.bar = bar; b.x = xb_xcc_id(); b.st = st;
    if (threadIdx.x == 0) (void)xb_add(&bar[XB_XCNT(b.x)], 1u);
    return b;
}
__device__ __forceinline__ void xcd_barrier_complete(unsigned* bar, unsigned x, unsigned& nloc, unsigned& nx) {
    const unsigned G = gridDim.x * gridDim.y * gridDim.z;
    unsigned sum, cnt, mine, sp = 0u;
    for (;;) {
        sum = 0u; cnt = 0u; mine = 0u;
#pragma unroll
        for (unsigned j = 0; j < 16; ++j) { const unsigned c = xb_ld(&bar[XB_XCNT(j)]); sum += c; cnt += (c > 0u) ? 1u : 0u; mine = (j == x) ? c : mine; }
        if (sum == G) break;
        __builtin_amdgcn_s_sleep(1);
        if ((++sp & 255u) == 0u) { if (xb_ld(&bar[XB_TMO])) break; if (sp > XB_SPIN_CAP) { atomicAdd(&bar[XB_TMO], 1u); break; } }
    }
    nloc = mine > 0u ? mine : 1u; nx = cnt > 0u ? cnt : 1u;
}
__device__ __forceinline__ void xcd_barrier(const XcdBarrier& b) {
    asm volatile("s_waitcnt vmcnt(0)" ::: "memory");
    __syncthreads();
    if (threadIdx.x == 0) {
        unsigned* bar = b.bar;
        __builtin_amdgcn_s_waitcnt(0);
        unsigned nloc = b.st[0], nx = b.st[1];
        if (nloc == 0u) { xcd_barrier_complete(bar, b.x, nloc, nx); b.st[0] = nloc; b.st[1] = nx; }
        const unsigned old = xb_add(&bar[XB_XSUB(b.x)], 1u);
        const unsigned gen = old / nloc;
        if (old + 1u == (gen + 1u) * nloc) {
            __builtin_amdgcn_fence(__ATOMIC_RELEASE, "agent");
            asm volatile("s_waitcnt vmcnt(0)" ::: "memory");
            const unsigned og = xb_add(&bar[XB_TOP], 1u);
            const unsigned tg = og / nx;
            if (og + 1u == (tg + 1u) * nx) xb_add(&bar[XB_TOPGEN], 1u);
            else XB_SPIN(xb_ld(&bar[XB_TOPGEN]) == tg, bar);
            __builtin_amdgcn_fence(__ATOMIC_ACQUIRE, "agent");
            xb_add(&bar[XB_XGEN(b.x)], 1u);
            asm volatile("s_waitcnt vmcnt(0)" ::: "memory");
        } else {
            XB_SPIN(xb_ld(&bar[XB_XGEN(b.x)]) == gen, bar);
            __builtin_amdgcn_fence(__ATOMIC_ACQUIRE, "agent");
            asm volatile("s_waitcnt vmcnt(0)" ::: "memory");
        }
    }
    __syncthreads();
}

#ifndef FAST_INPROJ
#define FAST_INPROJ 1
#endif
#ifndef FAST_MLAPROJ
#define FAST_MLAPROJ 1
#endif
#ifndef FAST_MERGE
#define FAST_MERGE 1
#endif
#ifndef FAST_OUTPROJ
#define FAST_OUTPROJ 1
#endif
#ifndef FAST_MOEUP
#define FAST_MOEUP 1
#endif
#ifndef FAST_MOEDOWN
#define FAST_MOEDOWN 1
#endif
#ifndef FAST_MLA
#define FAST_MLA 1
#endif
#ifndef MLA_V2
#define MLA_V2 1
#endif
#ifndef FAST_NA
#define FAST_NA 1
#endif
#ifndef FAST_POOL
#define FAST_POOL 1
#endif
#ifndef PROBE_PHASE
#define PROBE_PHASE -1
#endif
#ifndef PROBE_N
#define PROBE_N 1
#endif
constexpr int LDS_BYTES = 147456;
__global__ void __launch_bounds__(NT) mega(Params p) {
    extern __shared__ __attribute__((aligned(16))) unsigned char lds[];
    cg::grid_group grid = cg::this_grid();
    { volatile LAS unsigned* st = (volatile LAS unsigned*)((LAS unsigned char*)lds + LDS_BYTES - 16); if (threadIdx.x < 4) st[threadIdx.x] = 0u; }
    __syncthreads();
    const XcdBarrier xbar = xcd_barrier_post((unsigned*)(p.ws + WS_CTL), (volatile LAS unsigned*)((LAS unsigned char*)lds + LDS_BYTES - 16));
#define GSYNC() xcd_barrier(xbar)
#define REPS(k) (1 + ((PROBE_PHASE == (k)) ? PROBE_N : 0))
    for (int rep = 0; rep < REPS(0); ++rep) {
        ph_mod(p, lds);
        if (gridDim.x != 256) grid.sync(); else GSYNC();
        ph_h1(p, 0);
        ph_cvt(p, lds);
        GSYNC();
    }
    for (int rep = 0; rep < REPS(10) - 1; ++rep) { GSYNC(); GSYNC(); GSYNC(); GSYNC(); GSYNC(); GSYNC(); GSYNC(); GSYNC(); GSYNC(); GSYNC(); }
    for (int l = 0; l < DEPTH; ++l) {
        for (int rep = 0; rep < REPS(1); ++rep) { ph_inproj_fast(p, l, lds); GSYNC(); }
        for (int rep = 0; rep < REPS(2); ++rep) { ph_mlaproj_fast(p, l, lds); GSYNC(); }
        for (int rep = 0; rep < REPS(3); ++rep) {
            for (int r2 = 0; r2 < REPS(11); ++r2) ph_mla_fast(p, l, lds);
            for (int r2 = 0; r2 < REPS(12); ++r2) ph_na_fast(p, l, lds);
            for (int r2 = 0; r2 < REPS(13); ++r2) ph_pool_fast(p, l, lds);
            GSYNC();
        }
        for (int rep = 0; rep < REPS(4); ++rep) { ph_merge_fast(p, l, lds); GSYNC(); }
        ph_outproj_fast(p, l, lds);
        GSYNC();
        for (int rep = 0; rep < REPS(6); ++rep) { ph_h2router(p, l, lds); GSYNC(); }
        for (int rep = 0; rep < REPS(7); ++rep) { ph_topk(p, lds); GSYNC(); }
        for (int rep = 0; rep < REPS(8); ++rep) { ph_moeup_fast(p, l, lds); GSYNC(); }
        for (int rep = 0; rep < REPS(9); ++rep) { ph_moedown_fast(p, l, lds); GSYNC(); }
        ph_combine(p, l);
        GSYNC();
    }
}

extern "C" void kernel_launch(void* const* d_in, const int* in_sizes, int n_in, void* d_out, int out_size, void* d_ws, size_t ws_size, hipStream_t stream) {
    static int grid_blocks = 0;
    if (grid_blocks == 0) {
        if (n_in != 25 || ws_size < WS_END) { fprintf(stderr, "kernel_launch: n_in %d ws %zu (need %zu)\n", n_in, ws_size, (size_t)WS_END); grid_blocks = -1; return; }
        int dev = 0, cus = 0, per_cu = 0;
        (void)hipGetDevice(&dev);
        (void)hipDeviceGetAttribute(&cus, hipDeviceAttributeMultiprocessorCount, dev);
        if (hipFuncSetAttribute((const void*)mega, hipFuncAttributeMaxDynamicSharedMemorySize, LDS_BYTES) != hipSuccess) { fprintf(stderr, "kernel_launch: hipFuncSetAttribute failed\n"); grid_blocks = -1; return; }
        (void)hipOccupancyMaxActiveBlocksPerMultiprocessor(&per_cu, (const void*)mega, NT, LDS_BYTES);
        if (per_cu < 1) { fprintf(stderr, "kernel_launch: occupancy query says %d\n", per_cu); grid_blocks = -1; return; }
        grid_blocks = cus;
    }
    if (grid_blocks < 0) return;
    if (hipMemsetAsync((char*)d_ws + WS_CTL, 0, CTL_BYTES, stream) != hipSuccess) { fprintf(stderr, "kernel_launch: memset failed\n"); return; }
    Params p{};
    for (int i = 0; i < 25; ++i) p.in[i] = (const float*)d_in[i];
    p.out = (float*)d_out; p.ws = (unsigned char*)d_ws;
    void* args[] = {&p};
    hipError_t e = hipLaunchCooperativeKernel((const void*)mega, dim3(grid_blocks), dim3(NT), args, LDS_BYTES, stream);
    if (e != hipSuccess) fprintf(stderr, "cooperative launch failed: %s (grid %d)\n", hipGetErrorString(e), grid_blocks);
}
```

```cpp
#include <hip/hip_runtime.h>
#include <hip/hip_cooperative_groups.h>
#include <cstdio>
#include <cstdint>
namespace cg = cooperative_groups;
#ifndef MLA_ILV
#define MLA_ILV 1
#endif
#ifndef PG_ALIGN
#define PG_ALIGN 1
#endif
#ifndef PG_SP2
#define PG_SP2 1
#endif
#ifndef MLA_V2
#define MLA_V2 1
#endif

constexpr int D = 1024, NB = 2, SEQ = 8192, DEPTH = 2, GW = 64, CTX = 256;
constexpr int TL = NB * SEQ;
constexpr int T = TL + NB * CTX;
constexpr int QR = 384, KVR = 256, ROPE = 32, NAW = 256, PW = 256;
constexpr int DIN = 4768;
constexpr int ZW = 4864;
constexpr int Z_CQ = 0, Z_CKV = 384, Z_NA = 640, Z_POOL = 1408, Z_GATE = 1664, Z_KR = 4736;
constexpr int MH = 8, QKD = 96, VD = 64, QW = MH * QKD  , AW = MH * VD  , KVW = MH * 128  ;
constexpr int NKEY = CTX + SEQ;
constexpr int NE = 16, FF = 2048, CAPL = 1024, CAPC = 32;
constexpr int ER = 2304;
constexpr int ERV = 2112;
constexpr float EPS = 1e-6f;
constexpr int NT = 512;

constexpr size_t MiB = 1u << 20;
constexpr size_t WS_MOD = 0;
constexpr size_t WS_ROPE = 512 * 1024;
constexpr size_t WS_RS = 1 * MiB;
constexpr size_t WS_AFF = 2 * MiB;
constexpr size_t WS_SLOT = 4 * MiB;
constexpr size_t WS_GVX = 6 * MiB;
constexpr size_t WS_SEL = 6 * MiB + 512 * 1024;
constexpr size_t WS_CTL = 7 * MiB;
constexpr size_t CTL_BYTES = 65536;
constexpr size_t WS_H = 8 * MiB;
constexpr size_t WS_XA = 42 * MiB;
constexpr size_t WS_Z = 108 * MiB;
constexpr size_t WS_ACT = WS_Z;
constexpr size_t WS_Q = 265 * MiB;
constexpr size_t WS_KB = 290 * MiB;
constexpr size_t WS_VB = 315 * MiB;
constexpr size_t WS_ABP = 332 * MiB;
constexpr size_t WS_XS = 265 * MiB;
constexpr size_t WS_M = 366 * MiB;
constexpr size_t WS_TMP = 400 * MiB;
constexpr size_t WS_Y = 366 * MiB;
constexpr size_t WS_SLAB = 440 * MiB;
constexpr size_t WS_W = 466 * MiB;
constexpr size_t WS_END = 880 * MiB;

typedef unsigned short bf16;
__device__ __forceinline__ bf16 f2bf(float f) { unsigned u = __float_as_uint(f); u += 0x7fffu + ((u >> 16) & 1u); return (bf16)(u >> 16); }
__device__ __forceinline__ float bf2f(bf16 b) { return __uint_as_float(((unsigned)b) << 16); }
__device__ __forceinline__ float sigmoidf_(float x) { return 1.f / (1.f + __expf(-x)); }
__device__ __forceinline__ float siluf_(float x) { return x / (1.f + __expf(-x)); }
__device__ __forceinline__ float wave_sum(float v) {
#pragma unroll
    for (int o = 1; o < 64; o <<= 1) v += __shfl_xor(v, o);
    return v;
}

struct Params {
    const float* in[25];
    float* out;
    unsigned char* ws;
};
enum { I_X = 0, I_C, I_CTX, I_CCTX, I_N1G, I_N2G, I_WADA, I_BADA, I_WIN, I_QNORM, I_KVNORM, I_WUQ, I_WUKV, I_RPB, I_WPOOL, I_PSCALE,
       I_WBRM, I_WBRN, I_WBRP, I_WOUT, I_WROUTER, I_WGATE, I_WUP, I_WDOWN, I_FINALG };

__device__ __forceinline__ int row_set(int r) { return r < TL ? (r >> 13) : 2 + ((r - TL) >> 8); }
__device__ __forceinline__ int row_modv(int r) { return r < TL ? (r >> 13) : 2; }
__device__ __forceinline__ int row_krow(int r) { return r < TL ? ((r >> 13) * NKEY + CTX + (r & 8191)) : (((r - TL) >> 8) * NKEY + ((r - TL) & 255)); }

__device__ __forceinline__ int otid() { int t = threadIdx.x; asm volatile("" : "+v"(t)); return t; }
__device__ __forceinline__ int oblk() { int b = blockIdx.x; asm volatile("" : "+s"(b)); return b; }
#define GTID ((long)blockIdx.x * NT + tid)
#define GTOT ((long)gridDim.x * NT)
#define GWAVE ((int)(blockIdx.x * (NT / 64) + (tid >> 6)))
#define GNW ((int)(gridDim.x * (NT / 64)))

__device__ __forceinline__ void ph_mod(const Params& p, unsigned char* lds_) {
    const int tid = otid();
    float* mod = (float*)(p.ws + WS_MOD);
    { float* sc = (float*)lds_;
      float* part = sc + 3 * D;
      const int lane = tid & 63, wid = tid >> 6;
      for (int i = tid; i < 3 * D; i += NT) { const int v = i >> 10, k = i & 1023; sc[i] = siluf_(v < 2 ? p.in[I_C][v * D + k] : p.in[I_CCTX][k]); }
      __syncthreads();
      for (int task = blockIdx.x; task < 2 * 96; task += gridDim.x) {
          const int l = task / 96, col = (task % 96) * 64 + lane;
          const float* w = p.in[I_WADA] + (size_t)l * D * 6144 + (size_t)(wid * 128) * 6144 + col;
          float s0 = 0.f, s1 = 0.f, s2 = 0.f;
#pragma unroll 16
          for (int k = 0; k < 128; ++k) { const float wv = w[(size_t)k * 6144]; const int kk = wid * 128 + k; s0 += sc[kk] * wv; s1 += sc[D + kk] * wv; s2 += sc[2 * D + kk] * wv; }
          part[(wid * 3 + 0) * 64 + lane] = s0; part[(wid * 3 + 1) * 64 + lane] = s1; part[(wid * 3 + 2) * 64 + lane] = s2;
          __syncthreads();
          if (tid < 192) { const int v = tid >> 6; float a = p.in[I_BADA][l * 6144 + (task % 96) * 64 + lane];
#pragma unroll
              for (int w8 = 0; w8 < 8; ++w8) a += part[(w8 * 3 + v) * 64 + lane];
              mod[(size_t)(l * 3 + v) * 6144 + (task % 96) * 64 + lane] = a; }
          __syncthreads();
      } }
    float* rope = (float*)(p.ws + WS_ROPE);
    for (long o = GTID; o < (128 + 64) * 8; o += GTOT) {
        int i = (int)(o & 7), pos = (int)(o >> 3); if (pos >= 128) pos -= 128;
        const float inv[8] = {1.0f, 0.316227766f, 0.1f, 0.0316227766f, 0.01f, 0.00316227766f, 0.001f, 0.000316227766f};
        float invv = i == 0 ? inv[0] : i == 1 ? inv[1] : i == 2 ? inv[2] : i == 3 ? inv[3] : i == 4 ? inv[4] : i == 5 ? inv[5] : i == 6 ? inv[6] : inv[7];
        float angf = (float)pos * invv;
        double a = (double)angf;
        double n = rint(a * 0.15915494309189535);
        double r = a - n * 6.283185307179586476925;
        double q = r * 0.25, q2 = q * q;
        double sn = q * (1.0 + q2 * (-1.0 / 6 + q2 * (1.0 / 120 + q2 * (-1.0 / 5040 + q2 * (1.0 / 362880 + q2 * (-1.0 / 39916800 + q2 * (1.0 / 6227020800.0)))))));
        double cs = 1.0 + q2 * (-0.5 + q2 * (1.0 / 24 + q2 * (-1.0 / 720 + q2 * (1.0 / 40320 + q2 * (-1.0 / 3628800 + q2 * (1.0 / 479001600.0 + q2 * (-1.0 / 87178291200.0)))))));
        double s2 = 2 * sn * cs, c2 = 2 * cs * cs - 1;
        double s4 = 2 * s2 * c2, c4 = 2 * c2 * c2 - 1;
        rope[o * 2] = (float)c4; rope[o * 2 + 1] = (float)s4;
    }
}

__device__ __forceinline__ void load_row4(const float* xr, int lane, float4 (&x)[4]) {
#pragma unroll
    for (int j = 0; j < 4; ++j) x[j] = *(const float4*)(xr + 4 * lane + 256 * j);
}
__device__ __forceinline__ void modulate_vals(const float4 (&x)[4], const float* g, const float* sh, const float* sc, int lane, float (&v)[16]) {
    float ss = 0.f;
#pragma unroll
    for (int j = 0; j < 4; ++j) { const float4 t = x[j]; v[4 * j] = t.x; v[4 * j + 1] = t.y; v[4 * j + 2] = t.z; v[4 * j + 3] = t.w; ss += t.x * t.x + t.y * t.y + t.z * t.z + t.w * t.w; }
    ss = wave_sum(ss);
    const float rs = rsqrtf(ss * (1.f / D) + EPS);
#pragma unroll
    for (int j = 0; j < 4; ++j) {
        const float4 gg = *(const float4*)(g + 4 * lane + 256 * j), s1 = *(const float4*)(sc + 4 * lane + 256 * j), s0 = *(const float4*)(sh + 4 * lane + 256 * j);
        v[4 * j] = v[4 * j] * rs * gg.x * (1.f + s1.x) + s0.x; v[4 * j + 1] = v[4 * j + 1] * rs * gg.y * (1.f + s1.y) + s0.y;
        v[4 * j + 2] = v[4 * j + 2] * rs * gg.z * (1.f + s1.z) + s0.z; v[4 * j + 3] = v[4 * j + 3] * rs * gg.w * (1.f + s1.w) + s0.w;
    }
}
__device__ __forceinline__ void modulate_row(const float* xr, const float* g, const float* sh, const float* sc, int lane, float (&v)[16]) {
    float4 x[4]; load_row4(xr, lane, x); modulate_vals(x, g, sh, sc, lane, v);
}
__device__ __forceinline__ void store_row_bf16(bf16* orow, int lane, const float (&v)[16]) {
#pragma unroll
    for (int j = 0; j < 4; ++j) {
        uint2 w; w.x = (unsigned)f2bf(v[4 * j]) | ((unsigned)f2bf(v[4 * j + 1]) << 16); w.y = (unsigned)f2bf(v[4 * j + 2]) | ((unsigned)f2bf(v[4 * j + 3]) << 16);
        *(uint2*)(orow + 4 * lane + 256 * j) = w;
    }
}
__device__ __forceinline__ const float* src_row(const Params& p, int l, int r) {
    if (l == 0) return r < TL ? p.in[I_X] + (size_t)r * D : p.in[I_CTX] + (size_t)(r - TL) * D;
    return (const float*)(p.ws + WS_XA) + (size_t)r * D;
}
__device__ __forceinline__ void ph_h1(const Params& p, int l) {
    const int tid = otid();
    const float* mod = (const float*)(p.ws + WS_MOD) + (size_t)l * 3 * 6144;
    bf16* h = (bf16*)(p.ws + WS_H);
    const int lane = tid & 63;
    float4 cur[4]; if (GWAVE < T) load_row4(src_row(p, l, GWAVE), lane, cur);
    for (int r = GWAVE; r < T; r += GNW) {
        float4 nx[4]; const int rn = r + GNW; if (rn < T) load_row4(src_row(p, l, rn), lane, nx);
        const float* mv = mod + row_modv(r) * 6144;
        float v[16]; modulate_vals(cur, p.in[I_N1G] + l * D, mv + 0 * D, mv + 1 * D, lane, v);
#pragma unroll
        for (int j = 0; j < 4; ++j) cur[j] = nx[j];
        store_row_bf16(h + (size_t)r * D, lane, v);
    }
}
__device__ __forceinline__ void rope_pair(const float* rope, int r, int d  , float xa, float xb  , float& out) {
    const int t = r & 8191, pos = (d < 16) ? (t >> 6) : 128 + (t & 63);
    const float cs = rope[(pos * 8 + (d & 7)) * 2], sn = rope[(pos * 8 + (d & 7)) * 2 + 1];
    out = (d & 8) ? (xa * cs + xb * sn) : (xa * cs - xb * sn);
}
__device__ __forceinline__ void ph_h2router(const Params& p, int l, unsigned char* lds_) {
    const int tid = otid();
    const float* mod = (const float*)(p.ws + WS_MOD) + (size_t)l * 3 * 6144; const float* xa = (const float*)(p.ws + WS_XA);
    bf16* h = (bf16*)(p.ws + WS_H); float* aff = (float*)(p.ws + WS_AFF); const float* wr = p.in[I_WROUTER] + (size_t)l * D * NE;
    const int lane = tid & 63;
    float* wrT = (float*)lds_;
    __syncthreads();
    for (int i = tid; i < D * NE; i += NT) { const int k = i >> 4, e = i & 15; wrT[e * D + k] = wr[i]; }
    __syncthreads();
    float4 cur[4]; if (GWAVE < T) load_row4(xa + (size_t)GWAVE * D, lane, cur);
    for (int r = GWAVE; r < T; r += GNW) {
        float4 nx[4]; const int rn = r + GNW; if (rn < T) load_row4(xa + (size_t)rn * D, lane, nx);
        const float* mv = mod + row_modv(r) * 6144;
        if (r >= TL && l != DEPTH - 1 && gridDim.x == 256) {
            const float* cin = p.in[I_CTX] + (size_t)(r - TL) * D; const float* sp = (const float*)(p.ws + WS_SLAB) + (size_t)(r - TL) * D; float* xw = (float*)(p.ws + WS_XA) + (size_t)r * D;
#pragma unroll
            for (int j = 0; j < 4; ++j) { const int c = 4 * lane + 256 * j; const float4 a = *(const float4*)(cin + c), g = *(const float4*)(mv + 2 * D + c);
                const float4 s0 = *(const float4*)(sp + c), s1 = *(const float4*)(sp + (size_t)512 * D + c), s2 = *(const float4*)(sp + (size_t)2 * 512 * D + c), s3 = *(const float4*)(sp + (size_t)3 * 512 * D + c);
                float4 t; t.x = a.x + g.x * (((s0.x + s1.x) + s2.x) + s3.x); t.y = a.y + g.y * (((s0.y + s1.y) + s2.y) + s3.y); t.z = a.z + g.z * (((s0.z + s1.z) + s2.z) + s3.z); t.w = a.w + g.w * (((s0.w + s1.w) + s2.w) + s3.w);
                cur[j] = t; *(float4*)(xw + c) = t; } }
        float v[16]; modulate_vals(cur, p.in[I_N2G] + l * D, mv + 3 * D, mv + 4 * D, lane, v);
#pragma unroll
        for (int j = 0; j < 4; ++j) cur[j] = nx[j];
        store_row_bf16(h + (size_t)r * D, lane, v);
        float lg[NE];
        const float* wl = wrT + 4 * lane; asm volatile("" : "+v"(wl));
#pragma unroll
        for (int e = 0; e < NE; ++e) { float a = 0.f;
#pragma unroll
            for (int j = 0; j < 4; ++j) { const float4 w4 = *(const float4*)(wl + e * D + 256 * j); a += v[4 * j] * w4.x + v[4 * j + 1] * w4.y + v[4 * j + 2] * w4.z + v[4 * j + 3] * w4.w; }
            lg[e] = a; }
        float r1[8], r2[4], r3[2], r4;
        { const bool up = lane & 32;
#pragma unroll
          for (int i = 0; i < 8; ++i) { const float snd = up ? lg[i] : lg[8 + i]; const float keep = up ? lg[8 + i] : lg[i]; r1[i] = keep + __shfl_xor(snd, 32); } }
        { const bool up = lane & 16;
#pragma unroll
          for (int i = 0; i < 4; ++i) { const float snd = up ? r1[i] : r1[4 + i]; const float keep = up ? r1[4 + i] : r1[i]; r2[i] = keep + __shfl_xor(snd, 16); } }
        { const bool up = lane & 8;
#pragma unroll
          for (int i = 0; i < 2; ++i) { const float snd = up ? r2[i] : r2[2 + i]; const float keep = up ? r2[2 + i] : r2[i]; r3[i] = keep + __shfl_xor(snd, 8); } }
        { const bool up = lane & 4; const float snd = up ? r3[0] : r3[1]; const float keep = up ? r3[1] : r3[0]; r4 = keep + __shfl_xor(snd, 4); }
        r4 += __shfl_xor(r4, 2); r4 += __shfl_xor(r4, 1);
        float mx = r4;
#pragma unroll
        for (int o = 4; o < 64; o <<= 1) mx = fmaxf(mx, __shfl_xor(mx, o));
        const float ex = expf(r4 - mx); float sum = ex;
#pragma unroll
        for (int o = 4; o < 64; o <<= 1) sum += __shfl_xor(sum, o);
        if ((lane & 3) == 0) aff[(size_t)r * NE + (lane >> 2)] = ex / sum;
    }
}
__device__ __forceinline__ void ph_topk(const Params& p, unsigned char* lds) {
    const int tid = otid();
    const float* aff = (const float*)(p.ws + WS_AFF); int* slotm = (int*)(p.ws + WS_SLOT); float* gvx = (float*)(p.ws + WS_GVX); int* selrow = (int*)(p.ws + WS_SEL);
    const int lane = tid & 63, wid = tid >> 6;
    unsigned* keys = (unsigned*)lds;
    unsigned* hist = keys + 8192;
    unsigned* wtot = hist + 256;
    unsigned* ctl = wtot + 8;
    for (int prob = blockIdx.x; prob < 64; prob += gridDim.x) {
        const int s = prob >> 4, e = prob & 15;
        const int N = s < 2 ? SEQ : CTX, cap = N / 8, row0 = s < 2 ? s * SEQ : TL + (s - 2) * CTX, base = s < 2 ? s * CAPL : 2 * CAPL + (s - 2) * CAPC;
        __syncthreads();
        for (int i = tid; i < N; i += NT) keys[i] = __float_as_uint(aff[(size_t)(row0 + i) * NE + e]);
        unsigned prefix = 0, mask = 0; int remaining = cap;
        for (int pass = 3; pass >= 0; --pass) {
            const int shift = pass * 8;
            if (tid < 256) hist[tid] = 0;
            __syncthreads();
            for (int i = tid; i < N; i += NT) { const unsigned k = keys[i]; if ((k & mask) == prefix) atomicAdd(&hist[(k >> shift) & 255], 1u); }
            __syncthreads();
            if (wid == 0) {
                const unsigned h0 = hist[4 * lane], h1 = hist[4 * lane + 1], h2 = hist[4 * lane + 2], h3 = hist[4 * lane + 3], tot = h0 + h1 + h2 + h3;
                unsigned inc = tot;
#pragma unroll
                for (int o = 1; o < 64; o <<= 1) { const unsigned t = __shfl_down(inc, o); if (lane + o < 64) inc += t; }
                const unsigned above = inc - tot, rem = (unsigned)remaining;
                if (above < rem && rem <= above + tot) { unsigned r = rem - above; int b;
                    if (h3 >= r) b = 3; else { r -= h3; if (h2 >= r) b = 2; else { r -= h2; if (h1 >= r) b = 1; else { r -= h1; b = 0; } } }
                    ctl[0] = (unsigned)(4 * lane + b); ctl[1] = r; }
            }
            __syncthreads();
            prefix |= ctl[0] << shift; mask |= 255u << shift; remaining = (int)ctl[1];
            __syncthreads();
        }
        const unsigned Tk = prefix; const int need = remaining;
        const int CH = N >= NT ? N / NT : 1; const bool act = tid * CH < N;
        unsigned cnt = 0;
        if (act) for (int j = 0; j < CH; ++j) { const unsigned k = keys[tid * CH + j]; cnt += (k > Tk ? 1u : 0u) + (k == Tk ? 65536u : 0u); }
        unsigned inc = cnt;
#pragma unroll
        for (int o = 1; o < 64; o <<= 1) { const unsigned t = __shfl_up(inc, o); if (lane >= o) inc += t; }
        if (lane == 63) wtot[wid] = inc;
        __syncthreads();
        unsigned off = 0; for (int w = 0; w < wid; ++w) off += wtot[w];
        unsigned excl = off + inc - cnt;
        int gtb = (int)(excl & 0xffffu), eqb = (int)(excl >> 16);
        if (act) for (int j = 0; j < CH; ++j) {
            const int i = tid * CH + j; const unsigned k = keys[i]; const int row = row0 + i; int er = -1;
            if (k > Tk) { er = base + gtb + (eqb < need ? eqb : need); ++gtb; }
            else if (k == Tk) { if (eqb < need) er = base + gtb + eqb; ++eqb; }
            slotm[(size_t)row * NE + e] = er;
            if (er >= 0) { gvx[e * ER + er] = __uint_as_float(k); selrow[e * ER + er] = row; }
        }
    }
    if (blockIdx.x >= 64 || gridDim.x <= 64) {
        const int nb = gridDim.x > 64 ? gridDim.x - 64 : gridDim.x, bi = gridDim.x > 64 ? blockIdx.x - 64 : blockIdx.x;
        for (int i = bi * NT + tid; i < NE * (ER - ERV); i += nb * NT) { const int e = i / (ER - ERV), r = ERV + i % (ER - ERV); gvx[e * ER + r] = 0.f; selrow[e * ER + r] = 0; }
    }
}
__device__ __forceinline__ void ph_combine(const Params& p, int l) {
    const int tid = otid();
    const float* modl = (const float*)(p.ws + WS_MOD) + (size_t)l * 3 * 6144;
    float* xa = (float*)(p.ws + WS_XA); const int* slotm = (const int*)(p.ws + WS_SLOT); const bf16* y = (const bf16*)(p.ws + WS_Y); bf16* h = (bf16*)(p.ws + WS_H);
    const int lane = tid & 63; const bool last = (l == DEPTH - 1); const int RN = last ? TL : T;
    float4 cur[4]; int scur = -1;
    if (GWAVE < RN) { load_row4(xa + (size_t)GWAVE * D, lane, cur); scur = slotm[(size_t)GWAVE * NE + (lane & 15)]; }
    for (int r = GWAVE; r < RN; r += GNW) {
        float4 nx[4]; int snx = -1; const int rn = r + GNW;
        if (rn < RN) { load_row4(xa + (size_t)rn * D, lane, nx); snx = slotm[(size_t)rn * NE + (lane & 15)]; }
        const float* g2 = modl + row_modv(r) * 6144 + 5 * D;
        float acc[16];
#pragma unroll
        for (int j = 0; j < 16; ++j) acc[j] = 0.f;
        const bool fromslab = (r >= TL) && !last && gridDim.x == 256;
        if (fromslab) {
#pragma unroll
            for (int e = 0; e < NE; ++e) {
                const int er = __builtin_amdgcn_readlane(scur, e);
                if (er >= 0) {
#pragma unroll
                    for (int q = 0; q < 4; ++q) { const float* sp = (const float*)(p.ws + WS_SLAB) + (((size_t)q * NE + e) * 64 + (er - 2 * CAPL)) * D;
#pragma unroll
                        for (int j = 0; j < 4; ++j) { const float4 w = *(const float4*)(sp + 4 * lane + 256 * j); acc[4 * j] += w.x; acc[4 * j + 1] += w.y; acc[4 * j + 2] += w.z; acc[4 * j + 3] += w.w; } }
                }
            }
        } else {
            unsigned sm = (unsigned)__ballot(scur >= 0) & 0xffffu;
            while (sm) {
                uint2 w[4][4]; bool on[4];
#pragma unroll
                for (int k = 0; k < 4; ++k) { on[k] = sm != 0u;
                    if (on[k]) { const int e = __builtin_ctz(sm); sm &= sm - 1u; const int er = __builtin_amdgcn_readlane(scur, e); const bf16* yr = y + ((size_t)e * ER + er) * D;
#pragma unroll
                        for (int j = 0; j < 4; ++j) w[k][j] = *(const uint2*)(yr + 4 * lane + 256 * j); } }
#pragma unroll
                for (int k = 0; k < 4; ++k) if (on[k]) {
#pragma unroll
                    for (int j = 0; j < 4; ++j) { const uint2 ww = w[k][j];
                        acc[4 * j] += bf2f((bf16)(ww.x & 0xffff)); acc[4 * j + 1] += bf2f((bf16)(ww.x >> 16)); acc[4 * j + 2] += bf2f((bf16)(ww.y & 0xffff)); acc[4 * j + 3] += bf2f((bf16)(ww.y >> 16)); } }
            }
        }
        float v[16]; float ss = 0.f;
        float* xr = xa + (size_t)r * D;
#pragma unroll
        for (int j = 0; j < 4; ++j) { const float4 t = cur[j], g = *(const float4*)(g2 + 4 * lane + 256 * j);
            v[4 * j] = t.x + g.x * acc[4 * j]; v[4 * j + 1] = t.y + g.y * acc[4 * j + 1]; v[4 * j + 2] = t.z + g.z * acc[4 * j + 2]; v[4 * j + 3] = t.w + g.w * acc[4 * j + 3];
            ss += v[4 * j] * v[4 * j] + v[4 * j + 1] * v[4 * j + 1] + v[4 * j + 2] * v[4 * j + 2] + v[4 * j + 3] * v[4 * j + 3]; }
        ss = wave_sum(ss); const float rs = rsqrtf(ss * (1.f / D) + EPS);
        if (last) {
            const float* fg = p.in[I_FINALG]; float* orow = p.out + (size_t)r * D;
#pragma unroll
            for (int j = 0; j < 4; ++j) { const float4 g = *(const float4*)(fg + 4 * lane + 256 * j);
                *(float4*)(orow + 4 * lane + 256 * j) = make_float4(v[4 * j] * rs * g.x, v[4 * j + 1] * rs * g.y, v[4 * j + 2] * rs * g.z, v[4 * j + 3] * rs * g.w); }
        } else {
#pragma unroll
            for (int j = 0; j < 4; ++j) *(float4*)(xr + 4 * lane + 256 * j) = make_float4(v[4 * j], v[4 * j + 1], v[4 * j + 2], v[4 * j + 3]);
            const float* mn = (const float*)(p.ws + WS_MOD) + (size_t)(l + 1) * 3 * 6144 + row_modv(r) * 6144; const float* g1n = p.in[I_N1G] + (l + 1) * D;
            float hv[16];
#pragma unroll
            for (int j = 0; j < 4; ++j) { const float4 gg = *(const float4*)(g1n + 4 * lane + 256 * j), s1 = *(const float4*)(mn + D + 4 * lane + 256 * j), s0 = *(const float4*)(mn + 4 * lane + 256 * j);
                hv[4 * j] = v[4 * j] * rs * gg.x * (1.f + s1.x) + s0.x; hv[4 * j + 1] = v[4 * j + 1] * rs * gg.y * (1.f + s1.y) + s0.y;
                hv[4 * j + 2] = v[4 * j + 2] * rs * gg.z * (1.f + s1.z) + s0.z; hv[4 * j + 3] = v[4 * j + 3] * rs * gg.w * (1.f + s1.w) + s0.w; }
            store_row_bf16(h + (size_t)r * D, lane, hv);
        }
#pragma unroll
        for (int j = 0; j < 4; ++j) cur[j] = nx[j];
        scur = snx;
    }
}


constexpr size_t WL_IN = 0;
constexpr size_t WL_UQ = WL_IN + (size_t)ZW * D;
constexpr size_t WL_UKV = WL_UQ + (size_t)QW * QR;
constexpr size_t WL_CAT = WL_UKV + (size_t)KVW * KVR;
constexpr size_t WL_OUT = WL_CAT + (size_t)D * D;
constexpr size_t WL_POOL = WL_OUT + (size_t)D * D;
constexpr size_t WL_GU = WL_POOL + 4 * 64 * 64;
constexpr size_t WL_DN = WL_GU + (size_t)NE * 2 * FF * D;
constexpr size_t WL_SIZE = WL_DN + (size_t)NE * D * FF;
static_assert(WS_W + 2 * WL_SIZE * 2 <= WS_END, "weight region");
__device__ __forceinline__ bf16* wl_ptr(const Params& p, int l, size_t off) { return (bf16*)(p.ws + WS_W) + (size_t)l * WL_SIZE + off; }

#define LAS __attribute__((address_space(3)))
struct CvtJob { const float* W; int K, N; bf16* dst; int dstride, koff, map; const float* kscale; };
constexpr int CVT_PER_LAYER = 1200 + 72 + 64 + 128 + 64 + 64 + 256 + 4 + 3 * 8192;
__device__ __forceinline__ void cvt_decode(const Params& p, int it, CvtJob& j, int& item) {
    const int l = it / CVT_PER_LAYER; int r = it % CVT_PER_LAYER;
    j.koff = 0; j.map = 0; j.kscale = nullptr;
    if (r < 1200) { j.W = p.in[I_WIN] + (size_t)l * D * DIN; j.K = D; j.N = DIN; j.dst = wl_ptr(p, l, WL_IN); j.dstride = D; j.map = 1; item = r; return; } r -= 1200;
    if (r < 72) { j.W = p.in[I_WUQ] + (size_t)l * QR * QW; j.K = QR; j.N = QW; j.dst = wl_ptr(p, l, WL_UQ); j.dstride = QR; j.kscale = p.in[I_QNORM] + l * QR; item = r; return; } r -= 72;
    if (r < 64) { j.W = p.in[I_WUKV] + (size_t)l * KVR * KVW; j.K = KVR; j.N = KVW; j.dst = wl_ptr(p, l, WL_UKV); j.dstride = KVR; j.kscale = p.in[I_KVNORM] + l * KVR; item = r; return; } r -= 64;
    if (r < 128) { j.W = p.in[I_WBRM] + (size_t)l * 512 * D; j.K = 512; j.N = D; j.dst = wl_ptr(p, l, WL_CAT); j.dstride = D; item = r; return; } r -= 128;
    if (r < 64) { j.W = p.in[I_WBRN] + (size_t)l * 256 * D; j.K = 256; j.N = D; j.dst = wl_ptr(p, l, WL_CAT); j.dstride = D; j.koff = 512; item = r; return; } r -= 64;
    if (r < 64) { j.W = p.in[I_WBRP] + (size_t)l * 256 * D; j.K = 256; j.N = D; j.dst = wl_ptr(p, l, WL_CAT); j.dstride = D; j.koff = 768; item = r; return; } r -= 64;
    if (r < 256) { j.W = p.in[I_WOUT] + (size_t)l * D * D; j.K = D; j.N = D; j.dst = wl_ptr(p, l, WL_OUT); j.dstride = D; item = r; return; } r -= 256;
    if (r < 4) { j.W = p.in[I_WPOOL] + ((size_t)l * 4 + r) * 4096; j.K = 64; j.N = 64; j.dst = wl_ptr(p, l, WL_POOL) + r * 4096; j.dstride = 64; item = 0; return; } r -= 4;
    const int which = r / 8192, rr = r % 8192, e = rr / 512; item = rr % 512;
    if (which == 0) { j.W = p.in[I_WGATE] + (size_t)(l * NE + e) * D * FF; j.K = D; j.N = FF; j.dst = wl_ptr(p, l, WL_GU) + (size_t)e * 2 * FF * D; j.dstride = D; j.map = 2; }
    else if (which == 1) { j.W = p.in[I_WUP] + (size_t)(l * NE + e) * D * FF; j.K = D; j.N = FF; j.dst = wl_ptr(p, l, WL_GU) + (size_t)e * 2 * FF * D; j.dstride = D; j.map = 3; }
    else { j.W = p.in[I_WDOWN] + (size_t)(l * NE + e) * FF * D; j.K = FF; j.N = D; j.dst = wl_ptr(p, l, WL_DN) + (size_t)e * D * FF; j.dstride = FF; }
}
__device__ __forceinline__ int cvt_maprow(int map, int n) {
    if (map == 0) return n;
    if (map == 1) { if (n < 640) return n; if (n < 672) return Z_KR + (n - 640); if (n < 1440) return Z_NA + (n - 672); if (n < 1696) return Z_POOL + (n - 1440); return Z_GATE + (n - 1696); }
    return 256 * (n >> 7) + (n & 127) + (map == 3 ? 128 : 0);
}
__device__ __forceinline__ void ph_cvt(const Params& p, unsigned char* lds_) {
    const int tid = otid();
    LAS float* scr = (LAS float*)lds_ + (tid >> 6) * (64 * 65);
    const int lane = tid & 63;
    const bool moe_in_attn = MLA_V2 && gridDim.x == 256;
    for (int it = GWAVE; it < 2 * CVT_PER_LAYER; it += GNW) {
        if (moe_in_attn && (it % CVT_PER_LAYER) >= CVT_PER_LAYER - 3 * 8192) continue;
        CvtJob j; int item; cvt_decode(p, it, j, item);
        const int nblk = (j.N + 63) / 64, kb = item / nblk, nb = item % nblk, k0 = kb * 64, n0 = nb * 64;
        const int rr = lane >> 4, c4 = lane & 15;
        const bool nv = n0 + 4 * c4 < j.N;
        const float* src = j.W + (size_t)(k0 + rr) * j.N + n0 + 4 * c4;
#pragma unroll
        for (int i = 0; i < 16; ++i) { float4 v = nv ? *(const float4*)(src + (size_t)(4 * i) * j.N) : make_float4(0.f, 0.f, 0.f, 0.f);
            if (j.kscale) { const float ks = j.kscale[k0 + 4 * i + rr]; v.x *= ks; v.y *= ks; v.z *= ks; v.w *= ks; }
            LAS float* d = scr + (4 * i + rr) * 65 + 4 * c4; d[0] = v.x; d[1] = v.y; d[2] = v.z; d[3] = v.w; }
        asm volatile("s_waitcnt lgkmcnt(0)" ::: "memory");
        const int c = lane & 7;
#pragma unroll
        for (int jj = 0; jj < 8; ++jj) {
            const int n = (lane >> 3) + 8 * jj; const LAS float* sp = scr + (8 * c) * 65 + n;
            uint4 o; o.x = (unsigned)f2bf(sp[0]) | ((unsigned)f2bf(sp[65]) << 16); o.y = (unsigned)f2bf(sp[2 * 65]) | ((unsigned)f2bf(sp[3 * 65]) << 16);
            o.z = (unsigned)f2bf(sp[4 * 65]) | ((unsigned)f2bf(sp[5 * 65]) << 16); o.w = (unsigned)f2bf(sp[6 * 65]) | ((unsigned)f2bf(sp[7 * 65]) << 16);
            if (n0 + n < j.N) *(uint4*)(j.dst + (size_t)cvt_maprow(j.map, n0 + n) * j.dstride + j.koff + k0 + 8 * c) = o;
        }
        asm volatile("s_waitcnt lgkmcnt(0)" ::: "memory");
    }
}

namespace pg {
typedef short bf16x8 __attribute__((ext_vector_type(8)));
typedef float f32x4 __attribute__((ext_vector_type(4)));
typedef unsigned u32x4 __attribute__((ext_vector_type(4)));
constexpr int BM = 256, BK = 64, HALF = 128, HTB = HALF * BK * 2, STAGE_BYTES = 8 * HTB, NXCD = 8;
__host__ __device__ __forceinline__ int lds_byte(int r, int c) { const int st = (r >> 4) * 2 + (c >> 5), rr = r & 15, cc = c & 31, ob = rr * 64 + cc * 2; return st * 1024 + (ob ^ (((ob >> 9) & 1) << 5)); }
__host__ __device__ __forceinline__ void stage_rc(int b, int& R, int& C) { const int st = b / 1024, sb = b % 1024, swz = sb ^ (((sb >> 9) & 1) << 5); R = (st >> 1) * 16 + swz / 64; C = (st & 1) * 32 + (swz % 64) / 2; }
__host__ __device__ __forceinline__ int perm32(int rho) { const int n = rho >> 4, i = rho & 15; return 8 * (i >> 2) + 4 * n + (i & 3); }
__device__ __forceinline__ unsigned cvt_pk_bf16(float lo, float hi) { unsigned r; asm volatile("v_cvt_pk_bf16_f32 %0, %1, %2" : "=v"(r) : "v"(lo), "v"(hi)); return r; }

struct GUnit { const char* A; const char* B; unsigned lda, ldb; int nt, pm, pn, aux, ord; };

struct GridOrder {
    int nM, nN, G, c, WGM;
    __device__ __forceinline__ bool tile(int i, int& pm, int& pn) const {
        const int nwg = nM * nN; const long L = (long)i * G + c; if (L >= nwg) return false;
        int wgid = (int)L; { const int q = nwg / NXCD, r = nwg % NXCD, xcd = wgid % NXCD, off = wgid / NXCD; wgid = (xcd < r ? xcd * (q + 1) : r * (q + 1) + (xcd - r) * q) + off; }
        const int nig = WGM * nN, gid = wgid / nig, fm = gid * WGM, gsz = (nM - fm) < WGM ? (nM - fm) : WGM;
        pm = fm + ((wgid % nig) % gsz); pn = (wgid % nig) / gsz; return true;
    }
};

template <class Epi, class Sched>
__device__ __forceinline__ void gemm_phase(LAS unsigned char* lds, const Sched& S, const Epi& E) {
    const int tid = otid(), wid = __builtin_amdgcn_readfirstlane(tid >> 6), lane = tid & 63, wr = wid >> 2, wc = wid & 3, fr = lane & 15, fq = lane >> 4;
    int R_, C_; stage_rc(tid * 16, R_, C_); const int Rb_ = Epi::PERM ? ((R_ & ~31) + perm32(R_ & 31)) : R_;
    const unsigned ldsw = (unsigned)wid * 1024u;
    const int aoff = lds_byte(wr * 64 + fr, fq * 8), boff = lds_byte(wc * 32 + fr, fq * 8);
    const size_t kstep = (size_t)(BK * 2);
#define PG_SA(b, h) (((b) * 2 + (h)) * HTB)
#define PG_SB(b, h) ((4 + (b) * 2 + (h)) * HTB)
#define PG_STAGE(bufoff, gbase, voff, q64) do { \
        __builtin_amdgcn_global_load_lds((const unsigned*)((const char*)(gbase) + (voff)), (LAS unsigned*)(lds + (bufoff) + ldsw), 16, 0, 0); \
        __builtin_amdgcn_global_load_lds((const unsigned*)((const char*)(gbase) + (q64) + (voff)), (LAS unsigned*)(lds + (bufoff) + ldsw + 8192), 16, 0, 0); } while (0)
#define PG_STAGE_A(bufoff, kbase, hh, VV, QQ, GG) do { if constexpr (Sched::GATHER) { \
        __builtin_amdgcn_global_load_lds((const unsigned*)((const char*)(kbase) + (GG)[hh][0]), (LAS unsigned*)(lds + (bufoff) + ldsw), 16, 0, 0); \
        __builtin_amdgcn_global_load_lds((const unsigned*)((const char*)(kbase) + (GG)[hh][1]), (LAS unsigned*)(lds + (bufoff) + ldsw + 8192), 16, 0, 0); } \
        else { PG_STAGE(bufoff, (const char*)(kbase) + (hh) * 2 * (QQ), VV, QQ); } } while (0)
#define PG_LDGATHER(GG, U) do { if constexpr (Sched::GATHER) { _Pragma("unroll") for (int hh = 0; hh < 2; ++hh) _Pragma("unroll") for (int ii = 0; ii < 2; ++ii) \
        (GG)[hh][ii] = (unsigned)S.seltab[(U).ord * 256 + hh * 128 + R_ + 64 * ii] * (U).lda + (unsigned)C_ * 2u; } } while (0)
#define PG_LDA(dst, b, h) do { _Pragma("unroll") for (int m = 0; m < 4; ++m) _Pragma("unroll") for (int k = 0; k < 2; ++k) dst[m][k] = *(const LAS bf16x8*)(lds + PG_SA(b, h) + aoff + m * 2048 + k * 1024); } while (0)
#define PG_LDB(dst, b, h) do { _Pragma("unroll") for (int n = 0; n < 2; ++n) _Pragma("unroll") for (int k = 0; k < 2; ++k) dst[n][k] = *(const LAS bf16x8*)(lds + PG_SB(b, h) + boff + n * 2048 + k * 1024); } while (0)
#define PG_MMA(ai, bj, At, Bt) do { __builtin_amdgcn_s_setprio(1); _Pragma("unroll") for (int m = 0; m < 4; ++m) _Pragma("unroll") for (int n = 0; n < 2; ++n) _Pragma("unroll") for (int k = 0; k < 2; ++k) \
        acc[ai][bj][m][n] = __builtin_amdgcn_mfma_f32_16x16x32_bf16(Bt[n][k], At[m][k], acc[ai][bj][m][n], 0, 0, 0); __builtin_amdgcn_s_setprio(0); } while (0)
#define PG_WAIT_V(n) asm volatile("s_waitcnt vmcnt(" #n ")" ::: "memory")
#define PG_WAIT_L(n) asm volatile("s_waitcnt lgkmcnt(" #n ")" ::: "memory")
#define PG_BAR __builtin_amdgcn_s_barrier()
#define PG_SCHED __builtin_amdgcn_sched_barrier(0)
    GUnit cur, nxt; int ui = 0;
    if (!S.next(0, cur)) return;
    f32x4 acc[2][2][4][2];
#pragma unroll
    for (int a = 0; a < 2; ++a)
#pragma unroll
        for (int b = 0; b < 2; ++b)
#pragma unroll
            for (int m = 0; m < 4; ++m)
#pragma unroll
                for (int n = 0; n < 2; ++n) acc[a][b][m][n] = (f32x4){0.f, 0.f, 0.f, 0.f};
    bf16x8 At[4][2], B0[2][2], B1[2][2];
    const char* cA = cur.A; const char* cB = cur.B;
    unsigned vA = (unsigned)R_ * cur.lda + (unsigned)C_ * 2u, vB = (unsigned)Rb_ * cur.ldb + (unsigned)C_ * 2u;
    size_t qA = (size_t)64 * cur.lda, qB = (size_t)64 * cur.ldb, hA = 2 * qA, hB = 2 * qB;
    unsigned gA[2][2] = {{0u, 0u}, {0u, 0u}}, ngA[2][2] = {{0u, 0u}, {0u, 0u}}; PG_LDGATHER(gA, cur);
#if PG_SP2
    PG_STAGE(PG_SB(0, 0), cB, vB, qB); PG_STAGE(PG_SB(0, 1), cB + hB, vB, qB); PG_STAGE_A(PG_SA(0, 0), cA, 0, vA, qA, gA); PG_STAGE_A(PG_SA(0, 1), cA, 1, vA, qA, gA);
    if (wr == 1) PG_BAR;
    PG_WAIT_V(2); PG_BAR;
    PG_STAGE(PG_SB(1, 0), cB + kstep, vB, qB); PG_STAGE_A(PG_SA(1, 0), cA + kstep, 0, vA, qA, gA); PG_STAGE(PG_SB(1, 1), cB + hB + kstep, vB, qB);
    PG_WAIT_V(6); PG_BAR;
#else
    PG_STAGE(PG_SB(0, 0), cB, vB, qB); PG_STAGE_A(PG_SA(0, 0), cA, 0, vA, qA, gA); PG_STAGE(PG_SB(0, 1), cB + hB, vB, qB); PG_STAGE_A(PG_SA(0, 1), cA, 1, vA, qA, gA);
    if (wr == 1) PG_BAR;
    PG_WAIT_V(4); PG_BAR;
    PG_STAGE(PG_SB(1, 0), cB + kstep, vB, qB); PG_STAGE_A(PG_SA(1, 0), cA + kstep, 0, vA, qA, gA); PG_STAGE(PG_SB(1, 1), cB + hB + kstep, vB, qB);
    PG_WAIT_V(6); PG_BAR;
#endif
    for (;;) {
        const bool has_next = S.next(ui + 1, nxt);
        const char* nA = has_next ? nxt.A : cA; const char* nB = has_next ? nxt.B : cB;
        const unsigned nvA = has_next ? (unsigned)R_ * nxt.lda + (unsigned)C_ * 2u : vA, nvB = has_next ? (unsigned)Rb_ * nxt.ldb + (unsigned)C_ * 2u : vB;
        const size_t nqA = has_next ? (size_t)64 * nxt.lda : qA, nqB = has_next ? (size_t)64 * nxt.ldb : qB;
        if (has_next) PG_LDGATHER(ngA, nxt);
        const int nt = cur.nt;
        for (int t = 0; t < nt; t += 2) {
            if constexpr (Epi::SEG) E.seg(acc, cur, t, wr, wc, fr, fq);
            const bool last = (t == nt - 2);
            const char* a1 = cA + (size_t)(t + 1) * kstep;
            const char* a2 = last ? nA : cA + (size_t)(t + 2) * kstep; const char* b2 = last ? nB : cB + (size_t)(t + 2) * kstep;
            const char* a3 = a2 + kstep; const char* b3 = b2 + kstep;
            unsigned gA2[2][2];
#pragma unroll
            for (int hh = 0; hh < 2; ++hh)
#pragma unroll
                for (int ii = 0; ii < 2; ++ii) gA2[hh][ii] = (last && has_next) ? ngA[hh][ii] : gA[hh][ii];
            const unsigned vA2 = last ? nvA : vA, vB2 = last ? nvB : vB; const size_t qA2 = last ? nqA : qA, qB2 = last ? nqB : qB, hA2 = 2 * qA2, hB2 = 2 * qB2;
#if PG_SP2
            PG_LDB(B0, 0, 0); PG_LDB(B1, 0, 1); PG_SCHED; PG_LDA(At, 0, 0); PG_STAGE_A(PG_SA(1, 1), a1, 1, vA, qA, gA);
            PG_WAIT_V(8); PG_WAIT_L(0); PG_BAR; PG_MMA(0, 0, At, B0); PG_MMA(0, 1, At, B1); PG_BAR; PG_SCHED;
            PG_LDA(At, 0, 1); PG_STAGE(PG_SB(0, 0), b2, vB2, qB2); PG_STAGE(PG_SB(0, 1), b2 + hB2, vB2, qB2); PG_STAGE_A(PG_SA(0, 0), a2, 0, vA2, qA2, gA2);
            PG_WAIT_V(8); PG_WAIT_L(0); PG_BAR; PG_MMA(1, 0, At, B0); PG_MMA(1, 1, At, B1); PG_BAR; PG_SCHED;
            PG_LDB(B0, 1, 0); PG_LDB(B1, 1, 1); PG_SCHED; PG_LDA(At, 1, 0); PG_STAGE_A(PG_SA(0, 1), a2, 1, vA2, qA2, gA2);
            PG_WAIT_V(8); PG_WAIT_L(0); PG_BAR; PG_MMA(0, 0, At, B0); PG_MMA(0, 1, At, B1); PG_BAR; PG_SCHED;
            PG_LDA(At, 1, 1); PG_STAGE(PG_SB(1, 0), b3, vB2, qB2); PG_STAGE(PG_SB(1, 1), b3 + hB2, vB2, qB2); PG_STAGE_A(PG_SA(1, 0), a3, 0, vA2, qA2, gA2);
            PG_WAIT_V(8); PG_WAIT_L(0); PG_BAR; PG_MMA(1, 0, At, B0); PG_MMA(1, 1, At, B1); PG_BAR; PG_SCHED;
#else
            PG_LDB(B0, 0, 0); PG_SCHED; PG_LDA(At, 0, 0); PG_STAGE_A(PG_SA(1, 1), a1, 1, vA, qA, gA);
            PG_WAIT_L(8); PG_BAR; PG_WAIT_L(0); PG_MMA(0, 0, At, B0); PG_BAR; PG_SCHED;
            PG_LDB(B1, 0, 1); PG_STAGE(PG_SB(0, 0), b2, vB2, qB2);
            PG_BAR; PG_WAIT_L(0); PG_MMA(0, 1, At, B1); PG_BAR;
            PG_LDA(At, 0, 1); PG_STAGE_A(PG_SA(0, 0), a2, 0, vA2, qA2, gA2);
            PG_BAR; PG_WAIT_L(0); PG_MMA(1, 0, At, B0); PG_BAR; PG_SCHED;
            PG_STAGE(PG_SB(0, 1), b2 + hB2, vB2, qB2);
            PG_WAIT_V(6); PG_BAR; PG_MMA(1, 1, At, B1); PG_BAR;
            PG_LDB(B0, 1, 0); PG_SCHED; PG_LDA(At, 1, 0); PG_STAGE_A(PG_SA(0, 1), a2, 1, vA2, qA2, gA2);
            PG_WAIT_L(8); PG_BAR; PG_WAIT_L(0); PG_MMA(0, 0, At, B0); PG_BAR; PG_SCHED;
            PG_LDB(B1, 1, 1); PG_STAGE(PG_SB(1, 0), b3, vB2, qB2);
            PG_BAR; PG_WAIT_L(0); PG_MMA(0, 1, At, B1); PG_BAR;
            PG_LDA(At, 1, 1); PG_STAGE_A(PG_SA(1, 0), a3, 0, vA2, qA2, gA2);
            PG_BAR; PG_WAIT_L(0); PG_MMA(1, 0, At, B0); PG_BAR; PG_SCHED;
            PG_STAGE(PG_SB(1, 1), b3 + hB2, vB2, qB2);
            PG_WAIT_V(6); PG_BAR; PG_MMA(1, 1, At, B1); PG_BAR;
#endif
        }
#if PG_ALIGN
        if (wr == 0) PG_BAR;
#endif
        E(acc, cur, wr, wc, fr, fq);
        if (!has_next) break;
#pragma unroll
        for (int a = 0; a < 2; ++a)
#pragma unroll
            for (int b = 0; b < 2; ++b)
#pragma unroll
                for (int m = 0; m < 4; ++m)
#pragma unroll
                    for (int n = 0; n < 2; ++n) acc[a][b][m][n] = (f32x4){0.f, 0.f, 0.f, 0.f};
#pragma unroll
        for (int hh = 0; hh < 2; ++hh)
#pragma unroll
            for (int ii = 0; ii < 2; ++ii) gA[hh][ii] = ngA[hh][ii];
        cur = nxt; cA = nA; cB = nB; vA = nvA; vB = nvB; qA = nqA; qB = nqB; hA = 2 * qA; hB = 2 * qB; ++ui;
#if PG_ALIGN
        if (wr == 1) PG_BAR;
#endif
    }
    PG_WAIT_V(0);
#if !PG_ALIGN
    if (wr == 0) PG_BAR;
#endif
    PG_BAR;
#undef PG_SA
#undef PG_SB
#undef PG_STAGE
#undef PG_STAGE_A
#undef PG_LDGATHER
#undef PG_LDA
#undef PG_LDB
#undef PG_MMA
#undef PG_WAIT_V
#undef PG_WAIT_L
#undef PG_BAR
#undef PG_SCHED
}
typedef f32x4 Acc[2][2][4][2];
__device__ __forceinline__ u32x4 pack8(const f32x4 a, const f32x4 b) { u32x4 w; w.x = cvt_pk_bf16(a[0], a[1]); w.y = cvt_pk_bf16(a[2], a[3]); w.z = cvt_pk_bf16(b[0], b[1]); w.w = cvt_pk_bf16(b[2], b[3]); return w; }
__device__ __forceinline__ float fsig(float x) { return __builtin_amdgcn_rcpf(1.f + __expf(-x)); }

struct SchedSimple {
    static constexpr bool GATHER = false; GridOrder o; const char* A; const char* B; unsigned lda, ldb; int nt;
    __device__ __forceinline__ bool next(int i, GUnit& u) const { int pm, pn; if (!o.tile(i, pm, pn)) return false; u.A = A + (size_t)pm * 256 * lda; u.B = B + (size_t)pn * 256 * ldb; u.lda = lda; u.ldb = ldb; u.nt = nt; u.pm = pm; u.pn = pn; u.aux = 0; u.ord = i; return true; }
};
struct EpiInproj { static constexpr bool PERM = true, SEG = false; bf16* z;
    __device__ __forceinline__ void operator()(const Acc& acc, const GUnit& u, int wr, int wc, int fr, int fq) const {
        asm volatile("" : "+v"(fr), "+v"(fq));
        const int row0 = u.pm * BM + wr * 64 + fr;
#pragma unroll
        for (int bj = 0; bj < 2; ++bj) { const int colb = u.pn * BM + bj * HALF; const bool sig = colb >= Z_GATE && colb < Z_KR; const int col0 = colb + wc * 32 + 8 * fq;
#pragma unroll
            for (int ai = 0; ai < 2; ++ai)
#pragma unroll
                for (int m = 0; m < 4; ++m) { f32x4 v0 = acc[ai][bj][m][0], v1 = acc[ai][bj][m][1];
                    if (sig) {
#pragma unroll
                        for (int j = 0; j < 4; ++j) { v0[j] = fsig(v0[j]); v1[j] = fsig(v1[j]); } }
                    *(u32x4*)(z + (size_t)(row0 + ai * HALF + m * 16) * ZW + col0) = pack8(v0, v1); } }
    }
};
struct SchedMla { static constexpr bool GATHER = false; int G, c; const char* z; const char* wq; const char* wkv;
    __device__ __forceinline__ bool next(int i, GUnit& u) const {
        const int L = i * G + c; constexpr int NKV = 66 * 4, NQ = 66 * 3; if (L >= NKV + NQ) return false;
        u.ord = i; u.lda = ZW * 2;
        if (L < NKV) { u.pm = L >> 2; u.pn = L & 3; u.aux = 1; u.A = z + (size_t)u.pm * 256 * ZW * 2 + Z_CKV * 2; u.B = wkv + (size_t)u.pn * 256 * KVR * 2; u.ldb = KVR * 2; u.nt = KVR / 64; }
        else { const int q = L - NKV; u.pm = q / 3; u.pn = q % 3; u.aux = 0; u.A = z + (size_t)u.pm * 256 * ZW * 2 + Z_CQ * 2; u.B = wq + (size_t)u.pn * 256 * QR * 2; u.ldb = QR * 2; u.nt = QR / 64; }
        return true; }
};
struct EpiMla { static constexpr bool PERM = true, SEG = false; bf16* q; bf16* Kb; bf16* Vb; const float* rope; const LAS float* rstab;
    __device__ __forceinline__ void operator()(const Acc& acc, const GUnit& u, int wr, int wc, int fr, int fq) const {
        asm volatile("" : "+v"(fr), "+v"(fq));
        const LAS float* rs = rstab + u.ord * 256;
        if (u.aux == 0) {
#pragma unroll
            for (int bj = 0; bj < 2; ++bj) { const int cb = u.pn * BM + bj * HALF + wc * 32; const bool isrope = (cb % QKD) == 64 && u.pm < 64; const int col0 = cb + 8 * fq;
#pragma unroll
                for (int ai = 0; ai < 2; ++ai)
#pragma unroll
                    for (int m = 0; m < 4; ++m) { const int rl = ai * HALF + wr * 64 + m * 16 + fr, row = u.pm * BM + rl; const float sc = rs[rl] * 0.14724444896f;
                        f32x4 v0 = acc[ai][bj][m][0] * sc, v1 = acc[ai][bj][m][1] * sc;
                        if (isrope) { const int t = row & 8191, pos = fq < 2 ? (t >> 6) : 128 + (t & 63); const f32x4* rp = (const f32x4*)(rope + pos * 16); const float sgn = (fq & 1) ? 1.f : -1.f;
                            const f32x4 t0 = rp[0], t1 = rp[1], t2 = rp[2], t3 = rp[3];
                            f32x4 p0, p1;
#pragma unroll
                            for (int j = 0; j < 4; ++j) { p0[j] = __shfl_xor(v0[j], 16) * sgn; p1[j] = __shfl_xor(v1[j], 16) * sgn; }
                            v0[0] = v0[0] * t0[0] + p0[0] * t0[1]; v0[1] = v0[1] * t0[2] + p0[1] * t0[3]; v0[2] = v0[2] * t1[0] + p0[2] * t1[1]; v0[3] = v0[3] * t1[2] + p0[3] * t1[3];
                            v1[0] = v1[0] * t2[0] + p1[0] * t2[1]; v1[1] = v1[1] * t2[2] + p1[1] * t2[3]; v1[2] = v1[2] * t3[0] + p1[2] * t3[1]; v1[3] = v1[3] * t3[2] + p1[3] * t3[3]; }
                        *(u32x4*)(q + (size_t)row * QW + col0) = pack8(v0, v1); asm volatile("" ::: "memory"); } }
        } else {
#pragma unroll
            for (int bj = 0; bj < 2; ++bj) { const int head = 2 * u.pn + bj;
#pragma unroll
                for (int ai = 0; ai < 2; ++ai)
#pragma unroll
                    for (int m = 0; m < 4; ++m) { const int rl = ai * HALF + wr * 64 + m * 16 + fr, row = u.pm * BM + rl; const float sc = rs[rl]; const size_t kr = (size_t)row_krow(row);
                        const u32x4 w = pack8(acc[ai][bj][m][0] * sc, acc[ai][bj][m][1] * sc);
                        if (wc < 2) *(u32x4*)(Kb + kr * QW + head * QKD + wc * 32 + 8 * fq) = w; else *(u32x4*)(Vb + kr * AW + head * VD + (wc - 2) * 32 + 8 * fq) = w; asm volatile("" ::: "memory"); } }
        }
    }
};
struct EpiMerge { static constexpr bool PERM = true, SEG = true; const bf16* z; bf16* mo;
    __device__ __forceinline__ f32x4 lo4(const u32x4 w) const { return (f32x4){__uint_as_float(w.x << 16), __uint_as_float(w.x & 0xffff0000u), __uint_as_float(w.y << 16), __uint_as_float(w.y & 0xffff0000u)}; }
    __device__ __forceinline__ f32x4 hi4(const u32x4 w) const { return (f32x4){__uint_as_float(w.z << 16), __uint_as_float(w.z & 0xffff0000u), __uint_as_float(w.w << 16), __uint_as_float(w.w & 0xffff0000u)}; }
    __device__ __forceinline__ void seg(Acc& acc, const GUnit& u, int t, int wr, int wc, int fr, int fq) const {
        if (t != 8 && t != 12) return;
        asm volatile("" : "+v"(fr), "+v"(fq));
        const int br = (t == 8) ? 0 : 1; const int row0 = u.pm * BM + wr * 64 + fr;
#pragma unroll
        for (int bj = 0; bj < 2; ++bj) { const int col0 = u.pn * BM + bj * HALF + wc * 32 + 8 * fq;
#pragma unroll
            for (int ai = 0; ai < 2; ++ai) {
                u32x4 ga[4], gb[4];
#pragma unroll
                for (int m = 0; m < 4; ++m) { const bf16* zp = z + (size_t)(row0 + ai * HALF + m * 16) * ZW + Z_GATE + br * D + col0; ga[m] = *(const u32x4*)zp; gb[m] = *(const u32x4*)(zp + D); }
#pragma unroll
                for (int m = 0; m < 4; ++m) { const f32x4 a0 = lo4(ga[m]), a1 = hi4(ga[m]), b0 = lo4(gb[m]), b1 = hi4(gb[m]);
#pragma unroll
                    for (int j = 0; j < 4; ++j) { acc[ai][bj][m][0][j] *= a0[j] * __builtin_amdgcn_rcpf(b0[j]); acc[ai][bj][m][1][j] *= a1[j] * __builtin_amdgcn_rcpf(b1[j]); } }
                asm volatile("" : "+v"(acc[ai][bj][0][0]), "+v"(acc[ai][bj][1][0]), "+v"(acc[ai][bj][2][0]), "+v"(acc[ai][bj][3][0]) :: "memory"); } }
    }
    __device__ __forceinline__ void operator()(const Acc& acc, const GUnit& u, int wr, int wc, int fr, int fq) const {
        asm volatile("" : "+v"(fr), "+v"(fq));
        const int row0 = u.pm * BM + wr * 64 + fr;
#pragma unroll
        for (int bj = 0; bj < 2; ++bj) { const int col0 = u.pn * BM + bj * HALF + wc * 32 + 8 * fq;
#pragma unroll
            for (int ai = 0; ai < 2; ++ai) {
                u32x4 g[4];
#pragma unroll
                for (int m = 0; m < 4; ++m) g[m] = *(const u32x4*)(z + (size_t)(row0 + ai * HALF + m * 16) * ZW + Z_GATE + 2 * D + col0);
#pragma unroll
                for (int m = 0; m < 4; ++m) *(u32x4*)(mo + (size_t)(row0 + ai * HALF + m * 16) * D + col0) = pack8(acc[ai][bj][m][0] * lo4(g[m]), acc[ai][bj][m][1] * hi4(g[m]));
                asm volatile("" ::: "memory"); } }
    }
};
struct SchedOut { static constexpr bool GATHER = false; const int* sel; const LAS int* seltab; GridOrder o; int ksplit; const char* A; const char* B; unsigned lda, ldb; int nt;
    __device__ __forceinline__ bool next(int i, GUnit& u) const { int pm, pn; u.lda = lda; u.ldb = ldb; u.ord = i;
        if (o.tile(i, pm, pn)) { u.A = A + (size_t)pm * 256 * lda; u.B = B + (size_t)pn * 256 * ldb; u.nt = nt; u.pm = pm; u.pn = pn; u.aux = 0; return true; }
        if (!ksplit) return false;
        const long L = (long)i * o.G + o.c - (long)o.nM * o.nN; if (L < 0 || L >= 32) return false;
        const int tile = (int)L >> 2, q = (int)L & 3, pmc = 64 + (tile >> 2), pnc = tile & 3;
        u.A = A + (size_t)pmc * 256 * lda + (size_t)q * 512; u.B = B + (size_t)pnc * 256 * ldb + (size_t)q * 512; u.nt = 4; u.pm = pmc; u.pn = pnc; u.aux = 16 + q; return true; }
};
struct EpiOut { static constexpr bool PERM = false, SEG = false; const float* x; const float* ctx; const float* xa_in; float* xa; const float* mod; int l; float* slab;
    __device__ __forceinline__ void operator()(const Acc& acc, const GUnit& u, int wr, int wc, int fr, int fq) const {
        asm volatile("" : "+v"(fr), "+v"(fq));
        if (u.aux >= 16) {
            const int rowc = (u.pm - 64) * BM + wr * 64 + fr, col0q = u.pn * BM + wc * 32 + 4 * fq; float* sp = slab + (size_t)(u.aux - 16) * 512 * D;
#pragma unroll
            for (int ai = 0; ai < 2; ++ai)
#pragma unroll
                for (int m = 0; m < 4; ++m)
#pragma unroll
                    for (int bj = 0; bj < 2; ++bj)
#pragma unroll
                        for (int n = 0; n < 2; ++n) *(f32x4*)(sp + (size_t)(rowc + ai * HALF + m * 16) * D + col0q + bj * HALF + n * 16) = acc[ai][bj][m][n];
            return; }
        const int row0 = u.pm * BM + wr * 64 + fr, col0 = u.pn * BM + wc * 32 + 4 * fq; const float* g1 = mod + (u.pm < 32 ? 0 : (u.pm < 64 ? 1 : 2)) * 6144 + 2 * D;
        f32x4 gv[2][2];
#pragma unroll
        for (int bj = 0; bj < 2; ++bj)
#pragma unroll
            for (int n = 0; n < 2; ++n) gv[bj][n] = *(const f32x4*)(g1 + col0 + bj * HALF + n * 16);
#pragma unroll
        for (int ai = 0; ai < 2; ++ai)
#pragma unroll
            for (int m = 0; m < 4; ++m) { const int row = row0 + ai * HALF + m * 16;
                const float* src = l == 0 ? (row < TL ? x + (size_t)row * D : ctx + (size_t)(row - TL) * D) : xa_in + (size_t)row * D;
#pragma unroll
                for (int bj = 0; bj < 2; ++bj)
#pragma unroll
                    for (int n = 0; n < 2; ++n) { const int c = col0 + bj * HALF + n * 16; *(f32x4*)(xa + (size_t)row * D + c) = *(const f32x4*)(src + c) + gv[bj][n] * acc[ai][bj][m][n]; } }
    }
};
template <bool GATHER_> struct SchedMoe { static constexpr bool GATHER = GATHER_; const int* sel; const LAS int* seltab; GridOrder o; int tpe  ; const char* A; const char* B; unsigned lda, ldb; size_t bstride  ; int nt;
    __device__ __forceinline__ bool next(int i, GUnit& u) const { int pm, pn; if (!o.tile(i, pm, pn)) return false; const int e = pm / tpe, tr = pm % tpe, pmg = e * 9 + tr;
        u.A = GATHER_ ? A : A + (size_t)pmg * 256 * lda; u.B = B + (size_t)e * bstride + (size_t)pn * 256 * ldb; u.lda = lda; u.ldb = ldb; u.nt = nt; u.pm = pmg; u.pn = pn; u.aux = e; u.ord = i; return true; }
};
struct EpiMoeUp { static constexpr bool PERM = true, SEG = false; bf16* act;
    __device__ __forceinline__ void operator()(const Acc& acc, const GUnit& u, int wr, int wc, int fr, int fq) const {
        asm volatile("" : "+v"(fr), "+v"(fq));
        const int row0 = u.pm * BM + wr * 64 + fr, col0 = u.pn * HALF + wc * 32 + 8 * fq;
#pragma unroll
        for (int ai = 0; ai < 2; ++ai)
#pragma unroll
            for (int m = 0; m < 4; ++m) { f32x4 o0, o1;
#pragma unroll
                for (int j = 0; j < 4; ++j) { const float g0 = acc[ai][0][m][0][j], g1 = acc[ai][0][m][1][j]; o0[j] = g0 * fsig(g0) * acc[ai][1][m][0][j]; o1[j] = g1 * fsig(g1) * acc[ai][1][m][1][j]; }
                *(u32x4*)(act + (size_t)(row0 + ai * HALF + m * 16) * FF + col0) = pack8(o0, o1); }
    }
};
struct SchedMoeDown { static constexpr bool GATHER = false; const int* sel; const LAS int* seltab; GridOrder o; int ksplit; const char* A; const char* B; unsigned lda, ldb; size_t bstride; int nt;
    __device__ __forceinline__ bool next(int i, GUnit& u) const { int pm, pn; u.lda = lda; u.ldb = ldb; u.ord = i;
        if (o.tile(i, pm, pn)) { const int e = pm / o.WGM, tr = pm % o.WGM, pmg = e * 9 + tr;
            u.A = A + (size_t)pmg * 256 * lda; u.B = B + (size_t)e * bstride + (size_t)pn * 256 * ldb; u.nt = nt; u.pm = pmg; u.pn = pn; u.aux = e; return true; }
        if (!ksplit) return false;
        const long L = (long)i * o.G + o.c - (long)o.nM * o.nN; if (L < 0 || L >= 256) return false;
        const int e = (int)L >> 4, pnq = ((int)L >> 2) & 3, q = (int)L & 3, pmg = e * 9 + 8;
        u.A = A + (size_t)pmg * 256 * lda + (size_t)q * 1024; u.B = B + (size_t)e * bstride + (size_t)pnq * 256 * ldb + (size_t)q * 1024; u.nt = 8; u.pm = pmg; u.pn = pnq; u.aux = 16 + q; return true; }
};
struct EpiMoeDown { static constexpr bool PERM = true, SEG = false; bf16* y; const float* gvx; float* slab;
    __device__ __forceinline__ void operator()(const Acc& acc, const GUnit& u, int wr, int wc, int fr, int fq) const {
        asm volatile("" : "+v"(fr), "+v"(fq));
        const int row0 = u.pm * BM + wr * 64 + fr;
        if (u.aux >= 16) {
            if (wr == 0) { const int q = u.aux - 16, e = u.pm / 9;
#pragma unroll
                for (int m = 0; m < 4; ++m) { const int r64 = m * 16 + fr; const float gv = gvx[row0 + m * 16]; float* sp = slab + (((size_t)q * NE + e) * 64 + r64) * D + u.pn * BM + wc * 32 + 8 * fq;
#pragma unroll
                    for (int bj = 0; bj < 2; ++bj) { *(f32x4*)(sp + bj * HALF) = acc[0][bj][m][0] * gv; *(f32x4*)(sp + bj * HALF + 4) = acc[0][bj][m][1] * gv; } } }
            return; }
#pragma unroll
        for (int ai = 0; ai < 2; ++ai)
#pragma unroll
            for (int m = 0; m < 4; ++m) { const int row = row0 + ai * HALF + m * 16; const float gv = gvx[row];
#pragma unroll
                for (int bj = 0; bj < 2; ++bj) *(u32x4*)(y + (size_t)row * D + u.pn * BM + bj * HALF + wc * 32 + 8 * fq) = pack8(acc[ai][bj][m][0] * gv, acc[ai][bj][m][1] * gv); }
    }
};
}

constexpr int LDS_RS_OFF = pg::STAGE_BYTES;

__device__ __forceinline__ void ph_inproj_fast(const Params& p, int l, unsigned char* lds_) {
    const int tid = otid();
    pg::SchedSimple S; S.o = pg::GridOrder{T / 256, ZW / 256, (int)gridDim.x, oblk(), 8}; S.A = (const char*)(p.ws + WS_H); S.B = (const char*)wl_ptr(p, l, WL_IN); S.lda = D * 2; S.ldb = D * 2; S.nt = D / 64;
    pg::EpiInproj E{(bf16*)(p.ws + WS_Z)};
    pg::gemm_phase(( LAS unsigned char*)lds_, S, E);
}
__device__ __forceinline__ void ph_mlaproj_fast(const Params& p, int l, unsigned char* lds_) {
    const int tid = otid();
    pg::SchedMla S{(int)gridDim.x, oblk(), (const char*)(p.ws + WS_Z), (const char*)wl_ptr(p, l, WL_UQ), (const char*)wl_ptr(p, l, WL_UKV)};
    LAS float* rstab = (LAS float*)((LAS unsigned char*)lds_ + LDS_RS_OFF);
    { pg::GUnit u; const int rl = tid >> 1, hf = tid & 1;
      for (int i = 0; i < 4 && S.next(i, u); ++i) { const int K = u.aux ? KVR : QR; const bf16* zr = (const bf16*)u.A + (size_t)rl * ZW + hf * (K / 2);
          float s = 0.f; for (int k = 0; k < K / 2; k += 8) { const uint4 w = *(const uint4*)(zr + k); const unsigned ww[4] = {w.x, w.y, w.z, w.w};
#pragma unroll
              for (int j = 0; j < 4; ++j) { const float a = __uint_as_float(ww[j] << 16), b = __uint_as_float(ww[j] & 0xffff0000u); s += a * a + b * b; } }
          s += __shfl_xor(s, 1);
          if (hf == 0) rstab[i * 256 + rl] = rsqrtf(s * (u.aux ? (1.f / KVR) : (1.f / QR)) + EPS); } }
    __syncthreads();
    pg::EpiMla E{(bf16*)(p.ws + WS_Q), (bf16*)(p.ws + WS_KB), (bf16*)(p.ws + WS_VB), (const float*)(p.ws + WS_ROPE), rstab};
    pg::gemm_phase((LAS unsigned char*)lds_, S, E);
    { bf16* Kb = (bf16*)(p.ws + WS_KB); const bf16* z = (const bf16*)(p.ws + WS_Z); const float* rope = (const float*)(p.ws + WS_ROPE);
      for (long i = GTID; i < (long)T * ROPE; i += GTOT) { const int d = (int)(i & 31), r = (int)(i >> 5);
          float v = bf2f(z[(size_t)r * ZW + Z_KR + d]);
          if (r < TL) rope_pair(rope, r, d, v, bf2f(z[(size_t)r * ZW + Z_KR + (d ^ 8)]), v);
          const bf16 o = f2bf(v); const size_t kr = (size_t)row_krow(r);
#pragma unroll
          for (int hd = 0; hd < MH; ++hd) Kb[kr * QW + hd * QKD + 64 + d] = o; } }
}
__device__ __forceinline__ void ph_merge_fast(const Params& p, int l, unsigned char* lds_) {
    const int tid = otid();
    const int nM = (l == DEPTH - 1) ? TL / 256 : T / 256;
    pg::SchedSimple S; S.o = pg::GridOrder{nM, D / 256, (int)gridDim.x, oblk(), 8}; S.A = (const char*)(p.ws + WS_ABP); S.B = (const char*)wl_ptr(p, l, WL_CAT); S.lda = D * 2; S.ldb = D * 2; S.nt = D / 64;
    pg::EpiMerge E{(const bf16*)(p.ws + WS_Z), (bf16*)(p.ws + WS_M)};
    pg::gemm_phase((LAS unsigned char*)lds_, S, E);
}
__device__ __forceinline__ void ph_outproj_fast(const Params& p, int l, unsigned char* lds_) {
    const int tid = otid();
    const bool ksplit = (l != DEPTH - 1) && gridDim.x == 256;
    const int nM = (l == DEPTH - 1 || ksplit) ? TL / 256 : T / 256;
    pg::SchedOut S; S.sel = nullptr; S.seltab = nullptr; S.o = pg::GridOrder{nM, D / 256, (int)gridDim.x, oblk(), 8}; S.ksplit = ksplit ? 1 : 0; S.A = (const char*)(p.ws + WS_M); S.B = (const char*)wl_ptr(p, l, WL_OUT); S.lda = D * 2; S.ldb = D * 2; S.nt = D / 64;
    pg::EpiOut E{p.in[I_X], p.in[I_CTX], (const float*)(p.ws + WS_XA), (float*)(p.ws + WS_XA), (const float*)(p.ws + WS_MOD) + (size_t)l * 3 * 6144, l, (float*)(p.ws + WS_SLAB)};
    pg::gemm_phase((LAS unsigned char*)lds_, S, E);
}
__device__ __forceinline__ void ph_moeup_fast(const Params& p, int l, unsigned char* lds_) {
    const int tid = otid();
    const int tpe = (l == DEPTH - 1) ? 8 : 9;
    pg::SchedMoe<true> S; S.sel = (const int*)(p.ws + WS_SEL); S.o = pg::GridOrder{NE * tpe, 2 * FF / 256, (int)gridDim.x, oblk(), 4}; S.tpe = tpe; S.A = (const char*)(p.ws + WS_H); S.B = (const char*)wl_ptr(p, l, WL_GU);
    S.lda = D * 2; S.ldb = D * 2; S.bstride = (size_t)2 * FF * D * 2; S.nt = D / 64;
    { LAS int* tab = (LAS int*)((LAS unsigned char*)lds_ + LDS_RS_OFF); S.seltab = tab; pg::GUnit u;
      __syncthreads();
      for (int i = 0; i < 12 && S.next(i, u); ++i) if (tid < 256) tab[i * 256 + tid] = S.sel[u.pm * 256 + tid];
      __syncthreads(); }
    pg::EpiMoeUp E{(bf16*)(p.ws + WS_ACT)};
    pg::gemm_phase((LAS unsigned char*)lds_, S, E);
}
__device__ __forceinline__ void ph_moedown_fast(const Params& p, int l, unsigned char* lds_) {
    const int tid = otid();
    const bool ksplit = (l != DEPTH - 1) && gridDim.x == 256;
    const int tpe = (l == DEPTH - 1 || ksplit) ? 8 : 9;
    pg::SchedMoeDown S; S.sel = nullptr; S.seltab = nullptr; S.o = pg::GridOrder{NE * tpe, D / 256, (int)gridDim.x, oblk(), tpe}; S.ksplit = ksplit ? 1 : 0; S.A = (const char*)(p.ws + WS_ACT); S.B = (const char*)wl_ptr(p, l, WL_DN);
    S.lda = FF * 2; S.ldb = FF * 2; S.bstride = (size_t)D * FF * 2; S.nt = FF / 64;
    pg::EpiMoeDown E{(bf16*)(p.ws + WS_Y), (const float*)(p.ws + WS_GVX), (float*)(p.ws + WS_SLAB)};
    pg::gemm_phase((LAS unsigned char*)lds_, S, E);
}

namespace mla {
using bf16x8 = __attribute__((ext_vector_type(8))) short;
using s16x4  = __attribute__((ext_vector_type(4))) short;
using f32x16 = __attribute__((ext_vector_type(16))) float;
using u32x4  = __attribute__((ext_vector_type(4))) unsigned;
constexpr int KVBLK = 64;
constexpr float SCALE = 0.10206207261596575f, THR = 8.f;
constexpr int SHM_V = 64 * 64 * 2, SHM_K = 64 * 256;
constexpr int LDS_BYTES = 2 * SHM_V + 2 * SHM_K + 8 * 64 * 4;
#define KSWZ(row, colB) ((row) * 256 + ((colB) ^ (((row) & 15) << 4)))
#define SBAR() __builtin_amdgcn_sched_barrier(0)
__device__ __forceinline__ int crow(int r, int hi) { return (r & 3) + 8 * (r >> 2) + 4 * hi; }
__device__ __forceinline__ unsigned cvtpk(float lo, float hi) { unsigned r; asm volatile("v_cvt_pk_bf16_f32 %0, %1, %2" : "=v"(r) : "v"(lo), "v"(hi)); return r; }
__device__ __forceinline__ void store_tile_rows(char* wl, const f32x16& o0, const f32x16& o1, bf16* dst, long stride, int lane) {
    const int r32 = lane & 31, hi = lane >> 5; unsigned short* w = (unsigned short*)wl;
#pragma unroll
    for (int r = 0; r < 16; ++r) { const unsigned v = cvtpk(o0[r], o1[r]); const int row = crow(r, hi); w[row * 72 + r32] = (unsigned short)(v & 0xffffu); w[row * 72 + 32 + r32] = (unsigned short)(v >> 16); }
    asm volatile("s_waitcnt lgkmcnt(0)" ::: "memory");
#pragma unroll
    for (int i = 0; i < 4; ++i) { const int row = i * 8 + (lane >> 3), ch = lane & 7; const u32x4 v = *(const u32x4*)(wl + row * 144 + ch * 16); *(u32x4*)(dst + (long)row * stride + ch * 8) = v; }
    asm volatile("s_waitcnt lgkmcnt(0)" ::: "memory");
}
constexpr float THR2 = THR * 1.4426950408889634f;
__device__ __forceinline__ void partialSM(f32x16& p0, f32x16& p1, float& m_reg, float& mn, float& alpha) {
    float pmax = p0[0];
#pragma unroll
    for (int r = 1; r < 16; ++r) pmax = fmaxf(pmax, p0[r]);
#pragma unroll
    for (int r = 0; r < 16; ++r) pmax = fmaxf(pmax, p1[r]);
    { auto rr = __builtin_amdgcn_permlane32_swap(__float_as_uint(pmax), __float_as_uint(pmax), false, false); pmax = fmaxf(__uint_as_float(rr[0]), __uint_as_float(rr[1])); }
    if (__builtin_expect(__all(pmax - m_reg <= THR2), 1)) { mn = m_reg; alpha = 1.f; }
    else { mn = fmaxf(m_reg, pmax); alpha = __builtin_amdgcn_exp2f(m_reg - mn); m_reg = mn; }
#pragma unroll
    for (int r = 0; r < 16; ++r) p0[r] -= mn;
#pragma unroll
    for (int r = 0; r < 16; ++r) p1[r] -= mn;
#pragma unroll
    for (int r = 0; r < 16; ++r) p0[r] = __builtin_amdgcn_exp2f(p0[r]);
}
__device__ __forceinline__ float expsum(f32x16& p0, f32x16& p1) {
#pragma unroll
    for (int r = 0; r < 16; ++r) p0[r] = __builtin_amdgcn_exp2f(p0[r]);
#pragma unroll
    for (int r = 0; r < 16; ++r) p1[r] = __builtin_amdgcn_exp2f(p1[r]);
    float sa = 0;
#pragma unroll
    for (int r = 0; r < 16; ++r) sa += p0[r];
#pragma unroll
    for (int r = 0; r < 16; ++r) sa += p1[r];
    { auto rr = __builtin_amdgcn_permlane32_swap(__float_as_uint(sa), __float_as_uint(sa), false, false); sa = __uint_as_float(rr[0]) + __uint_as_float(rr[1]); }
    return sa;
}
__device__ __forceinline__ void packP(const f32x16& p0, const f32x16& p1, bf16x8& pa0, bf16x8& pa1, bf16x8& pa2, bf16x8& pa3) {
#define PK4(P, BASE, OUT) do { unsigned a0 = cvtpk(P[BASE + 0], P[BASE + 1]), a1 = cvtpk(P[BASE + 2], P[BASE + 3]);   \
    unsigned b0 = cvtpk(P[BASE + 4], P[BASE + 5]), b1 = cvtpk(P[BASE + 6], P[BASE + 7]);                              \
    auto r0 = __builtin_amdgcn_permlane32_swap(a0, b0, false, false); auto r1 = __builtin_amdgcn_permlane32_swap(a1, b1, false, false); \
    u32x4 w = {r0[0], r1[0], r0[1], r1[1]}; OUT = *reinterpret_cast<bf16x8*>(&w); } while (0)
    PK4(p0, 0, pa0); PK4(p0, 8, pa1); PK4(p1, 0, pa2); PK4(p1, 8, pa3);
#undef PK4
}
__device__ __forceinline__ void finishSM(f32x16& p0, f32x16& p1, float alpha, float& l_reg, bf16x8& pa0, bf16x8& pa1, bf16x8& pa2, bf16x8& pa3) {
#pragma unroll
    for (int r = 0; r < 16; ++r) p1[r] = __builtin_amdgcn_exp2f(p1[r]);
    float ps = 0;
#pragma unroll
    for (int r = 0; r < 16; ++r) ps += p0[r];
#pragma unroll
    for (int r = 0; r < 16; ++r) ps += p1[r];
    { auto rr = __builtin_amdgcn_permlane32_swap(__float_as_uint(ps), __float_as_uint(ps), false, false); ps = __uint_as_float(rr[0]) + __uint_as_float(rr[1]); }
    l_reg = l_reg * alpha + ps;
#define PK4(P, BASE, OUT) do { unsigned a0 = cvtpk(P[BASE + 0], P[BASE + 1]), a1 = cvtpk(P[BASE + 2], P[BASE + 3]);   \
    unsigned b0 = cvtpk(P[BASE + 4], P[BASE + 5]), b1 = cvtpk(P[BASE + 6], P[BASE + 7]);                              \
    auto r0 = __builtin_amdgcn_permlane32_swap(a0, b0, false, false); auto r1 = __builtin_amdgcn_permlane32_swap(a1, b1, false, false); \
    u32x4 w = {r0[0], r1[0], r0[1], r1[1]}; OUT = *reinterpret_cast<bf16x8*>(&w); } while (0)
    PK4(p0, 0, pa0); PK4(p0, 8, pa1); PK4(p1, 0, pa2); PK4(p1, 8, pa3);
#undef PK4
}
__device__ __forceinline__ void qkt(f32x16& p0, f32x16& p1, const char* Ks, const bf16x8* qr, int r32, int hi) {
    p0 = f32x16{}; p1 = f32x16{};
#pragma unroll
    for (int d0 = 0; d0 < 6; ++d0) { const int cb = (d0 * 16 + hi * 8) * 2;
        bf16x8 b0 = *reinterpret_cast<const bf16x8*>(Ks + KSWZ(r32, cb));
        bf16x8 b1 = *reinterpret_cast<const bf16x8*>(Ks + KSWZ(32 + r32, cb));
        p0 = __builtin_amdgcn_mfma_f32_32x32x16_bf16(b0, qr[d0], p0, 0, 0, 0);
        p1 = __builtin_amdgcn_mfma_f32_32x32x16_bf16(b1, qr[d0], p1, 0, 0, 0); }
}
__device__ __forceinline__ int v_st(int k, int c) { const int kk = (k & ~0xC) | ((k & 4) << 1) | ((k & 8) >> 1); return ((kk >> 3) * 2 + (c >> 5)) * 512 + ((kk & 7) * 32 + (c & 31)) * 2; }
__device__ __forceinline__ int v_rd_base(int lane) { return ((lane & 3) << 3) | (((lane >> 2) & 3) << 6) | (((lane >> 4) & 1) << 5) | (((lane >> 5) & 1) << 8); }
constexpr int v_rd_off(int d0, int ks, int half) { return d0 * 512 + ks * 2048 + half * 1024; }
template <int OFF> __device__ __forceinline__ s16x4 tr_read(int vb) { s16x4 r; asm volatile("ds_read_b64_tr_b16 %0, %1 offset:%2" : "=&v"(r) : "v"(vb), "i"(OFF) : "memory"); return r; }
template <int D0> __device__ __forceinline__ void pv_one(f32x16& od, int vb, bf16x8 pa0, bf16x8 pa1, bf16x8 pa2, bf16x8 pa3) {
    const s16x4 l0 = tr_read<v_rd_off(D0, 0, 0)>(vb), h0 = tr_read<v_rd_off(D0, 0, 1)>(vb), l1 = tr_read<v_rd_off(D0, 1, 0)>(vb), h1 = tr_read<v_rd_off(D0, 1, 1)>(vb);
    const s16x4 l2 = tr_read<v_rd_off(D0, 2, 0)>(vb), h2 = tr_read<v_rd_off(D0, 2, 1)>(vb), l3 = tr_read<v_rd_off(D0, 3, 0)>(vb), h3 = tr_read<v_rd_off(D0, 3, 1)>(vb);
    asm volatile("s_waitcnt lgkmcnt(0)" ::: "memory"); SBAR();
#define PK(L, H) (bf16x8){L[0], L[1], L[2], L[3], H[0], H[1], H[2], H[3]}
    od = __builtin_amdgcn_mfma_f32_32x32x16_bf16(pa0, PK(l0, h0), od, 0, 0, 0);
    od = __builtin_amdgcn_mfma_f32_32x32x16_bf16(pa1, PK(l1, h1), od, 0, 0, 0);
    od = __builtin_amdgcn_mfma_f32_32x32x16_bf16(pa2, PK(l2, h2), od, 0, 0, 0);
    od = __builtin_amdgcn_mfma_f32_32x32x16_bf16(pa3, PK(l3, h3), od, 0, 0, 0);
#undef PK
}
__device__ __forceinline__ void pv_d0(f32x16& o0, f32x16& o1, int vb, bf16x8 pa0, bf16x8 pa1, bf16x8 pa2, bf16x8 pa3) { pv_one<0>(o0, vb, pa0, pa1, pa2, pa3); pv_one<1>(o1, vb, pa0, pa1, pa2, pa3); }

__device__ __forceinline__ void attn_unit(const bf16* __restrict__ Qb, const bf16* __restrict__ Kh, const bf16* __restrict__ Vh, bf16* __restrict__ Ob, int nkeys, char* lds, int tid) {
    asm volatile("" : "+v"(tid));
    const int wid = __builtin_amdgcn_readfirstlane(tid >> 6), lane = tid & 63, r32 = lane & 31, hi = lane >> 5;
    char* V_lds = lds; char* K_lds = lds + 2 * SHM_V;
    float* ws = (float*)(lds + 2 * SHM_V + 2 * SHM_K) + wid * 64; float* li_l = ws; float* al_l = ws + 32;
    float m_reg = -1e30f, l_reg = 0; f32x16 o0 = {}, o1 = {}; bf16x8 qr[6];
    const bf16* Qw = Qb + (long)(wid * 32 + r32) * QW + hi * 8;
#pragma unroll
    for (int d0 = 0; d0 < 6; ++d0) qr[d0] = *reinterpret_cast<const bf16x8*>(Qw + d0 * 16);
    const int kr0 = tid / 12, kc0 = tid % 12, kr1 = (tid + 512) / 12, kc1 = (tid + 512) % 12, vr = tid >> 3, vc = tid & 7;
    const bool two = wid < 4;
    const int kst0 = KSWZ(kr0, kc0 * 16), kst1 = KSWZ(kr1, kc1 * 16), vst = v_st(vr, vc * 8);
    const bf16* kg0 = Kh + (long)kr0 * QW + kc0 * 8; const bf16* kg1 = Kh + (long)kr1 * QW + kc1 * 8; const bf16* vg = Vh + (long)vr * AW + vc * 8;
    const int vb0 = (int)(uintptr_t)V_lds + v_rd_base(lane);
    bf16x8 sk0[2], sk1[2], sv[2];
#define SLOAD(i, k0) do { sv[i] = *reinterpret_cast<const bf16x8*>(vg + (long)(k0) * AW); sk0[i] = *reinterpret_cast<const bf16x8*>(kg0 + (long)(k0) * QW); if (two) sk1[i] = *reinterpret_cast<const bf16x8*>(kg1 + (long)(k0) * QW); } while (0)
#define SWRITE(b, i) do { *(bf16x8*)(V_lds + (b) * SHM_V + vst) = sv[i]; *(bf16x8*)(K_lds + (b) * SHM_K + kst0) = sk0[i]; if (two) *(bf16x8*)(K_lds + (b) * SHM_K + kst1) = sk1[i]; } while (0)
#define SWAIT() do { if (two) asm volatile("s_waitcnt vmcnt(3)" ::: "memory"); else asm volatile("s_waitcnt vmcnt(2)" ::: "memory"); } while (0)
#define RESC(a) do { if (__any((a) < 1.f)) { if (hi == 0) al_l[r32] = (a); asm volatile("s_waitcnt lgkmcnt(0)" ::: "memory"); \
    _Pragma("unroll") for (int r = 0; r < 16; ++r) { const float f = al_l[crow(r, hi)]; o0[r] *= f; o1[r] *= f; } } } while (0)
    f32x16 pA0, pA1, pB0, pB1; float mnA, mnB, alA, alB; bf16x8 pa0, pa1, pa2, pa3; const int NTL = nkeys / KVBLK;
    __syncthreads();
    SLOAD(0, 0); asm volatile("s_waitcnt vmcnt(0)" ::: "memory"); SWRITE(0, 0); __syncthreads();
    qkt(pA0, pA1, K_lds, qr, r32, hi); partialSM(pA0, pA1, m_reg, mnA, alA);
    SLOAD(1, KVBLK); if (2 < NTL) SLOAD(0, 2 * KVBLK);
    SWAIT(); SWRITE(1, 1); __syncthreads();
    for (int j = 1; j + 1 < NTL; j += 2) {
        SBAR(); qkt(pB0, pB1, K_lds + SHM_K, qr, r32, hi);
        finishSM(pA0, pA1, alA, l_reg, pa0, pa1, pa2, pa3); SBAR();
        SLOAD(1, (j + 2) * KVBLK); SBAR();
        pv_d0(o0, o1, vb0, pa0, pa1, pa2, pa3); partialSM(pB0, pB1, m_reg, mnB, alB);
        __syncthreads(); SWAIT(); SWRITE(0, 0);
        RESC(alB); __syncthreads();
        SBAR(); qkt(pA0, pA1, K_lds, qr, r32, hi);
        finishSM(pB0, pB1, alB, l_reg, pa0, pa1, pa2, pa3); SBAR();
        if (j + 3 < NTL) SLOAD(0, (j + 3) * KVBLK); SBAR();
        pv_d0(o0, o1, vb0 + SHM_V, pa0, pa1, pa2, pa3); partialSM(pA0, pA1, m_reg, mnA, alA);
        __syncthreads(); SWAIT(); SWRITE(1, 1);
        RESC(alA); __syncthreads();
    }
    SBAR(); qkt(pB0, pB1, K_lds + SHM_K, qr, r32, hi);
    finishSM(pA0, pA1, alA, l_reg, pa0, pa1, pa2, pa3); SBAR();
    pv_d0(o0, o1, vb0, pa0, pa1, pa2, pa3); partialSM(pB0, pB1, m_reg, mnB, alB);
    __syncthreads(); RESC(alB);
    finishSM(pB0, pB1, alB, l_reg, pa0, pa1, pa2, pa3); SBAR();
    pv_d0(o0, o1, vb0 + SHM_V, pa0, pa1, pa2, pa3);
    if (hi == 0) li_l[r32] = l_reg; asm volatile("s_waitcnt lgkmcnt(0)" ::: "memory");
#pragma unroll
    for (int r = 0; r < 16; ++r) { const float rl = __builtin_amdgcn_rcpf(li_l[crow(r, hi)]); o0[r] *= rl; o1[r] *= rl; }
    __syncthreads();
    store_tile_rows(lds + wid * 4608, o0, o1, Ob + (long)(wid * 32) * D, D, lane);
#undef SLOAD
#undef SWRITE
#undef SWAIT
#undef RESC
}

struct CvtSide {
    const float* wg; long du, dd; bf16* gu; bf16* dn; int on;
    __device__ __forceinline__ void setup(int e, int sub, int run, int tid, const char*& sb, char*& db, unsigned& slo, unsigned& dlo, int& sh) const {
        const int nl = (tid >> 6) * 16 + (tid & 15), kp = (tid & 63) >> 4; const bool isdn = run == 2;
        const int N = isdn ? D : FF, K = isdn ? FF : D; sh = isdn ? 12 : 13;
        const size_t so = (size_t)e * D * FF + (isdn ? (size_t)((sub & 1) * 1024) * D + (sub >> 1) * 128 : (size_t)sub * 128);
        sb = (const char*)(wg + (run == 1 ? du : 0) + (isdn ? dd : 0) + so);
        db = (char*)((isdn ? dn : gu) + (isdn ? (size_t)e * D * FF + (size_t)((sub >> 1) * 128) * FF + (sub & 1) * 1024 : (size_t)e * 2 * FF * D + (size_t)(256 * sub + 128 * run) * D));
        slo = (unsigned)(kp * 8 * N + nl) * 4u; dlo = (unsigned)(nl * K + kp * 8) * 2u;
    }
    __device__ __forceinline__ void load(const char*& sb, unsigned slo, int sh, float (&v)[8]) const {
#pragma unroll
        for (int i = 0; i < 8; ++i) v[i] = *(const float*)(sb + (slo + ((unsigned)i << sh)));
        sb += (size_t)32 << sh;
    }
    __device__ __forceinline__ void store(char*& db, unsigned dlo, const float (&v)[8]) const {
        u32x4 w; w.x = cvtpk(v[0], v[1]); w.y = cvtpk(v[2], v[3]); w.z = cvtpk(v[4], v[5]); w.w = cvtpk(v[6], v[7]);
        *(u32x4*)(db + dlo) = w; db += 64;
    }
};

template <int D0> __device__ __forceinline__ void pv_one2(f32x16& oa, f32x16& ob, int vb, bf16x8 a0, bf16x8 a1, bf16x8 a2, bf16x8 a3, bf16x8 b0, bf16x8 b1, bf16x8 b2, bf16x8 b3) {
    const s16x4 l0 = tr_read<v_rd_off(D0, 0, 0)>(vb), h0 = tr_read<v_rd_off(D0, 0, 1)>(vb), l1 = tr_read<v_rd_off(D0, 1, 0)>(vb), h1 = tr_read<v_rd_off(D0, 1, 1)>(vb);
    const s16x4 l2 = tr_read<v_rd_off(D0, 2, 0)>(vb), h2 = tr_read<v_rd_off(D0, 2, 1)>(vb), l3 = tr_read<v_rd_off(D0, 3, 0)>(vb), h3 = tr_read<v_rd_off(D0, 3, 1)>(vb);
    asm volatile("s_waitcnt lgkmcnt(0)" ::: "memory"); SBAR();
#define PK(L, H) (bf16x8){L[0], L[1], L[2], L[3], H[0], H[1], H[2], H[3]}
    const bf16x8 v0 = PK(l0, h0), v1 = PK(l1, h1), v2 = PK(l2, h2), v3 = PK(l3, h3);
    oa = __builtin_amdgcn_mfma_f32_32x32x16_bf16(a0, v0, oa, 0, 0, 0); ob = __builtin_amdgcn_mfma_f32_32x32x16_bf16(b0, v0, ob, 0, 0, 0);
    oa = __builtin_amdgcn_mfma_f32_32x32x16_bf16(a1, v1, oa, 0, 0, 0); ob = __builtin_amdgcn_mfma_f32_32x32x16_bf16(b1, v1, ob, 0, 0, 0);
    oa = __builtin_amdgcn_mfma_f32_32x32x16_bf16(a2, v2, oa, 0, 0, 0); ob = __builtin_amdgcn_mfma_f32_32x32x16_bf16(b2, v2, ob, 0, 0, 0);
    oa = __builtin_amdgcn_mfma_f32_32x32x16_bf16(a3, v3, oa, 0, 0, 0); ob = __builtin_amdgcn_mfma_f32_32x32x16_bf16(b3, v3, ob, 0, 0, 0);
#undef PK
}
__device__ __forceinline__ void attn_unit2(const bf16* __restrict__ Qb, const bf16* __restrict__ Kh, const bf16* __restrict__ Vh, bf16* __restrict__ Ob, int nkeys, char* lds, int tid, const CvtSide& side, int cbase) {
    asm volatile("" : "+v"(tid));
    const int wid = __builtin_amdgcn_readfirstlane(tid >> 6), lane = tid & 63, r32 = lane & 31, hi = lane >> 5;
    char* V_lds = lds; char* K_lds = lds + 4 * SHM_V;
    float* ws = (float*)(lds + 4 * SHM_V + 4 * SHM_K) + wid * 128; float* liA = ws; float* liB = ws + 32; float* alA_l = ws + 64; float* alB_l = ws + 96;
    float mA = 0.f, lA = 0, mB = 0.f, lB = 0; bool slow = false; f32x16 oA0 = {}, oA1 = {}, oB0 = {}, oB1 = {}; bf16x8 qA[6], qB[6];
    const bf16* Qw = Qb + (long)(wid * 64 + r32) * QW + hi * 8;
#pragma unroll
    for (int d0 = 0; d0 < 6; ++d0) { qA[d0] = *reinterpret_cast<const bf16x8*>(Qw + d0 * 16); qB[d0] = *reinterpret_cast<const bf16x8*>(Qw + 32 * QW + d0 * 16); }
    const int kr0 = tid / 12, kc0 = tid % 12, kr1 = (tid + 512) / 12, kc1 = (tid + 512) % 12, vr = tid >> 3, vc = tid & 7;
    const bool two = wid < 4;
    const int kst0 = KSWZ(kr0, kc0 * 16), kst1 = KSWZ(kr1, kc1 * 16), vst = v_st(vr, vc * 8);
    const bf16* kg0 = Kh + (long)kr0 * QW + kc0 * 8; const bf16* kg1 = Kh + (long)kr1 * QW + kc1 * 8; const bf16* vg = Vh + (long)vr * AW + vc * 8;
    const int vb0 = (int)(uintptr_t)V_lds + v_rd_base(lane);
    bf16x8 sk0, sk1, sv;
#define SLOAD2(k0) do { sv = *reinterpret_cast<const bf16x8*>(vg + (long)(k0) * AW); sk0 = *reinterpret_cast<const bf16x8*>(kg0 + (long)(k0) * QW); if (two) sk1 = *reinterpret_cast<const bf16x8*>(kg1 + (long)(k0) * QW); } while (0)
#define TBUF(t) (((((t) >> 1) & 1) << 1) | ((t) & 1))
#define SWRITE2(b) do { *(bf16x8*)(V_lds + (b) * SHM_V + vst) = sv; *(bf16x8*)(K_lds + (b) * SHM_K + kst0) = sk0; if (two) *(bf16x8*)(K_lds + (b) * SHM_K + kst1) = sk1; } while (0)
#define RESC2(a, al_l, o0, o1) do { if (__any((a) < 1.f)) { if (hi == 0) al_l[r32] = (a); asm volatile("s_waitcnt lgkmcnt(0)" ::: "memory"); \
    _Pragma("unroll") for (int r = 0; r < 16; ++r) { const float f = al_l[crow(r, hi)]; o0[r] *= f; o1[r] *= f; } } } while (0)
    const int NTL = nkeys / KVBLK;
    __syncthreads();
    SLOAD2(0); SWRITE2(TBUF(0)); SLOAD2(KVBLK); SWRITE2(TBUF(1)); SLOAD2(2 * KVBLK);
    if (wid >= 4) __builtin_amdgcn_s_setprio(1);
    const char* sd_sb = nullptr; char* sd_db = nullptr; unsigned sd_slo = 0, sd_dlo = 0; int sd_sh = 12;
    for (int j = 0; j < NTL; ++j) {
        if ((j & 1) == 0) __syncthreads();
        if (j + 2 < NTL) { SWRITE2(TBUF(j + 2)); if (j + 3 < NTL) SLOAD2((j + 3) * KVBLK); }
        float cv[8]; const bool cvt_on = side.on && j < 96;
        if (cvt_on) { if ((j & 31) == 0) side.setup(cbase >> 4, cbase & 15, j >> 5, tid, sd_sb, sd_db, sd_slo, sd_dlo, sd_sh); side.load(sd_sb, sd_slo, sd_sh, cv); }
        const char* Ks = K_lds + TBUF(j) * SHM_K; const int vb = vb0 + TBUF(j) * SHM_V;
        float mn, al; bf16x8 a0, a1, a2, a3, c0, c1, c2, c3;
        if (__builtin_expect(!slow, 1)) {
            float psA, psB;
#if MLA_ILV
            {
                f32x16 pA0, pA1; qkt(pA0, pA1, Ks, qA, r32, hi);
                f32x16 pB0 = {}, pB1 = {}; float sA = 0.f;
#define BSTEP(d0) do { const int cb_ = ((d0) * 16 + hi * 8) * 2; const bf16x8 b0_ = *reinterpret_cast<const bf16x8*>(Ks + KSWZ(r32, cb_)), b1_ = *reinterpret_cast<const bf16x8*>(Ks + KSWZ(32 + r32, cb_)); \
                    pB0 = __builtin_amdgcn_mfma_f32_32x32x16_bf16(b0_, qB[d0], pB0, 0, 0, 0); pB1 = __builtin_amdgcn_mfma_f32_32x32x16_bf16(b1_, qB[d0], pB1, 0, 0, 0); } while (0)
#define ACHUNK(P, BASE, OUT) do { _Pragma("unroll") for (int r_ = 0; r_ < 8; ++r_) { P[BASE + r_] = __builtin_amdgcn_exp2f(P[BASE + r_]); sA += P[BASE + r_]; } \
                    unsigned x0_ = cvtpk(P[BASE + 0], P[BASE + 1]), x1_ = cvtpk(P[BASE + 2], P[BASE + 3]), y0_ = cvtpk(P[BASE + 4], P[BASE + 5]), y1_ = cvtpk(P[BASE + 6], P[BASE + 7]); \
                    auto r0_ = __builtin_amdgcn_permlane32_swap(x0_, y0_, false, false); auto r1_ = __builtin_amdgcn_permlane32_swap(x1_, y1_, false, false); \
                    u32x4 w_ = {r0_[0], r1_[0], r0_[1], r1_[1]}; OUT = *reinterpret_cast<bf16x8*>(&w_); } while (0)
                BSTEP(0); ACHUNK(pA0, 0, a0); SBAR();
                BSTEP(1); ACHUNK(pA0, 8, a1); SBAR();
                BSTEP(2); ACHUNK(pA1, 0, a2); SBAR();
                BSTEP(3); ACHUNK(pA1, 8, a3); SBAR();
                BSTEP(4); BSTEP(5);
#undef BSTEP
#undef ACHUNK
                { auto rr = __builtin_amdgcn_permlane32_swap(__float_as_uint(sA), __float_as_uint(sA), false, false); psA = __uint_as_float(rr[0]) + __uint_as_float(rr[1]); }
                psB = expsum(pB0, pB1); packP(pB0, pB1, c0, c1, c2, c3);
            }
#else
            { f32x16 p0, p1; qkt(p0, p1, Ks, qA, r32, hi); psA = expsum(p0, p1); packP(p0, p1, a0, a1, a2, a3); }
            { f32x16 p0, p1; qkt(p0, p1, Ks, qB, r32, hi); psB = expsum(p0, p1); packP(p0, p1, c0, c1, c2, c3); }
#endif
            const bool bad = !(psA < 1.0e12f) || !(psB < 1.0e12f) || (j == 0 && (!(psA > 1.0e-18f) || !(psB > 1.0e-18f)));
            if (__builtin_expect(__any(bad), 0)) { slow = true; if (j == 0) { mA = -1e30f; mB = -1e30f; } }
            else { lA += psA; lB += psB; }
        }
        if (__builtin_expect(slow, 0)) {
            { f32x16 p0, p1; qkt(p0, p1, Ks, qA, r32, hi); partialSM(p0, p1, mA, mn, al); RESC2(al, alA_l, oA0, oA1); finishSM(p0, p1, al, lA, a0, a1, a2, a3); }
            { f32x16 p0, p1; qkt(p0, p1, Ks, qB, r32, hi); partialSM(p0, p1, mB, mn, al); RESC2(al, alB_l, oB0, oB1); finishSM(p0, p1, al, lB, c0, c1, c2, c3); }
        }
        pv_one2<0>(oA0, oB0, vb, a0, a1, a2, a3, c0, c1, c2, c3);
        pv_one2<1>(oA1, oB1, vb, a0, a1, a2, a3, c0, c1, c2, c3);
        if (cvt_on) side.store(sd_db, sd_dlo, cv);
    }
    __builtin_amdgcn_s_setprio(0);
    if (hi == 0) { liA[r32] = lA; liB[r32] = lB; } asm volatile("s_waitcnt lgkmcnt(0)" ::: "memory");
#pragma unroll
    for (int r = 0; r < 16; ++r) { const int orow = crow(r, hi); const float ra = __builtin_amdgcn_rcpf(liA[orow]), rb = __builtin_amdgcn_rcpf(liB[orow]); oA0[r] *= ra; oA1[r] *= ra; oB0[r] *= rb; oB1[r] *= rb; }
    __syncthreads();
    store_tile_rows(lds + wid * 9216, oA0, oA1, Ob + (long)(wid * 64) * D, D, lane);
    store_tile_rows(lds + wid * 9216 + 4608, oB0, oB1, Ob + (long)(wid * 64 + 32) * D, D, lane);
#undef SLOAD2
#undef SWRITE2
#undef TBUF
#undef RESC2
}
#undef KSWZ
#undef SBAR
}

__device__ __forceinline__ void ph_mla_fast(const Params& p, int l, unsigned char* lds_) {
    const int tid = otid();
    const bf16* q = (const bf16*)(p.ws + WS_Q); const bf16* Kb = (const bf16*)(p.ws + WS_KB); const bf16* Vb = (const bf16*)(p.ws + WS_VB); bf16* abp = (bf16*)(p.ws + WS_ABP);
#if MLA_V2
    const mla::CvtSide side{p.in[I_WGATE] + (size_t)l * NE * D * FF, (long)(p.in[I_WUP] - p.in[I_WGATE]), (long)(p.in[I_WDOWN] - p.in[I_WGATE]), wl_ptr(p, l, WL_GU), wl_ptr(p, l, WL_DN), (gridDim.x == 256) ? 1 : 0};
    for (int u = blockIdx.x; u < 256; u += gridDim.x) { const int hd = u & 7, jj = u >> 3, b = jj >> 4, row0 = b * SEQ + (jj & 15) * 512;
        mla::attn_unit2(q + (size_t)row0 * QW + hd * QKD, Kb + (size_t)b * NKEY * QW + hd * QKD, Vb + (size_t)b * NKEY * AW + hd * VD, abp + (size_t)row0 * D + hd * VD, NKEY, (char*)lds_, tid, side, u); }
    if (l == 0) for (int c = blockIdx.x; c < 16; c += gridDim.x) { const int b = c >> 3, hd = c & 7, row0 = TL + b * CTX;
        mla::attn_unit(q + (size_t)row0 * QW + hd * QKD, Kb + (size_t)b * NKEY * QW + hd * QKD, Vb + (size_t)b * NKEY * AW + hd * VD, abp + (size_t)row0 * D + hd * VD, CTX, (char*)lds_, tid); }
#else
    for (int u = blockIdx.x; u < 512 + (l == 0 ? 16 : 0); u += gridDim.x) {
        int b, hd, row0, nkeys;
        if (u < 512) { const int c = u & 255; b = u >> 8; hd = c & 7; row0 = b * SEQ + (c >> 3) * 256; nkeys = NKEY; }
        else { const int c = u - 512; b = c >> 3; hd = c & 7; row0 = TL + b * CTX; nkeys = CTX; }
        mla::attn_unit(q + (size_t)row0 * QW + hd * QKD, Kb + (size_t)b * NKEY * QW + hd * QKD, Vb + (size_t)b * NKEY * AW + hd * VD, abp + (size_t)row0 * D + hd * VD, nkeys, (char*)lds_, tid);
    }
#endif
}

namespace na {
using mla::bf16x8; using mla::s16x4; using mla::f32x16; using mla::u32x4;
constexpr int TILE_B = 65536;
constexpr int OFF_RPB = 2 * TILE_B, OFF_WS = OFF_RPB + (64 + 4 * 15 * 32 + 64) * 4, LDS_BYTES = OFF_WS + 8 * 64 * 4;
#define KSWZ64(row, colB) ((row) * 128 + ((colB) ^ (((row) & 7) << 4)))
__device__ __forceinline__ void qkt64(f32x16& p0, f32x16& p1, const char* Ks, const bf16x8* qr, int r32, int hi) {
    p0 = f32x16{}; p1 = f32x16{};
#pragma unroll
    for (int d0 = 0; d0 < 4; ++d0) { const int cb = (d0 * 16 + hi * 8) * 2;
        bf16x8 b0 = *reinterpret_cast<const bf16x8*>(Ks + KSWZ64(r32, cb));
        bf16x8 b1 = *reinterpret_cast<const bf16x8*>(Ks + KSWZ64(32 + r32, cb));
        p0 = __builtin_amdgcn_mfma_f32_32x32x16_bf16(b0, qr[d0], p0, 0, 0, 0);
        p1 = __builtin_amdgcn_mfma_f32_32x32x16_bf16(b1, qr[d0], p1, 0, 0, 0); }
}
__device__ __forceinline__ void na_unit(const Params& p, int l, int qrow0, bool lat, int b, int gr0, int hp, char* lds, int tid) {
    asm volatile("" : "+v"(tid));
    const bf16* z = (const bf16*)(p.ws + WS_Z); bf16* abp = (bf16*)(p.ws + WS_ABP);
    const int wid = __builtin_amdgcn_readfirstlane(tid >> 6), lane = tid & 63, r32 = lane & 31, hi = lane >> 5, hl = wid >> 2, rsel = (wid >> 1) & 1, qh = wid & 1, hd = hp * 2 + hl;
    float* rpbs = (float*)(lds + OFF_RPB); float* ws = (float*)(lds + OFF_WS) + wid * 64; float* li_l = ws; float* al_l = ws + 32;
    const int gr = gr0 + rsel;
    int sr0 = gr0 - 4; sr0 = sr0 < 0 ? 0 : (sr0 > 120 ? 120 : sr0);
    int sr1 = gr0 - 3; sr1 = sr1 < 0 ? 0 : (sr1 > 120 ? 120 : sr1);
    const int srw = rsel ? sr1 : sr0;
    const int ntile = lat ? 12 + (sr1 != sr0 ? 1 : 0) : 4;
    const int cq = qh * 32 + r32; int sc = cq - 8; sc = sc < 0 ? 0 : (sc > 48 ? 48 : sc);
    __syncthreads();
    bf16x8 qr[4];
    const int srow = tid >> 4, sch = tid & 15, shd = sch >> 3, sc8 = sch & 7;
    bf16x8 skA[2], svA[2], skB[2], svB[2];
#define TROW(j) ((lat && (j) >= 4) ? (b * SEQ + (sr0 + (j) - 4) * GW) : (TL + b * CTX + (j) * 64))
#define NLOAD(j, SK, SV) do { const bf16* g = z + (size_t)(TROW(j) + srow) * ZW + Z_NA + 256 + hp * 128 + sch * 8; _Pragma("unroll") for (int i = 0; i < 2; ++i) { SK[i] = *reinterpret_cast<const bf16x8*>(g + (size_t)(32 * i) * ZW); SV[i] = *reinterpret_cast<const bf16x8*>(g + (size_t)(32 * i) * ZW + 256); } } while (0)
#define NWRITE(bu, SK, SV) do { char* kb = lds + (bu) * TILE_B + shd * 8192; char* vb_ = kb + 16384; _Pragma("unroll") for (int i = 0; i < 2; ++i) { const int row = srow + 32 * i; \
        *(bf16x8*)(kb + KSWZ64(row, sc8 * 16)) = SK[i]; *(bf16x8*)(vb_ + mla::v_st(row, sc8 * 8)) = SV[i]; } } while (0)
    float m_reg = -1e30f, l_reg = 0; f32x16 o0 = {}, o1 = {};
    constexpr float C = 0.125f * 1.4426950408889634f;
    NLOAD(0, skA, svA); if (2 < ntile) NLOAD(2, skB, svB);
    { const float* rpb = p.in[I_RPB] + (size_t)l * 4 * 15 * 31; for (int i = tid; i < 64 + 4 * 15 * 32 + 64; i += NT) { const int t_ = i - 64, c = t_ & 31; rpbs[i] = (t_ >= 0 && t_ < 4 * 15 * 32 && c < 31) ? rpb[(t_ >> 5) * 31 + c] : 0.f; } }
    { const bf16* Qw = z + (size_t)(qrow0 + rsel * 64 + cq) * ZW + Z_NA + hd * 64 + hi * 8;
#pragma unroll
      for (int d0 = 0; d0 < 4; ++d0) qr[d0] = *reinterpret_cast<const bf16x8*>(Qw + d0 * 16); }
    NWRITE(0, skA, svA); NLOAD(1, skA, svA); __syncthreads();
#define PK4(P, BASE, OUT) do { unsigned a0 = mla::cvtpk(P[BASE + 0], P[BASE + 1]), a1 = mla::cvtpk(P[BASE + 2], P[BASE + 3]);   \
    unsigned b0 = mla::cvtpk(P[BASE + 4], P[BASE + 5]), b1 = mla::cvtpk(P[BASE + 6], P[BASE + 7]);                              \
    auto r0 = __builtin_amdgcn_permlane32_swap(a0, b0, false, false); auto r1 = __builtin_amdgcn_permlane32_swap(a1, b1, false, false); \
    u32x4 w = {r0[0], r1[0], r0[1], r1[1]}; OUT = *reinterpret_cast<bf16x8*>(&w); } while (0)
#define NA_TILE(j, SK, SV) do { \
        const int krow = sr0 + (j) - 4;                                            \
        if (!(lat && (j) >= 4) || (krow >= srw && krow < srw + 8)) { \
        const char* Kt = lds + ((j) & 1) * TILE_B + hl * 8192; const int vb = (int)(uintptr_t)(lds + ((j) & 1) * TILE_B + 16384 + hl * 8192) + mla::v_rd_base(lane); \
        f32x16 p0, p1; qkt64(p0, p1, Kt, qr, r32, hi); \
        if (lat && (j) >= 4) { const float* brow = rpbs + 64 + (hd * 15 + (krow - gr + 7)) * 32 + (4 * hi - cq + 15); const int vb2 = 4 * hi - sc; \
_Pragma("unroll") \
            for (int r = 0; r < 16; ++r) { const int k0 = (r & 3) + 8 * (r >> 2); \
                const float b0 = brow[k0], b1 = brow[k0 + 32]; \
                p0[r] = ((unsigned)(vb2 + k0) < 16u) ? p0[r] + 8.f * b0 : -1e30f; p1[r] = ((unsigned)(vb2 + k0 + 32) < 16u) ? p1[r] + 8.f * b1 : -1e30f; } } \
        float pmax = p0[0]; \
_Pragma("unroll") \
        for (int r = 1; r < 16; ++r) pmax = fmaxf(pmax, p0[r]); \
_Pragma("unroll") \
        for (int r = 0; r < 16; ++r) pmax = fmaxf(pmax, p1[r]); \
        { auto rr = __builtin_amdgcn_permlane32_swap(__float_as_uint(pmax), __float_as_uint(pmax), false, false); pmax = fmaxf(__uint_as_float(rr[0]), __uint_as_float(rr[1])); } \
        const float mn = fmaxf(m_reg, pmax), alpha = __builtin_amdgcn_exp2f((m_reg - mn) * C); m_reg = mn; const float mnC = -mn * C; \
        float ps = 0.f; \
_Pragma("unroll") \
        for (int r = 0; r < 16; ++r) { p0[r] = __builtin_amdgcn_exp2f(fmaf(p0[r], C, mnC)); p1[r] = __builtin_amdgcn_exp2f(fmaf(p1[r], C, mnC)); ps += p0[r] + p1[r]; } \
        { auto rr = __builtin_amdgcn_permlane32_swap(__float_as_uint(ps), __float_as_uint(ps), false, false); ps = __uint_as_float(rr[0]) + __uint_as_float(rr[1]); } \
        l_reg = l_reg * alpha + ps; \
        if (hi == 0) al_l[r32] = alpha; asm volatile("s_waitcnt lgkmcnt(0)" ::: "memory"); \
_Pragma("unroll") \
        for (int r = 0; r < 16; ++r) { const float f = al_l[mla::crow(r, hi)]; o0[r] *= f; o1[r] *= f; } \
        mla::bf16x8 pa0, pa1, pa2, pa3; \
        PK4(p0, 0, pa0); PK4(p0, 8, pa1); PK4(p1, 0, pa2); PK4(p1, 8, pa3); \
        mla::pv_d0(o0, o1, vb, pa0, pa1, pa2, pa3); } \
        if ((j) + 1 < ntile) { NWRITE(((j) + 1) & 1, SK, SV); if ((j) + 3 < ntile) NLOAD((j) + 3, SK, SV); } \
        __syncthreads(); } while (0)
    for (int j = 0; j < ntile; j += 2) { NA_TILE(j, skA, svA); if (j + 1 < ntile) NA_TILE(j + 1, skB, svB); }
#undef NA_TILE
#undef PK4
    if (hi == 0) li_l[r32] = l_reg; asm volatile("s_waitcnt lgkmcnt(0)" ::: "memory");
#pragma unroll
    for (int r = 0; r < 16; ++r) { const float rl = __builtin_amdgcn_rcpf(li_l[mla::crow(r, hi)]); o0[r] *= rl; o1[r] *= rl; }
    mla::store_tile_rows(lds + wid * 4608, o0, o1, abp + (size_t)(qrow0 + rsel * 64 + qh * 32) * D + 512 + hd * 64, D, lane);
#undef TROW
#undef NLOAD
#undef NWRITE
}
#undef KSWZ64
}
__device__ __forceinline__ void ph_na_fast(const Params& p, int l, unsigned char* lds_) {
    const int tid = otid();
    for (int u = blockIdx.x; u < 256; u += gridDim.x) {
        const int v = (gridDim.x == 256) ? (u & 7) * 32 + (u >> 3) : u, hp = v & 1, rp = (v >> 1) & 63, b = v >> 7;
        na::na_unit(p, l, b * SEQ + rp * 2 * GW, true, b, rp * 2, hp, (char*)lds_, tid);
    }
    if (l == 0) {
        const int first = gridDim.x >= 24 ? 16 : 0;
        for (int c = (int)blockIdx.x - first; c >= 0 && c < 8; c += gridDim.x) { const int b = c >> 2; na::na_unit(p, l, TL + b * CTX + ((c >> 1) & 1) * 128, false, b, 0, c & 1, (char*)lds_, tid); }
    }
}
__device__ __forceinline__ void ph_pool_fast(const Params& p, int l, unsigned char* lds_) {
    const int tid = otid();
    using mla::bf16x8; using mla::f32x16;
    const bf16* z = (const bf16*)(p.ws + WS_Z); bf16* abp = (bf16*)(p.ws + WS_ABP); const bf16* wpt = wl_ptr(p, l, WL_POOL); const float* ps = p.in[I_PSCALE] + l * PW;
    const int lane = tid & 63, r32 = lane & 31, hi = lane >> 5;
    const int nrow = (l == DEPTH - 1) ? TL : T;
    for (int it = GWAVE; it < (nrow / 32) * 4; it += GNW) {
        const int g = it & 3, row0 = (it >> 2) * 32, w = 2 << g, row = row0 + r32;
        int base, n, t; if (row < TL) { base = row & ~8191; n = SEQ; t = row & 8191; } else { base = TL + ((row - TL) & ~255); n = CTX; t = (row - TL) & 255; }
        int lo = t - w / 2; lo = lo < 0 ? 0 : lo; int hi_ = t + w / 2; hi_ = hi_ > n ? n : hi_;
        const float invn = 1.f / (float)(hi_ - lo);
        f32x16 acc0 = {}, acc1 = {};
        float a8[4][8];
#pragma unroll
        for (int s4 = 0; s4 < 4; ++s4)
#pragma unroll
            for (int j = 0; j < 8; ++j) a8[s4][j] = 0.f;
        const bf16* zc = z + Z_POOL + g * 64 + 8 * hi;
        for (int i = 0; i < w; i += 2) {
            const int ta = t - w / 2 + i, tb = ta + 1;
            const float fa = (ta >= 0 && ta < n) ? 1.f : 0.f, fb = (tb >= 0 && tb < n) ? 1.f : 0.f;
            const int tac = ta < 0 ? 0 : (ta >= n ? n - 1 : ta), tbc = tb < 0 ? 0 : (tb >= n ? n - 1 : tb);
            uint4 va[4], vb[4];
#pragma unroll
            for (int s4 = 0; s4 < 4; ++s4) { va[s4] = *(const uint4*)(zc + (size_t)(base + tac) * ZW + 16 * s4); vb[s4] = *(const uint4*)(zc + (size_t)(base + tbc) * ZW + 16 * s4); }
#pragma unroll
            for (int s4 = 0; s4 < 4; ++s4) { const unsigned xa_[4] = {va[s4].x, va[s4].y, va[s4].z, va[s4].w}, xb_[4] = {vb[s4].x, vb[s4].y, vb[s4].z, vb[s4].w};
#pragma unroll
                for (int j = 0; j < 4; ++j) { a8[s4][2 * j] += fa * __uint_as_float(xa_[j] << 16) + fb * __uint_as_float(xb_[j] << 16); a8[s4][2 * j + 1] += fa * __uint_as_float(xa_[j] & 0xffff0000u) + fb * __uint_as_float(xb_[j] & 0xffff0000u); } }
        }
#pragma unroll
        for (int s4 = 0; s4 < 4; ++s4) {
            const uint4 ov = *(const uint4*)(zc + (size_t)row * ZW + 16 * s4); const unsigned oo[4] = {ov.x, ov.y, ov.z, ov.w};
            mla::u32x4 aw;
#pragma unroll
            for (int j = 0; j < 4; ++j) aw[j] = mla::cvtpk(a8[s4][2 * j] * invn - __uint_as_float(oo[j] << 16), a8[s4][2 * j + 1] * invn - __uint_as_float(oo[j] & 0xffff0000u));
            const bf16x8 af = *reinterpret_cast<bf16x8*>(&aw);
            const bf16x8 b0 = *reinterpret_cast<const bf16x8*>(wpt + (size_t)(g * 64 + r32) * 64 + 16 * s4 + 8 * hi), b1 = *reinterpret_cast<const bf16x8*>(wpt + (size_t)(g * 64 + 32 + r32) * 64 + 16 * s4 + 8 * hi);
            acc0 = __builtin_amdgcn_mfma_f32_32x32x16_bf16(af, b0, acc0, 0, 0, 0);
            acc1 = __builtin_amdgcn_mfma_f32_32x32x16_bf16(af, b1, acc1, 0, 0, 0);
        }
        const float s0 = ps[g * 64 + r32], s1 = ps[g * 64 + 32 + r32];
        acc0 = acc0 * s0; acc1 = acc1 * s1;
        mla::store_tile_rows((char*)lds_ + (tid >> 6) * 4608, acc0, acc1, abp + (size_t)row0 * D + 768 + g * 64, D, lane);
    }
}


#define XB_TMO      128
#define XB_XCNT(j)  (256  + 64 * (j))
#define XB_XSUB(j)  (1280 + 64 * (j))
#define XB_XGEN(j)  (2304 + 64 * (j))
#define XB_TOP      3328
#define XB_TOPGEN   3392
#define XCD_BAR_WORDS 3456
#define XB_SPIN_CAP (1u << 18)
__device__ __forceinline__ unsigned xb_ld(unsigned* p)              { return __hip_atomic_load(p, __ATOMIC_RELAXED, __HIP_MEMORY_SCOPE_AGENT); }
__device__ __forceinline__ unsigned xb_add(unsigned* p, unsigned v) { return __hip_atomic_fetch_add(p, v, __ATOMIC_RELAXED, __HIP_MEMORY_SCOPE_AGENT); }
__device__ __forceinline__ unsigned xb_xcc_id() { return (unsigned)__builtin_amdgcn_s_getreg((3 << 11) | 20) & 0xFu; }
#define XB_SPIN(cond, bar) do { unsigned _sp = 0; while (cond) { __builtin_amdgcn_s_sleep(1); \
    if ((++_sp & 255u) == 0u) { if (xb_ld(&(bar)[XB_TMO])) break; if (_sp > XB_SPIN_CAP) { atomicAdd(&(bar)[XB_TMO], 1u); break; } } } } while (0)
struct XcdBarrier { unsigned* bar; unsigned x; volatile LAS unsigned* st; };
__device__ __forceinline__ XcdBarrier xcd_barrier_post(unsigned* bar, volatile LAS unsigned* st) {
    XcdBarrier b; b.bar = bar; b.x = xb_xcc_id(); b.st = st;
    if (threadIdx.x == 0) (void)xb_add(&bar[XB_XCNT(b.x)], 1u);
    return b;
}
__device__ __forceinline__ void xcd_barrier_complete(unsigned* bar, unsigned x, unsigned& nloc, unsigned& nx) {
    const unsigned G = gridDim.x * gridDim.y * gridDim.z;
    unsigned sum, cnt, mine, sp = 0u;
    for (;;) {
        sum = 0u; cnt = 0u; mine = 0u;
#pragma unroll
        for (unsigned j = 0; j < 16; ++j) { const unsigned c = xb_ld(&bar[XB_XCNT(j)]); sum += c; cnt += (c > 0u) ? 1u : 0u; mine = (j == x) ? c : mine; }
        if (sum == G) break;
        __builtin_amdgcn_s_sleep(1);
        if ((++sp & 255u) == 0u) { if (xb_ld(&bar[XB_TMO])) break; if (sp > XB_SPIN_CAP) { atomicAdd(&bar[XB_TMO], 1u); break; } }
    }
    nloc = mine > 0u ? mine : 1u; nx = cnt > 0u ? cnt : 1u;
}
__device__ __forceinline__ void xcd_barrier(const XcdBarrier& b) {
    asm volatile("s_waitcnt vmcnt(0)" ::: "memory");
    __syncthreads();
    if (threadIdx.x == 0) {
        unsigned* bar = b.bar;
        __builtin_amdgcn_s_waitcnt(0);
        unsigned nloc = b.st[0], nx = b.st[1];
        if (nloc == 0u) { xcd_barrier_complete(bar, b.x, nloc, nx); b.st[0] = nloc; b.st[1] = nx; }
        const unsigned old = xb_add(&bar[XB_XSUB(b.x)], 1u);
        const unsigned gen = old / nloc;
        if (old + 1u == (gen + 1u) * nloc) {
            __builtin_amdgcn_fence(__ATOMIC_RELEASE, "agent");
            asm volatile("s_waitcnt vmcnt(0)" ::: "memory");
            const unsigned og = xb_add(&bar[XB_TOP], 1u);
            const unsigned tg = og / nx;
            if (og + 1u == (tg + 1u) * nx) xb_add(&bar[XB_TOPGEN], 1u);
            else XB_SPIN(xb_ld(&bar[XB_TOPGEN]) == tg, bar);
            __builtin_amdgcn_fence(__ATOMIC_ACQUIRE, "agent");
            xb_add(&bar[XB_XGEN(b.x)], 1u);
            asm volatile("s_waitcnt vmcnt(0)" ::: "memory");
        } else {
            XB_SPIN(xb_ld(&bar[XB_XGEN(b.x)]) == gen, bar);
            __builtin_amdgcn_fence(__ATOMIC_ACQUIRE, "agent");
            asm volatile("s_waitcnt vmcnt(0)" ::: "memory");
        }
    }
    __syncthreads();
}

#ifndef FAST_INPROJ
#define FAST_INPROJ 1
#endif
#ifndef FAST_MLAPROJ
#define FAST_MLAPROJ 1
#endif
#ifndef FAST_MERGE
#define FAST_MERGE 1
#endif
#ifndef FAST_OUTPROJ
#define FAST_OUTPROJ 1
#endif
#ifndef FAST_MOEUP
#define FAST_MOEUP 1
#endif
#ifndef FAST_MOEDOWN
#define FAST_MOEDOWN 1
#endif
#ifndef FAST_MLA
#define FAST_MLA 1
#endif
#ifndef MLA_V2
#define MLA_V2 1
#endif
#ifndef FAST_NA
#define FAST_NA 1
#endif
#ifndef FAST_POOL
#define FAST_POOL 1
#endif
#ifndef PROBE_PHASE
#define PROBE_PHASE -1
#endif
#ifndef PROBE_N
#define PROBE_N 1
#endif
constexpr int LDS_BYTES = 147456;
__global__ void __launch_bounds__(NT) mega(Params p) {
    extern __shared__ __attribute__((aligned(16))) unsigned char lds[];
    cg::grid_group grid = cg::this_grid();
    { volatile LAS unsigned* st = (volatile LAS unsigned*)((LAS unsigned char*)lds + LDS_BYTES - 16); if (threadIdx.x < 4) st[threadIdx.x] = 0u; }
    __syncthreads();
    const XcdBarrier xbar = xcd_barrier_post((unsigned*)(p.ws + WS_CTL), (volatile LAS unsigned*)((LAS unsigned char*)lds + LDS_BYTES - 16));
#define GSYNC() xcd_barrier(xbar)
#define REPS(k) (1 + ((PROBE_PHASE == (k)) ? PROBE_N : 0))
    for (int rep = 0; rep < REPS(0); ++rep) {
        ph_mod(p, lds);
        if (gridDim.x != 256) grid.sync(); else GSYNC();
        ph_h1(p, 0);
        ph_cvt(p, lds);
        GSYNC();
    }
    for (int rep = 0; rep < REPS(10) - 1; ++rep) { GSYNC(); GSYNC(); GSYNC(); GSYNC(); GSYNC(); GSYNC(); GSYNC(); GSYNC(); GSYNC(); GSYNC(); }
    for (int l = 0; l < DEPTH; ++l) {
        for (int rep = 0; rep < REPS(1); ++rep) { ph_inproj_fast(p, l, lds); GSYNC(); }
        for (int rep = 0; rep < REPS(2); ++rep) { ph_mlaproj_fast(p, l, lds); GSYNC(); }
        for (int rep = 0; rep < REPS(3); ++rep) {
            for (int r2 = 0; r2 < REPS(11); ++r2) ph_mla_fast(p, l, lds);
            for (int r2 = 0; r2 < REPS(12); ++r2) ph_na_fast(p, l, lds);
            for (int r2 = 0; r2 < REPS(13); ++r2) ph_pool_fast(p, l, lds);
            GSYNC();
        }
        for (int rep = 0; rep < REPS(4); ++rep) { ph_merge_fast(p, l, lds); GSYNC(); }
        ph_outproj_fast(p, l, lds);
        GSYNC();
        for (int rep = 0; rep < REPS(6); ++rep) { ph_h2router(p, l, lds); GSYNC(); }
        for (int rep = 0; rep < REPS(7); ++rep) { ph_topk(p, lds); GSYNC(); }
        for (int rep = 0; rep < REPS(8); ++rep) { ph_moeup_fast(p, l, lds); GSYNC(); }
        for (int rep = 0; rep < REPS(9); ++rep) { ph_moedown_fast(p, l, lds); GSYNC(); }
        ph_combine(p, l);
        GSYNC();
    }
}

extern "C" void kernel_launch(void* const* d_in, const int* in_sizes, int n_in, void* d_out, int out_size, void* d_ws, size_t ws_size, hipStream_t stream) {
    static int grid_blocks = 0;
    if (grid_blocks == 0) {
        if (n_in != 25 || ws_size < WS_END) { fprintf(stderr, "kernel_launch: n_in %d ws %zu (need %zu)\n", n_in, ws_size, (size_t)WS_END); grid_blocks = -1; return; }
        int dev = 0, cus = 0, per_cu = 0;
        (void)hipGetDevice(&dev);
        (void)hipDeviceGetAttribute(&cus, hipDeviceAttributeMultiprocessorCount, dev);
        if (hipFuncSetAttribute((const void*)mega, hipFuncAttributeMaxDynamicSharedMemorySize, LDS_BYTES) != hipSuccess) { fprintf(stderr, "kernel_launch: hipFuncSetAttribute failed\n"); grid_blocks = -1; return; }
        (void)hipOccupancyMaxActiveBlocksPerMultiprocessor(&per_cu, (const void*)mega, NT, LDS_BYTES);
        if (per_cu < 1) { fprintf(stderr, "kernel_launch: occupancy query says %d\n", per_cu); grid_blocks = -1; return; }
        grid_blocks = cus;
    }
    if (grid_blocks < 0) return;
    if (hipMemsetAsync((char*)d_ws + WS_CTL, 0, CTL_BYTES, stream) != hipSuccess) { fprintf(stderr, "kernel_launch: memset failed\n"); return; }
    Params p{};
    for (int i = 0; i < 25; ++i) p.in[i] = (const float*)d_in[i];
    p.out = (float*)d_out; p.ws = (unsigned char*)d_ws;
    void* args[] = {&p};
    hipError_t e = hipLaunchCooperativeKernel((const void*)mega, dim3(grid_blocks), dim3(NT), args, LDS_BYTES, stream);
    if (e != hipSuccess) fprintf(stderr, "cooperative launch failed: %s (grid %d)\n", hipGetErrorString(e), grid_blocks);
}
```

```cpp
#include <hip/hip_runtime.h>
#include <hip/hip_cooperative_groups.h>
#include <cstdio>
#include <cstdint>
namespace cg = cooperative_groups;
#ifndef MLA_ILV
#define MLA_ILV 1
#endif
#ifndef PG_ALIGN
#define PG_ALIGN 1
#endif
#ifndef PG_SP2
#define PG_SP2 1
#endif
#ifndef MLA_V2
#define MLA_V2 1
#endif

constexpr int D = 1024, NB = 2, SEQ = 8192, DEPTH = 2, GW = 64, CTX = 256;
constexpr int TL = NB * SEQ;
constexpr int T = TL + NB * CTX;
constexpr int QR = 384, KVR = 256, ROPE = 32, NAW = 256, PW = 256;
constexpr int DIN = 4768;
constexpr int ZW = 4864;
constexpr int Z_CQ = 0, Z_CKV = 384, Z_NA = 640, Z_POOL = 1408, Z_GATE = 1664, Z_KR = 4736;
constexpr int MH = 8, QKD = 96, VD = 64, QW = MH * QKD  , AW = MH * VD  , KVW = MH * 128  ;
constexpr int NKEY = CTX + SEQ;
constexpr int NE = 16, FF = 2048, CAPL = 1024, CAPC = 32;
constexpr int ER = 2304;
constexpr int ERV = 2112;
constexpr float EPS = 1e-6f;
constexpr int NT = 512;

constexpr size_t MiB = 1u << 20;
constexpr size_t WS_MOD = 0;
constexpr size_t WS_ROPE = 512 * 1024;
constexpr size_t WS_RS = 1 * MiB;
constexpr size_t WS_AFF = 2 * MiB;
constexpr size_t WS_SLOT = 4 * MiB;
constexpr size_t WS_GVX = 6 * MiB;
constexpr size_t WS_SEL = 6 * MiB + 512 * 1024;
constexpr size_t WS_CTL = 7 * MiB;
constexpr size_t CTL_BYTES = 65536;
constexpr size_t WS_H = 8 * MiB;
constexpr size_t WS_XA = 42 * MiB;
constexpr size_t WS_Z = 108 * MiB;
constexpr size_t WS_ACT = WS_Z;
constexpr size_t WS_Q = 265 * MiB;
constexpr size_t WS_KB = 290 * MiB;
constexpr size_t WS_VB = 315 * MiB;
constexpr size_t WS_ABP = 332 * MiB;
constexpr size_t WS_XS = 265 * MiB;
constexpr size_t WS_M = 366 * MiB;
constexpr size_t WS_TMP = 400 * MiB;
constexpr size_t WS_Y = 366 * MiB;
constexpr size_t WS_SLAB = 440 * MiB;
constexpr size_t WS_W = 466 * MiB;
constexpr size_t WS_END = 880 * MiB;

typedef unsigned short bf16;
__device__ __forceinline__ bf16 f2bf(float f) { unsigned u = __float_as_uint(f); u += 0x7fffu + ((u >> 16) & 1u); return (bf16)(u >> 16); }
__device__ __forceinline__ float bf2f(bf16 b) { return __uint_as_float(((unsigned)b) << 16); }
__device__ __forceinline__ unsigned cvtpk2(float lo, float hi) { unsigned r; asm volatile("v_cvt_pk_bf16_f32 %0, %1, %2" : "=v"(r) : "v"(lo), "v"(hi)); return r; }
__device__ __forceinline__ unsigned pk4_fp8(float a, float b, float c, float d) { int r = __builtin_amdgcn_cvt_pk_fp8_f32(a, b, 0, false); r = __builtin_amdgcn_cvt_pk_fp8_f32(c, d, r, true); return (unsigned)r; }
__device__ __forceinline__ float clamp_fp8(float x) { return __builtin_amdgcn_fmed3f(x, -448.f, 448.f); }
constexpr float F8_WSC = 32.f;
constexpr float F8_ASC = 4.f;
__device__ __forceinline__ float sigmoidf_(float x) { return 1.f / (1.f + __expf(-x)); }
__device__ __forceinline__ float siluf_(float x) { return x / (1.f + __expf(-x)); }
template <int CTRL> __device__ __forceinline__ float dppf(float v) { return __int_as_float(__builtin_amdgcn_update_dpp(0, __float_as_int(v), CTRL, 0xF, 0xF, false)); }
#define DPP_XOR1 0xB1
#define DPP_XOR2 0x4E
#define DPP_ROR8 0x128
#define DPP_HMIR 0x141
#define DPP_RMIR 0x140
__device__ __forceinline__ float xor4f(float v) {
    int t = __builtin_amdgcn_update_dpp(0, __float_as_int(v), 0x104, 0xF, 0x5, false); t = __builtin_amdgcn_update_dpp(t, __float_as_int(v), 0x114, 0xF, 0xA, false); return __int_as_float(t); }
__device__ __forceinline__ float swap16_sum(float a, float b) { auto r = __builtin_amdgcn_permlane16_swap(__float_as_uint(a), __float_as_uint(b), false, false); return __uint_as_float(r[0]) + __uint_as_float(r[1]); }
__device__ __forceinline__ float swap32_sum(float a, float b) { auto r = __builtin_amdgcn_permlane32_swap(__float_as_uint(a), __float_as_uint(b), false, false); return __uint_as_float(r[0]) + __uint_as_float(r[1]); }
__device__ __forceinline__ float swap16_max(float a) { auto r = __builtin_amdgcn_permlane16_swap(__float_as_uint(a), __float_as_uint(a), false, false); return fmaxf(__uint_as_float(r[0]), __uint_as_float(r[1])); }
__device__ __forceinline__ float swap32_max(float a) { auto r = __builtin_amdgcn_permlane32_swap(__float_as_uint(a), __float_as_uint(a), false, false); return fmaxf(__uint_as_float(r[0]), __uint_as_float(r[1])); }
__device__ __forceinline__ float wave_sum(float v) {
    v += dppf<DPP_XOR1>(v); v += dppf<DPP_XOR2>(v); v += dppf<DPP_HMIR>(v); v += dppf<DPP_RMIR>(v);
    v = swap16_sum(v, v); v = swap32_sum(v, v);
    return v;
}

struct Params {
    const float* in[25];
    float* out;
    unsigned char* ws;
};
enum { I_X = 0, I_C, I_CTX, I_CCTX, I_N1G, I_N2G, I_WADA, I_BADA, I_WIN, I_QNORM, I_KVNORM, I_WUQ, I_WUKV, I_RPB, I_WPOOL, I_PSCALE,
       I_WBRM, I_WBRN, I_WBRP, I_WOUT, I_WROUTER, I_WGATE, I_WUP, I_WDOWN, I_FINALG };

__device__ __forceinline__ int row_set(int r) { return r < TL ? (r >> 13) : 2 + ((r - TL) >> 8); }
__device__ __forceinline__ int row_modv(int r) { return r < TL ? (r >> 13) : 2; }
__device__ __forceinline__ int row_krow(int r) { return r < TL ? ((r >> 13) * NKEY + CTX + (r & 8191)) : (((r - TL) >> 8) * NKEY + ((r - TL) & 255)); }

__device__ __forceinline__ int otid() { int t = threadIdx.x; asm volatile("" : "+v"(t)); return t; }
__device__ __forceinline__ int oblk() { int b = blockIdx.x; asm volatile("" : "+s"(b)); return b; }
#define GTID ((long)blockIdx.x * NT + tid)
#define GTOT ((long)gridDim.x * NT)
#define GWAVE ((int)(blockIdx.x * (NT / 64) + (tid >> 6)))
#define GNW ((int)(gridDim.x * (NT / 64)))

__device__ __forceinline__ void ph_mod(const Params& p, unsigned char* lds_) {
    const int tid = otid();
    float* mod = (float*)(p.ws + WS_MOD);
    { float* sc = (float*)lds_;
      float* part = sc + 3 * D;
      const int lane = tid & 63, wid = tid >> 6;
      { float t_[6];
#pragma unroll
        for (int q = 0; q < 6; ++q) { const int i = tid + q * NT, v = i >> 10, k = i & 1023; t_[q] = v < 2 ? p.in[I_C][v * D + k] : p.in[I_CCTX][k]; }
        __builtin_amdgcn_sched_barrier(0);
#pragma unroll
        for (int q = 0; q < 6; ++q) sc[tid + q * NT] = siluf_(t_[q]); }
      __syncthreads();
      for (int task = blockIdx.x; task < 2 * 96; task += gridDim.x) {
          const int l = task / 96, col = (task % 96) * 64 + lane;
          const float* w = p.in[I_WADA] + (size_t)l * D * 6144 + (size_t)(wid * 128) * 6144 + col;
          float s0 = 0.f, s1 = 0.f, s2 = 0.f;
          for (int k0 = 0; k0 < 128; k0 += 64) { float wv[64];
#pragma unroll
              for (int i = 0; i < 64; ++i) wv[i] = w[(size_t)(k0 + i) * 6144];
              __builtin_amdgcn_sched_barrier(0);
#pragma unroll
              for (int i = 0; i < 64; ++i) { const int kk = wid * 128 + k0 + i; s0 += sc[kk] * wv[i]; s1 += sc[D + kk] * wv[i]; s2 += sc[2 * D + kk] * wv[i]; }
              __builtin_amdgcn_sched_barrier(0); }
          part[(wid * 3 + 0) * 64 + lane] = s0; part[(wid * 3 + 1) * 64 + lane] = s1; part[(wid * 3 + 2) * 64 + lane] = s2;
          __syncthreads();
          if (tid < 192) { const int v = tid >> 6; float a = p.in[I_BADA][l * 6144 + (task % 96) * 64 + lane];
#pragma unroll
              for (int w8 = 0; w8 < 8; ++w8) a += part[(w8 * 3 + v) * 64 + lane];
              mod[(size_t)(l * 3 + v) * 6144 + (task % 96) * 64 + lane] = a; }
          __syncthreads();
      } }
    float* rope = (float*)(p.ws + WS_ROPE);
    for (long o = GTID; o < (128 + 64) * 8; o += GTOT) {
        int i = (int)(o & 7), pos = (int)(o >> 3); if (pos >= 128) pos -= 128;
        const float inv[8] = {1.0f, 0.316227766f, 0.1f, 0.0316227766f, 0.01f, 0.00316227766f, 0.001f, 0.000316227766f};
        float invv = i == 0 ? inv[0] : i == 1 ? inv[1] : i == 2 ? inv[2] : i == 3 ? inv[3] : i == 4 ? inv[4] : i == 5 ? inv[5] : i == 6 ? inv[6] : inv[7];
        float angf = (float)pos * invv;
        double a = (double)angf;
        double n = rint(a * 0.15915494309189535);
        double r = a - n * 6.283185307179586476925;
        double q = r * 0.25, q2 = q * q;
        double sn = q * (1.0 + q2 * (-1.0 / 6 + q2 * (1.0 / 120 + q2 * (-1.0 / 5040 + q2 * (1.0 / 362880 + q2 * (-1.0 / 39916800 + q2 * (1.0 / 6227020800.0)))))));
        double cs = 1.0 + q2 * (-0.5 + q2 * (1.0 / 24 + q2 * (-1.0 / 720 + q2 * (1.0 / 40320 + q2 * (-1.0 / 3628800 + q2 * (1.0 / 479001600.0 + q2 * (-1.0 / 87178291200.0)))))));
        double s2 = 2 * sn * cs, c2 = 2 * cs * cs - 1;
        double s4 = 2 * s2 * c2, c4 = 2 * c2 * c2 - 1;
        rope[o * 2] = (float)c4; rope[o * 2 + 1] = (float)s4;
    }
}

__device__ __forceinline__ void load_row4(const float* xr, int lane, float4 (&x)[4]) {
#pragma unroll
    for (int j = 0; j < 4; ++j) x[j] = *(const float4*)(xr + 4 * lane + 256 * j);
}
__device__ __forceinline__ void modulate_vals(const float4 (&x)[4], const float* g, const float* sh, const float* sc, int lane, float (&v)[16]) {
    float ss = 0.f;
#pragma unroll
    for (int j = 0; j < 4; ++j) { const float4 t = x[j]; v[4 * j] = t.x; v[4 * j + 1] = t.y; v[4 * j + 2] = t.z; v[4 * j + 3] = t.w; ss += t.x * t.x + t.y * t.y + t.z * t.z + t.w * t.w; }
    ss = wave_sum(ss);
    const float rs = rsqrtf(ss * (1.f / D) + EPS);
#pragma unroll
    for (int j = 0; j < 4; ++j) {
        const float4 gg = *(const float4*)(g + 4 * lane + 256 * j), s1 = *(const float4*)(sc + 4 * lane + 256 * j), s0 = *(const float4*)(sh + 4 * lane + 256 * j);
        v[4 * j] = v[4 * j] * rs * gg.x * (1.f + s1.x) + s0.x; v[4 * j + 1] = v[4 * j + 1] * rs * gg.y * (1.f + s1.y) + s0.y;
        v[4 * j + 2] = v[4 * j + 2] * rs * gg.z * (1.f + s1.z) + s0.z; v[4 * j + 3] = v[4 * j + 3] * rs * gg.w * (1.f + s1.w) + s0.w;
    }
}
__device__ __forceinline__ void modulate_row(const float* xr, const float* g, const float* sh, const float* sc, int lane, float (&v)[16]) {
    float4 x[4]; load_row4(xr, lane, x); modulate_vals(x, g, sh, sc, lane, v);
}
__device__ __forceinline__ void store_row_bf16(bf16* orow, int lane, const float (&v)[16]) {
#pragma unroll
    for (int j = 0; j < 4; ++j) {
        uint2 w; w.x = cvtpk2(v[4 * j], v[4 * j + 1]); w.y = cvtpk2(v[4 * j + 2], v[4 * j + 3]);
        *(uint2*)(orow + 4 * lane + 256 * j) = w;
    }
}
__device__ __forceinline__ void store_row_fp8(unsigned char* orow, int lane, const float (&v)[16]) {
#pragma unroll
    for (int j = 0; j < 4; ++j) *(unsigned*)(orow + 4 * lane + 256 * j) = pk4_fp8(clamp_fp8(v[4 * j]), clamp_fp8(v[4 * j + 1]), clamp_fp8(v[4 * j + 2]), clamp_fp8(v[4 * j + 3]));
}
__device__ __forceinline__ const float* src_row(const Params& p, int l, int r) {
    if (l == 0) return r < TL ? p.in[I_X] + (size_t)r * D : p.in[I_CTX] + (size_t)(r - TL) * D;
    return (const float*)(p.ws + WS_XA) + (size_t)r * D;
}
__device__ __forceinline__ unsigned char* h8_ptr(const Params& p);
__device__ __forceinline__ void ph_h1(const Params& p, int l) {
    const int tid = otid();
    const float* mod = (const float*)(p.ws + WS_MOD) + (size_t)l * 3 * 6144;
    bf16* h = (bf16*)(p.ws + WS_H); unsigned char* h8 = h8_ptr(p);
    const int lane = tid & 63;
    float4 cur[4]; if (GWAVE < T) load_row4(src_row(p, l, GWAVE), lane, cur);
    for (int r = GWAVE; r < T; r += GNW) {
        float4 nx[4]; const int rn = r + GNW; if (rn < T) load_row4(src_row(p, l, rn), lane, nx);
        const float* mv = mod + row_modv(r) * 6144;
        float v[16]; modulate_vals(cur, p.in[I_N1G] + l * D, mv + 0 * D, mv + 1 * D, lane, v);
#pragma unroll
        for (int j = 0; j < 4; ++j) cur[j] = nx[j];
        store_row_bf16(h + (size_t)r * D, lane, v);
        store_row_fp8(h8 + (size_t)r * D, lane, v);
    }
}
__device__ __forceinline__ void rope_pair(const float* rope, int r, int d  , float xa, float xb  , float& out) {
    const int t = r & 8191, pos = (d < 16) ? (t >> 6) : 128 + (t & 63);
    const float cs = rope[(pos * 8 + (d & 7)) * 2], sn = rope[(pos * 8 + (d & 7)) * 2 + 1];
    out = (d & 8) ? (xa * cs + xb * sn) : (xa * cs - xb * sn);
}
__device__ __forceinline__ unsigned char* g8_ptr(const Params& p);
__device__ __forceinline__ void load_rowd(const bf16* dr, int lane, uint2 (&d)[4]) {
#pragma unroll
    for (int j = 0; j < 4; ++j) d[j] = *(const uint2*)(dr + 4 * lane + 256 * j);
}
__device__ __forceinline__ void add_rowd(float4 (&x)[4], const uint2 (&d)[4]) {
#pragma unroll
    for (int j = 0; j < 4; ++j) { x[j].x += __uint_as_float(d[j].x << 16); x[j].y += __uint_as_float(d[j].x & 0xffff0000u); x[j].z += __uint_as_float(d[j].y << 16); x[j].w += __uint_as_float(d[j].y & 0xffff0000u); }
}
__device__ __forceinline__ void ph_h2router(const Params& p, int l, unsigned char* lds_) {
    const int tid = otid();
    const float* mod = (const float*)(p.ws + WS_MOD) + (size_t)l * 3 * 6144; const float* xa = (const float*)(p.ws + WS_XA);
    bf16* h = (bf16*)(p.ws + WS_H); float* aff = (float*)(p.ws + WS_AFF); const float* wr = p.in[I_WROUTER] + (size_t)l * D * NE;
    const int lane = tid & 63;
    float* wrT = (float*)lds_;
    const bf16* dl = (const bf16*)g8_ptr(p);
    float4 cur[4]; uint2 dcur[4];
    if (GWAVE < T) { load_row4(src_row(p, l, GWAVE), lane, cur); load_rowd(dl + (size_t)GWAVE * D, lane, dcur); }
    __syncthreads();
    { float4 t_[8];
#pragma unroll
      for (int q = 0; q < 8; ++q) t_[q] = *(const float4*)(wr + 4 * (tid + q * NT));
      __builtin_amdgcn_sched_barrier(0);
#pragma unroll
      for (int q = 0; q < 8; ++q) { const int i = 4 * (tid + q * NT), k = i >> 4, e = i & 15; wrT[e * D + k] = t_[q].x; wrT[(e + 1) * D + k] = t_[q].y; wrT[(e + 2) * D + k] = t_[q].z; wrT[(e + 3) * D + k] = t_[q].w; } }
    __syncthreads();
    for (int r = GWAVE; r < T; r += GNW) {
        float4 nx[4]; uint2 dnx[4]; const int rn = r + GNW; if (rn < T) { load_row4(src_row(p, l, rn), lane, nx); load_rowd(dl + (size_t)rn * D, lane, dnx); }
        const float* mv = mod + row_modv(r) * 6144;
        if (r >= TL && l != DEPTH - 1 && gridDim.x == 256) {
            const float* cin = p.in[I_CTX] + (size_t)(r - TL) * D; const float* sp = (const float*)(p.ws + WS_SLAB) + (size_t)(r - TL) * D; float* xw = (float*)(p.ws + WS_XA) + (size_t)r * D;
#pragma unroll
            for (int j = 0; j < 4; ++j) { const int c = 4 * lane + 256 * j; const float4 a = *(const float4*)(cin + c), g = *(const float4*)(mv + 2 * D + c);
                const float4 s0 = *(const float4*)(sp + c), s1 = *(const float4*)(sp + (size_t)512 * D + c), s2 = *(const float4*)(sp + (size_t)2 * 512 * D + c), s3 = *(const float4*)(sp + (size_t)3 * 512 * D + c);
                float4 t; t.x = a.x + g.x * (((s0.x + s1.x) + s2.x) + s3.x); t.y = a.y + g.y * (((s0.y + s1.y) + s2.y) + s3.y); t.z = a.z + g.z * (((s0.z + s1.z) + s2.z) + s3.z); t.w = a.w + g.w * (((s0.w + s1.w) + s2.w) + s3.w);
                cur[j] = t; *(float4*)(xw + c) = t; } }
        else add_rowd(cur, dcur);
        float v[16]; modulate_vals(cur, p.in[I_N2G] + l * D, mv + 3 * D, mv + 4 * D, lane, v);
#pragma unroll
        for (int j = 0; j < 4; ++j) { cur[j] = nx[j]; dcur[j] = dnx[j]; }
        store_row_fp8((unsigned char*)h + (size_t)r * D, lane, v);
        float lg[NE];
        const __attribute__((address_space(3))) float* wl = (const __attribute__((address_space(3))) float*)(__attribute__((address_space(3))) unsigned char*)lds_ + 4 * lane; asm volatile("" : "+v"(wl));
#pragma unroll
        for (int eg = 0; eg < NE; eg += 4) {
            typedef float fv4_ __attribute__((ext_vector_type(4)));
            fv4_ w4[4][4];
#pragma unroll
            for (int e4 = 0; e4 < 4; ++e4)
#pragma unroll
                for (int j = 0; j < 4; ++j) w4[e4][j] = *(const __attribute__((address_space(3))) fv4_*)(wl + (eg + e4) * D + 256 * j);
            __builtin_amdgcn_sched_barrier(0);
#pragma unroll
            for (int e4 = 0; e4 < 4; ++e4) { float a = 0.f;
#pragma unroll
                for (int j = 0; j < 4; ++j) a = fmaf(v[4 * j + 3], w4[e4][j].w, fmaf(v[4 * j + 2], w4[e4][j].z, fmaf(v[4 * j + 1], w4[e4][j].y, fmaf(v[4 * j], w4[e4][j].x, a))));
                lg[eg + e4] = a; }
            __builtin_amdgcn_sched_barrier(0);
        }
        float r1[8], r2[4], r3[2], r4;
#pragma unroll
        for (int i = 0; i < 8; ++i) r1[i] = swap32_sum(lg[i], lg[8 + i]);
#pragma unroll
        for (int i = 0; i < 4; ++i) r2[i] = swap16_sum(r1[i], r1[4 + i]);
        { const bool up = lane & 8;
#pragma unroll
          for (int i = 0; i < 2; ++i) { const float a = r2[i] + dppf<DPP_ROR8>(r2[i]), b = r2[2 + i] + dppf<DPP_ROR8>(r2[2 + i]); r3[i] = up ? b : a; } }
        { const bool up = lane & 4; const float snd = up ? r3[0] : r3[1]; const float keep = up ? r3[1] : r3[0]; r4 = keep + xor4f(snd); }
        r4 += dppf<DPP_XOR2>(r4); r4 += dppf<DPP_XOR1>(r4);
        float mx = r4;
        mx = fmaxf(mx, dppf<DPP_HMIR>(mx)); mx = fmaxf(mx, dppf<DPP_RMIR>(mx)); mx = swap16_max(mx); mx = swap32_max(mx);
        const float ex = expf(r4 - mx); float sum = ex;
        sum += dppf<DPP_HMIR>(sum); sum += dppf<DPP_RMIR>(sum); sum = swap16_sum(sum, sum); sum = swap32_sum(sum, sum);
        if ((lane & 3) == 0) aff[(size_t)r * NE + (lane >> 2)] = ex / sum;
    }
}
__device__ __forceinline__ void ph_topk(const Params& p, unsigned char* lds) {
    const int tid = otid();
    const float* aff = (const float*)(p.ws + WS_AFF); int* slotm = (int*)(p.ws + WS_SLOT); float* gvx = (float*)(p.ws + WS_GVX); int* selrow = (int*)(p.ws + WS_SEL);
    const int lane = tid & 63, wid = tid >> 6;
    unsigned* keys = (unsigned*)lds;
    unsigned* hist = keys + 8192;
    unsigned* wtot = hist + 256;
    unsigned* ctl = wtot + 8;
    for (int prob = blockIdx.x; prob < 64; prob += gridDim.x) {
        const int s = prob >> 4, e = prob & 15;
        const int N = s < 2 ? SEQ : CTX, cap = N / 8, row0 = s < 2 ? s * SEQ : TL + (s - 2) * CTX, base = s < 2 ? s * CAPL : 2 * CAPL + (s - 2) * CAPC;
        __syncthreads();
        for (int i0 = 0; i0 < N; i0 += 16 * NT) {
            float t_[16];
#pragma unroll
            for (int q = 0; q < 16; ++q) { const int i = i0 + tid + q * NT; t_[q] = i < N ? aff[(size_t)(row0 + i) * NE + e] : 0.f; }
            __builtin_amdgcn_sched_barrier(0);
#pragma unroll
            for (int q = 0; q < 16; ++q) { const int i = i0 + tid + q * NT; if (i < N) keys[i] = __float_as_uint(t_[q]) << 2; }
        }
        unsigned prefix = 0, mask = 0; int remaining = cap;
        for (int pass = 3; pass >= 0; --pass) {
            const int shift = pass * 8;
            if (tid < 256) hist[tid] = 0;
            __syncthreads();
            for (int i = tid; i < N; i += NT) { const unsigned k = keys[i]; if ((k & mask) == prefix) atomicAdd(&hist[(k >> shift) & 255], 1u); }
            __syncthreads();
            if (wid == 0) {
                const unsigned h0 = hist[4 * lane], h1 = hist[4 * lane + 1], h2 = hist[4 * lane + 2], h3 = hist[4 * lane + 3], tot = h0 + h1 + h2 + h3;
                unsigned inc = tot;
#pragma unroll
                for (int o = 1; o < 64; o <<= 1) { const unsigned t = __shfl_down(inc, o); if (lane + o < 64) inc += t; }
                const unsigned above = inc - tot, rem = (unsigned)remaining;
                if (above < rem && rem <= above + tot) { unsigned r = rem - above; int b;
                    if (h3 >= r) b = 3; else { r -= h3; if (h2 >= r) b = 2; else { r -= h2; if (h1 >= r) b = 1; else { r -= h1; b = 0; } } }
                    ctl[0] = (unsigned)(4 * lane + b); ctl[1] = r; }
            }
            __syncthreads();
            prefix |= ctl[0] << shift; mask |= 255u << shift; remaining = (int)ctl[1];
            __syncthreads();
        }
        const unsigned Tk = prefix; const int need = remaining;
        const int CH = N >= NT ? N / NT : 1; const bool act = tid * CH < N;
        unsigned cnt = 0;
        if (act) for (int j = 0; j < CH; ++j) { const unsigned k = keys[tid * CH + j]; cnt += (k > Tk ? 1u : 0u) + (k == Tk ? 65536u : 0u); }
        unsigned inc = cnt;
#pragma unroll
        for (int o = 1; o < 64; o <<= 1) { const unsigned t = __shfl_up(inc, o); if (lane >= o) inc += t; }
        if (lane == 63) wtot[wid] = inc;
        __syncthreads();
        unsigned off = 0; for (int w = 0; w < wid; ++w) off += wtot[w];
        unsigned excl = off + inc - cnt;
        int gtb = (int)(excl & 0xffffu), eqb = (int)(excl >> 16);
        if (act) for (int j = 0; j < CH; ++j) {
            const int i = tid * CH + j; const unsigned k = keys[i]; const int row = row0 + i; int er = -1;
            if (k > Tk) { er = base + gtb + (eqb < need ? eqb : need); ++gtb; }
            else if (k == Tk) { if (eqb < need) er = base + gtb + eqb; ++eqb; }
            slotm[(size_t)row * NE + e] = er;
            if (er >= 0) { gvx[e * ER + er] = __uint_as_float(k >> 2); selrow[e * ER + er] = row; }
        }
    }
    if (blockIdx.x >= 64 || gridDim.x <= 64) {
        const int nb = gridDim.x > 64 ? gridDim.x - 64 : gridDim.x, bi = gridDim.x > 64 ? blockIdx.x - 64 : blockIdx.x;
        for (int i = bi * NT + tid; i < NE * (ER - ERV); i += nb * NT) { const int e = i / (ER - ERV), r = ERV + i % (ER - ERV); gvx[e * ER + r] = 0.f; selrow[e * ER + r] = 0; }
    }
}
__device__ __forceinline__ void ph_combine(const Params& p, int l) {
    const int tid = otid();
    const float* modl = (const float*)(p.ws + WS_MOD) + (size_t)l * 3 * 6144;
    float* xa = (float*)(p.ws + WS_XA); const int* slotm = (const int*)(p.ws + WS_SLOT); const bf16* y = (const bf16*)(p.ws + WS_Y); bf16* h = (bf16*)(p.ws + WS_H);
    const int lane = tid & 63; const bool last = (l == DEPTH - 1); const int RN = last ? TL : T;
    float4 cur[4]; int scur = -1;
    const bf16* dl = (const bf16*)g8_ptr(p); uint2 dcur[4];
#define CB_SLAB(rr) ((rr) >= TL && !last && gridDim.x == 256)
#define CB_ROW(rr) (CB_SLAB(rr) ? (const float*)(xa + (size_t)(rr) * D) : src_row(p, l, (rr)))
    if (GWAVE < RN) { load_row4(CB_ROW(GWAVE), lane, cur); load_rowd(dl + (size_t)GWAVE * D, lane, dcur); scur = slotm[(size_t)GWAVE * NE + (lane & 15)]; }
    for (int r = GWAVE; r < RN; r += GNW) {
        float4 nx[4]; int snx = -1; const int rn = r + GNW;
        uint2 dnx[4];
        if (rn < RN) { load_row4(CB_ROW(rn), lane, nx); load_rowd(dl + (size_t)rn * D, lane, dnx); snx = slotm[(size_t)rn * NE + (lane & 15)]; }
        if (!CB_SLAB(r)) add_rowd(cur, dcur);
        const float* g2 = modl + row_modv(r) * 6144 + 5 * D;
        float acc[16];
#pragma unroll
        for (int j = 0; j < 16; ++j) acc[j] = 0.f;
        const bool fromslab = (r >= TL) && !last && gridDim.x == 256;
#pragma unroll
        for (int e = 0; e < NE; ++e) {
            const int er = __builtin_amdgcn_readlane(scur, e);
            if (er >= 0) {
                if (fromslab) {
#pragma unroll
                    for (int q = 0; q < 4; ++q) { const float* sp = (const float*)(p.ws + WS_SLAB) + (((size_t)q * NE + e) * 64 + (er - 2 * CAPL)) * D;
#pragma unroll
                        for (int j = 0; j < 4; ++j) { const float4 w = *(const float4*)(sp + 4 * lane + 256 * j); acc[4 * j] += w.x; acc[4 * j + 1] += w.y; acc[4 * j + 2] += w.z; acc[4 * j + 3] += w.w; } }
                } else { const bf16* yr = y + ((size_t)e * ER + er) * D;
#pragma unroll
                for (int j = 0; j < 4; ++j) { const uint2 w = *(const uint2*)(yr + 4 * lane + 256 * j);
                    acc[4 * j] += bf2f((bf16)(w.x & 0xffff)); acc[4 * j + 1] += bf2f((bf16)(w.x >> 16)); acc[4 * j + 2] += bf2f((bf16)(w.y & 0xffff)); acc[4 * j + 3] += bf2f((bf16)(w.y >> 16)); } }
            }
        }
        float v[16]; float ss = 0.f;
        float* xr = xa + (size_t)r * D;
#pragma unroll
        for (int j = 0; j < 4; ++j) { const float4 t = cur[j], g = *(const float4*)(g2 + 4 * lane + 256 * j);
            v[4 * j] = t.x + g.x * acc[4 * j]; v[4 * j + 1] = t.y + g.y * acc[4 * j + 1]; v[4 * j + 2] = t.z + g.z * acc[4 * j + 2]; v[4 * j + 3] = t.w + g.w * acc[4 * j + 3];
            ss += v[4 * j] * v[4 * j] + v[4 * j + 1] * v[4 * j + 1] + v[4 * j + 2] * v[4 * j + 2] + v[4 * j + 3] * v[4 * j + 3]; }
        ss = wave_sum(ss); const float rs = rsqrtf(ss * (1.f / D) + EPS);
        if (last) {
            const float* fg = p.in[I_FINALG]; float* orow = p.out + (size_t)r * D;
#pragma unroll
            for (int j = 0; j < 4; ++j) { const float4 g = *(const float4*)(fg + 4 * lane + 256 * j);
                *(float4*)(orow + 4 * lane + 256 * j) = make_float4(v[4 * j] * rs * g.x, v[4 * j + 1] * rs * g.y, v[4 * j + 2] * rs * g.z, v[4 * j + 3] * rs * g.w); }
        } else {
#pragma unroll
            for (int j = 0; j < 4; ++j) *(float4*)(xr + 4 * lane + 256 * j) = make_float4(v[4 * j], v[4 * j + 1], v[4 * j + 2], v[4 * j + 3]);
            const float* mn = (const float*)(p.ws + WS_MOD) + (size_t)(l + 1) * 3 * 6144 + row_modv(r) * 6144; const float* g1n = p.in[I_N1G] + (l + 1) * D;
            float hv[16];
#pragma unroll
            for (int j = 0; j < 4; ++j) { const float4 gg = *(const float4*)(g1n + 4 * lane + 256 * j), s1 = *(const float4*)(mn + D + 4 * lane + 256 * j), s0 = *(const float4*)(mn + 4 * lane + 256 * j);
                hv[4 * j] = v[4 * j] * rs * gg.x * (1.f + s1.x) + s0.x; hv[4 * j + 1] = v[4 * j + 1] * rs * gg.y * (1.f + s1.y) + s0.y;
                hv[4 * j + 2] = v[4 * j + 2] * rs * gg.z * (1.f + s1.z) + s0.z; hv[4 * j + 3] = v[4 * j + 3] * rs * gg.w * (1.f + s1.w) + s0.w; }
            store_row_bf16(h + (size_t)r * D, lane, hv);
            store_row_fp8(h8_ptr(p) + (size_t)r * D, lane, hv);
        }
#pragma unroll
        for (int j = 0; j < 4; ++j) { cur[j] = nx[j]; dcur[j] = dnx[j]; }
        scur = snx;
    }
#undef CB_SLAB
#undef CB_ROW
}


constexpr size_t WL_IN = 0;
constexpr size_t WL_UQ = WL_IN + (size_t)ZW * D;
constexpr size_t WL_UKV = WL_UQ + (size_t)QW * QR;
constexpr size_t WL_CAT = WL_UKV + (size_t)KVW * KVR;
constexpr size_t WL_OUT = WL_CAT + (size_t)D * D;
constexpr size_t WL_POOL = WL_OUT + (size_t)D * D;
constexpr size_t WL_GU = WL_POOL + 4 * 64 * 64;
constexpr size_t WL_DN = WL_GU + (size_t)NE * 2 * FF * D;
constexpr size_t WL_SIZE = WL_DN + (size_t)NE * D * FF;
static_assert(WS_W + 2 * WL_SIZE * 2 <= WS_END, "weight region");
__device__ __forceinline__ bf16* wl_ptr(const Params& p, int l, size_t off) { return (bf16*)(p.ws + WS_W) + (size_t)l * WL_SIZE + off; }
__device__ __forceinline__ unsigned char* g8_ptr(const Params& p) { return (unsigned char*)wl_ptr(p, 0, WL_GU) + (size_t)NE * 2 * FF * D; }
__device__ __forceinline__ unsigned char* h8_ptr(const Params& p) { return (unsigned char*)wl_ptr(p, 1, WL_GU) + (size_t)NE * 2 * FF * D; }
constexpr int ZG0 = 1792, ZG1 = 4608;
__device__ __forceinline__ unsigned char* win8_ptr(const Params& p, int l) { return g8_ptr(p) + (size_t)50 * MiB + (size_t)l * (ZG1 - ZG0) * D; }
__device__ __forceinline__ unsigned pk4_lowbytes(float a, float b, float c, float d) {
    const unsigned p01 = __builtin_amdgcn_perm(__float_as_uint(b), __float_as_uint(a), 0x0c0c0400u), p23 = __builtin_amdgcn_perm(__float_as_uint(d), __float_as_uint(c), 0x0c0c0400u); return p01 | (p23 << 16); }

#define LAS __attribute__((address_space(3)))
struct CvtJob { const float* W; int K, N; bf16* dst; int dstride, koff, map; const float* kscale; int fp8; };
constexpr int CVT_PER_LAYER = 1200 + 72 + 64 + 128 + 64 + 64 + 256 + 4 + 3 * 8192;
__device__ __forceinline__ void cvt_decode(const Params& p, int it, CvtJob& j, int& item) {
    const int l = it / CVT_PER_LAYER; int r = it % CVT_PER_LAYER;
    j.koff = 0; j.map = 0; j.kscale = nullptr; j.fp8 = 0;
    if (r < 1200) { j.W = p.in[I_WIN] + (size_t)l * D * DIN; j.K = D; j.N = DIN; j.dst = wl_ptr(p, l, WL_IN); j.dstride = D; j.map = 1; item = r; return; } r -= 1200;
    if (r < 72) { j.W = p.in[I_WUQ] + (size_t)l * QR * QW; j.K = QR; j.N = QW; j.dst = wl_ptr(p, l, WL_UQ); j.dstride = QR; j.kscale = p.in[I_QNORM] + l * QR; item = r; return; } r -= 72;
    if (r < 64) { j.W = p.in[I_WUKV] + (size_t)l * KVR * KVW; j.K = KVR; j.N = KVW; j.dst = wl_ptr(p, l, WL_UKV); j.dstride = KVR; j.kscale = p.in[I_KVNORM] + l * KVR; item = r; return; } r -= 64;
    if (r < 128) { j.W = p.in[I_WBRM] + (size_t)l * 512 * D; j.K = 512; j.N = D; j.dst = wl_ptr(p, l, WL_CAT); j.dstride = D; item = r; return; } r -= 128;
    if (r < 64) { j.W = p.in[I_WBRN] + (size_t)l * 256 * D; j.K = 256; j.N = D; j.dst = wl_ptr(p, l, WL_CAT); j.dstride = D; j.koff = 512; item = r; return; } r -= 64;
    if (r < 64) { j.W = p.in[I_WBRP] + (size_t)l * 256 * D; j.K = 256; j.N = D; j.dst = wl_ptr(p, l, WL_CAT); j.dstride = D; j.koff = 768; item = r; return; } r -= 64;
    if (r < 256) { j.W = p.in[I_WOUT] + (size_t)l * D * D; j.K = D; j.N = D; j.dst = wl_ptr(p, l, WL_OUT); j.dstride = D; item = r; return; } r -= 256;
    if (r < 4) { j.W = p.in[I_WPOOL] + ((size_t)l * 4 + r) * 4096; j.K = 64; j.N = 64; j.dst = wl_ptr(p, l, WL_POOL) + r * 4096; j.dstride = 64; item = 0; return; } r -= 4;
    const int which = r / 8192, rr = r % 8192, e = rr / 512; item = rr % 512;
    j.fp8 = 1;
    if (which == 0) { j.W = p.in[I_WGATE] + (size_t)(l * NE + e) * D * FF; j.K = D; j.N = FF; j.dst = (bf16*)((unsigned char*)wl_ptr(p, l, WL_GU) + (size_t)e * 2 * FF * D); j.dstride = D; j.map = 2; }
    else if (which == 1) { j.W = p.in[I_WUP] + (size_t)(l * NE + e) * D * FF; j.K = D; j.N = FF; j.dst = (bf16*)((unsigned char*)wl_ptr(p, l, WL_GU) + (size_t)e * 2 * FF * D); j.dstride = D; j.map = 3; }
    else { j.W = p.in[I_WDOWN] + (size_t)(l * NE + e) * FF * D; j.K = FF; j.N = D; j.dst = (bf16*)((unsigned char*)wl_ptr(p, l, WL_DN) + (size_t)e * D * FF); j.dstride = FF; }
}
__device__ __forceinline__ int cvt_maprow(int map, int n) {
    if (map == 0) return n;
    if (map == 1) { if (n < 640) return n; if (n < 672) return Z_KR + (n - 640); if (n < 1440) return Z_NA + (n - 672); if (n < 1696) return Z_POOL + (n - 1440); return Z_GATE + (n - 1696); }
    return 256 * (n >> 7) + (n & 127) + (map == 3 ? 128 : 0);
}
__device__ __forceinline__ void ph_cvt(const Params& p, unsigned char* lds_, int it_lo, int it_hi, int wave0, int nwaves) {
    const int tid = otid();
    LAS float* scr = (LAS float*)lds_ + (tid >> 6) * (64 * 65);
    const int lane = tid & 63;
    const bool moe_in_attn = MLA_V2 && gridDim.x == 256;
    for (int it = it_lo + wave0; it < it_hi; it += nwaves) {
        if (moe_in_attn && (it % CVT_PER_LAYER) >= CVT_PER_LAYER - 3 * 8192) continue;
        CvtJob j; int item; cvt_decode(p, it, j, item);
        const int nblk = (j.N + 63) / 64, kb = item / nblk, nb = item % nblk, k0 = kb * 64, n0 = nb * 64;
        const int rr = lane >> 4, c4 = lane & 15;
        const bool nv = n0 + 4 * c4 < j.N;
        const float* src = j.W + (size_t)(k0 + rr) * j.N + n0 + 4 * c4;
#pragma unroll
        for (int i = 0; i < 16; ++i) { float4 v = nv ? *(const float4*)(src + (size_t)(4 * i) * j.N) : make_float4(0.f, 0.f, 0.f, 0.f);
            if (j.kscale) { const float ks = j.kscale[k0 + 4 * i + rr]; v.x *= ks; v.y *= ks; v.z *= ks; v.w *= ks; }
            LAS float* d = scr + (4 * i + rr) * 65 + 4 * c4; d[0] = v.x; d[1] = v.y; d[2] = v.z; d[3] = v.w; }
        asm volatile("s_waitcnt lgkmcnt(0)" ::: "memory");
        const int c = lane & 7;
#pragma unroll
        for (int jj = 0; jj < 8; ++jj) {
            const int n = (lane >> 3) + 8 * jj; const LAS float* sp = scr + (8 * c) * 65 + n;
            uint4 o; o.x = (unsigned)f2bf(sp[0]) | ((unsigned)f2bf(sp[65]) << 16); o.y = (unsigned)f2bf(sp[2 * 65]) | ((unsigned)f2bf(sp[3 * 65]) << 16);
            o.z = (unsigned)f2bf(sp[4 * 65]) | ((unsigned)f2bf(sp[5 * 65]) << 16); o.w = (unsigned)f2bf(sp[6 * 65]) | ((unsigned)f2bf(sp[7 * 65]) << 16);
            if (j.fp8) { uint2 o8; o8.x = pk4_fp8(sp[0] * F8_WSC, sp[65] * F8_WSC, sp[2 * 65] * F8_WSC, sp[3 * 65] * F8_WSC); o8.y = pk4_fp8(sp[4 * 65] * F8_WSC, sp[5 * 65] * F8_WSC, sp[6 * 65] * F8_WSC, sp[7 * 65] * F8_WSC);
                if (n0 + n < j.N) *(uint2*)((unsigned char*)j.dst + (size_t)cvt_maprow(j.map, n0 + n) * j.dstride + j.koff + k0 + 8 * c) = o8; }
            else if (n0 + n < j.N) { const int zr = cvt_maprow(j.map, n0 + n); *(uint4*)(j.dst + (size_t)zr * j.dstride + j.koff + k0 + 8 * c) = o;
                if (j.map == 1 && zr >= ZG0 && zr < ZG1) { uint2 o8; o8.x = pk4_fp8(sp[0] * F8_WSC, sp[65] * F8_WSC, sp[2 * 65] * F8_WSC, sp[3 * 65] * F8_WSC); o8.y = pk4_fp8(sp[4 * 65] * F8_WSC, sp[5 * 65] * F8_WSC, sp[6 * 65] * F8_WSC, sp[7 * 65] * F8_WSC);
                    *(uint2*)(win8_ptr(p, it / CVT_PER_LAYER) + (size_t)(zr - ZG0) * D + k0 + 8 * c) = o8; } }
        }
        asm volatile("s_waitcnt lgkmcnt(0)" ::: "memory");
    }
}

namespace pg {
typedef short bf16x8 __attribute__((ext_vector_type(8)));
typedef float f32x4 __attribute__((ext_vector_type(4)));
typedef unsigned u32x4 __attribute__((ext_vector_type(4)));
constexpr int BM = 256, BK = 64, HALF = 128, HTB = HALF * BK * 2, STAGE_BYTES = 8 * HTB, NXCD = 8;
__host__ __device__ __forceinline__ int lds_byte(int r, int c) { const int st = (r >> 4) * 2 + (c >> 5), rr = r & 15, cc = c & 31, ob = rr * 64 + cc * 2; return st * 1024 + (ob ^ (((ob >> 9) & 1) << 5)); }
__host__ __device__ __forceinline__ void stage_rc(int b, int& R, int& C) { const int st = b / 1024, sb = b % 1024, swz = sb ^ (((sb >> 9) & 1) << 5); R = (st >> 1) * 16 + swz / 64; C = (st & 1) * 32 + (swz % 64) / 2; }
__host__ __device__ __forceinline__ int perm32(int rho) { const int n = rho >> 4, i = rho & 15; return 8 * (i >> 2) + 4 * n + (i & 3); }
__device__ __forceinline__ unsigned cvt_pk_bf16(float lo, float hi) { unsigned r; asm volatile("v_cvt_pk_bf16_f32 %0, %1, %2" : "=v"(r) : "v"(lo), "v"(hi)); return r; }

typedef int i32x4 __attribute__((ext_vector_type(4)));
typedef int i32x8 __attribute__((ext_vector_type(8)));
__device__ __forceinline__ i32x8 cat8(bf16x8 a, bf16x8 b) { const i32x4 x = __builtin_bit_cast(i32x4, a), y = __builtin_bit_cast(i32x4, b); return __builtin_shufflevector(x, y, 0, 1, 2, 3, 4, 5, 6, 7); }
struct GUnit { const char* A; const char* B; unsigned lda, ldb; int nt, pm, pn, aux, ord; };

struct GridOrder {
    int nM, nN, G, c, WGM;
    __device__ __forceinline__ bool tile(int i, int& pm, int& pn) const { return tileL((long)i * G + c, pm, pn); }
    __device__ __forceinline__ bool tileL(const long L, int& pm, int& pn) const {
        const int nwg = nM * nN; if (L >= nwg) return false;
        int wgid = (int)L; { const int q = nwg / NXCD, r = nwg % NXCD, xcd = wgid % NXCD, off = wgid / NXCD; wgid = (xcd < r ? xcd * (q + 1) : r * (q + 1) + (xcd - r) * q) + off; }
        const int nig = WGM * nN, gid = wgid / nig, fm = gid * WGM, gsz = (nM - fm) < WGM ? (nM - fm) : WGM;
        pm = fm + ((wgid % nig) % gsz); pn = (wgid % nig) / gsz; return true;
    }
};

template <class Epi, class Sched>
__device__ __forceinline__ void gemm_phase(LAS unsigned char* lds, const Sched& S, const Epi& E) {
    const int tid = otid(), wid = __builtin_amdgcn_readfirstlane(tid >> 6), lane = tid & 63, wr = wid >> 2, wc = wid & 3, fr = lane & 15, fq = lane >> 4;
    int R_, C_; stage_rc(tid * 16, R_, C_); const int Rb_ = Epi::PERM ? ((R_ & ~31) + perm32(R_ & 31)) : R_;
    const unsigned ldsw = (unsigned)wid * 1024u;
    const int aoff = lds_byte(wr * 64 + fr, fq * 8), boff = lds_byte(wc * 32 + fr, fq * 8);
    const size_t kstep = (size_t)(BK * 2);
#define PG_SA(b, h) (((b) * 2 + (h)) * HTB)
#define PG_SB(b, h) ((4 + (b) * 2 + (h)) * HTB)
#define PG_STAGE(bufoff, gbase, voff, q64) do { \
        __builtin_amdgcn_global_load_lds((const unsigned*)((const char*)(gbase) + (voff)), (LAS unsigned*)(lds + (bufoff) + ldsw), 16, 0, 0); \
        __builtin_amdgcn_global_load_lds((const unsigned*)((const char*)(gbase) + (q64) + (voff)), (LAS unsigned*)(lds + (bufoff) + ldsw + 8192), 16, 0, 0); } while (0)
#define PG_STAGE_A(bufoff, kbase, hh, VV, QQ, GG) do { if constexpr (Sched::GATHER) { \
        __builtin_amdgcn_global_load_lds((const unsigned*)((const char*)(kbase) + (GG)[hh][0]), (LAS unsigned*)(lds + (bufoff) + ldsw), 16, 0, 0); \
        __builtin_amdgcn_global_load_lds((const unsigned*)((const char*)(kbase) + (GG)[hh][1]), (LAS unsigned*)(lds + (bufoff) + ldsw + 8192), 16, 0, 0); } \
        else { PG_STAGE(bufoff, (const char*)(kbase) + (hh) * 2 * (QQ), VV, QQ); } } while (0)
#define PG_LDGATHER(GG, U) do { if constexpr (Sched::GATHER) { _Pragma("unroll") for (int hh = 0; hh < 2; ++hh) _Pragma("unroll") for (int ii = 0; ii < 2; ++ii) \
        (GG)[hh][ii] = (unsigned)S.seltab[(U).ord * 256 + hh * 128 + R_ + 64 * ii] * (U).lda + (unsigned)C_ * 2u; } } while (0)
#define PG_LDA(dst, b, h) do { _Pragma("unroll") for (int m = 0; m < 4; ++m) _Pragma("unroll") for (int k = 0; k < 2; ++k) dst[m][k] = *(const LAS bf16x8*)(lds + PG_SA(b, h) + aoff + m * 2048 + k * 1024); } while (0)
#define PG_LDB(dst, b, h) do { _Pragma("unroll") for (int n = 0; n < 2; ++n) _Pragma("unroll") for (int k = 0; k < 2; ++k) dst[n][k] = *(const LAS bf16x8*)(lds + PG_SB(b, h) + boff + n * 2048 + k * 1024); } while (0)
#define PG_MMA(ai, bj, At, Bt) do { __builtin_amdgcn_s_setprio(1); _Pragma("unroll") for (int m = 0; m < 4; ++m) _Pragma("unroll") for (int n = 0; n < 2; ++n) { \
        if constexpr (Sched::FP8) asm volatile("v_mfma_f32_16x16x128_f8f6f4 %0, %1, %2, %0" : "+v"(acc[ai][bj][m][n]) : "v"(cat8(Bt[n][0], Bt[n][1])), "v"(cat8(At[m][0], At[m][1])));   \
        else { _Pragma("unroll") for (int k = 0; k < 2; ++k) acc[ai][bj][m][n] = __builtin_amdgcn_mfma_f32_16x16x32_bf16(Bt[n][k], At[m][k], acc[ai][bj][m][n], 0, 0, 0); } } __builtin_amdgcn_s_setprio(0); } while (0)
#define PG_WAIT_V(n) asm volatile("s_waitcnt vmcnt(" #n ")" ::: "memory")
#define PG_WAIT_L(n) asm volatile("s_waitcnt lgkmcnt(" #n ")" ::: "memory")
#define PG_BAR __builtin_amdgcn_s_barrier()
#define PG_SCHED __builtin_amdgcn_sched_barrier(0)
    GUnit cur, nxt; int ui = 0;
    if (!S.next(0, cur)) return;
    f32x4 acc[2][2][4][2];
#pragma unroll
    for (int a = 0; a < 2; ++a)
#pragma unroll
        for (int b = 0; b < 2; ++b)
#pragma unroll
            for (int m = 0; m < 4; ++m)
#pragma unroll
                for (int n = 0; n < 2; ++n) acc[a][b][m][n] = (f32x4){0.f, 0.f, 0.f, 0.f};
    bf16x8 At[4][2], B0[2][2], B1[2][2];
    const char* cA = cur.A; const char* cB = cur.B;
    unsigned vA = (unsigned)R_ * cur.lda + (unsigned)C_ * 2u, vB = (unsigned)Rb_ * cur.ldb + (unsigned)C_ * 2u;
    size_t qA = (size_t)64 * cur.lda, qB = (size_t)64 * cur.ldb, hA = 2 * qA, hB = 2 * qB;
    unsigned gA[2][2] = {{0u, 0u}, {0u, 0u}}, ngA[2][2] = {{0u, 0u}, {0u, 0u}}; PG_LDGATHER(gA, cur);
#if PG_SP2
    PG_STAGE(PG_SB(0, 0), cB, vB, qB); PG_STAGE(PG_SB(0, 1), cB + hB, vB, qB); PG_STAGE_A(PG_SA(0, 0), cA, 0, vA, qA, gA); PG_STAGE_A(PG_SA(0, 1), cA, 1, vA, qA, gA);
    if (wr == 1) PG_BAR;
    PG_WAIT_V(2); PG_BAR;
    PG_STAGE(PG_SB(1, 0), cB + kstep, vB, qB); PG_STAGE_A(PG_SA(1, 0), cA + kstep, 0, vA, qA, gA); PG_STAGE(PG_SB(1, 1), cB + hB + kstep, vB, qB);
    PG_WAIT_V(6); PG_BAR;
#else
    PG_STAGE(PG_SB(0, 0), cB, vB, qB); PG_STAGE_A(PG_SA(0, 0), cA, 0, vA, qA, gA); PG_STAGE(PG_SB(0, 1), cB + hB, vB, qB); PG_STAGE_A(PG_SA(0, 1), cA, 1, vA, qA, gA);
    if (wr == 1) PG_BAR;
    PG_WAIT_V(4); PG_BAR;
    PG_STAGE(PG_SB(1, 0), cB + kstep, vB, qB); PG_STAGE_A(PG_SA(1, 0), cA + kstep, 0, vA, qA, gA); PG_STAGE(PG_SB(1, 1), cB + hB + kstep, vB, qB);
    PG_WAIT_V(6); PG_BAR;
#endif
    for (;;) {
        const bool has_next = S.next(ui + 1, nxt);
        const char* nA = has_next ? nxt.A : cA; const char* nB = has_next ? nxt.B : cB;
        const unsigned nvA = has_next ? (unsigned)R_ * nxt.lda + (unsigned)C_ * 2u : vA, nvB = has_next ? (unsigned)Rb_ * nxt.ldb + (unsigned)C_ * 2u : vB;
        const size_t nqA = has_next ? (size_t)64 * nxt.lda : qA, nqB = has_next ? (size_t)64 * nxt.ldb : qB;
        if (has_next) PG_LDGATHER(ngA, nxt);
        const int nt = cur.nt;
        for (int t = 0; t < nt; t += 2) {
            if constexpr (Epi::SEG) E.seg(acc, cur, t, wr, wc, fr, fq);
            const bool last = (t == nt - 2);
            const char* a1 = cA + (size_t)(t + 1) * kstep;
            const char* a2 = last ? nA : cA + (size_t)(t + 2) * kstep; const char* b2 = last ? nB : cB + (size_t)(t + 2) * kstep;
            const char* a3 = a2 + kstep; const char* b3 = b2 + kstep;
            unsigned gA2[2][2];
#pragma unroll
            for (int hh = 0; hh < 2; ++hh)
#pragma unroll
                for (int ii = 0; ii < 2; ++ii) gA2[hh][ii] = (last && has_next) ? ngA[hh][ii] : gA[hh][ii];
            const unsigned vA2 = last ? nvA : vA, vB2 = last ? nvB : vB; const size_t qA2 = last ? nqA : qA, qB2 = last ? nqB : qB, hA2 = 2 * qA2, hB2 = 2 * qB2;
#if PG_SP2
            PG_LDB(B0, 0, 0); PG_LDB(B1, 0, 1); PG_SCHED; PG_LDA(At, 0, 0); PG_STAGE_A(PG_SA(1, 1), a1, 1, vA, qA, gA);
            PG_WAIT_V(8); PG_WAIT_L(0); PG_BAR; PG_MMA(0, 0, At, B0); PG_MMA(0, 1, At, B1); PG_BAR; PG_SCHED;
            PG_LDA(At, 0, 1); PG_STAGE(PG_SB(0, 0), b2, vB2, qB2); PG_STAGE(PG_SB(0, 1), b2 + hB2, vB2, qB2); PG_STAGE_A(PG_SA(0, 0), a2, 0, vA2, qA2, gA2);
            PG_WAIT_V(8); PG_WAIT_L(0); PG_BAR; PG_MMA(1, 0, At, B0); PG_MMA(1, 1, At, B1); PG_BAR; PG_SCHED;
            PG_LDB(B0, 1, 0); PG_LDB(B1, 1, 1); PG_SCHED; PG_LDA(At, 1, 0); PG_STAGE_A(PG_SA(0, 1), a2, 1, vA2, qA2, gA2);
            PG_WAIT_V(8); PG_WAIT_L(0); PG_BAR; PG_MMA(0, 0, At, B0); PG_MMA(0, 1, At, B1); PG_BAR; PG_SCHED;
            PG_LDA(At, 1, 1); PG_STAGE(PG_SB(1, 0), b3, vB2, qB2); PG_STAGE(PG_SB(1, 1), b3 + hB2, vB2, qB2); PG_STAGE_A(PG_SA(1, 0), a3, 0, vA2, qA2, gA2);
            PG_WAIT_V(8); PG_WAIT_L(0); PG_BAR; PG_MMA(1, 0, At, B0); PG_MMA(1, 1, At, B1); PG_BAR; PG_SCHED;
#else
            PG_LDB(B0, 0, 0); PG_SCHED; PG_LDA(At, 0, 0); PG_STAGE_A(PG_SA(1, 1), a1, 1, vA, qA, gA);
            PG_WAIT_L(8); PG_BAR; PG_WAIT_L(0); PG_MMA(0, 0, At, B0); PG_BAR; PG_SCHED;
            PG_LDB(B1, 0, 1); PG_STAGE(PG_SB(0, 0), b2, vB2, qB2);
            PG_BAR; PG_WAIT_L(0); PG_MMA(0, 1, At, B1); PG_BAR;
            PG_LDA(At, 0, 1); PG_STAGE_A(PG_SA(0, 0), a2, 0, vA2, qA2, gA2);
            PG_BAR; PG_WAIT_L(0); PG_MMA(1, 0, At, B0); PG_BAR; PG_SCHED;
            PG_STAGE(PG_SB(0, 1), b2 + hB2, vB2, qB2);
            PG_WAIT_V(6); PG_BAR; PG_MMA(1, 1, At, B1); PG_BAR;
            PG_LDB(B0, 1, 0); PG_SCHED; PG_LDA(At, 1, 0); PG_STAGE_A(PG_SA(0, 1), a2, 1, vA2, qA2, gA2);
            PG_WAIT_L(8); PG_BAR; PG_WAIT_L(0); PG_MMA(0, 0, At, B0); PG_BAR; PG_SCHED;
            PG_LDB(B1, 1, 1); PG_STAGE(PG_SB(1, 0), b3, vB2, qB2);
            PG_BAR; PG_WAIT_L(0); PG_MMA(0, 1, At, B1); PG_BAR;
            PG_LDA(At, 1, 1); PG_STAGE_A(PG_SA(1, 0), a3, 0, vA2, qA2, gA2);
            PG_BAR; PG_WAIT_L(0); PG_MMA(1, 0, At, B0); PG_BAR; PG_SCHED;
            PG_STAGE(PG_SB(1, 1), b3 + hB2, vB2, qB2);
            PG_WAIT_V(6); PG_BAR; PG_MMA(1, 1, At, B1); PG_BAR;
#endif
        }
#if PG_ALIGN
        if (wr == 0) PG_BAR;
#endif
        if constexpr (Sched::FP8) asm volatile("s_nop 15\n\ts_nop 7" ::: "memory");
        E(acc, cur, wr, wc, fr, fq);
        if (!has_next) break;
#pragma unroll
        for (int a = 0; a < 2; ++a)
#pragma unroll
            for (int b = 0; b < 2; ++b)
#pragma unroll
                for (int m = 0; m < 4; ++m)
#pragma unroll
                    for (int n = 0; n < 2; ++n) acc[a][b][m][n] = (f32x4){0.f, 0.f, 0.f, 0.f};
#pragma unroll
        for (int hh = 0; hh < 2; ++hh)
#pragma unroll
            for (int ii = 0; ii < 2; ++ii) gA[hh][ii] = ngA[hh][ii];
        cur = nxt; cA = nA; cB = nB; vA = nvA; vB = nvB; qA = nqA; qB = nqB; hA = 2 * qA; hB = 2 * qB; ++ui;
#if PG_ALIGN
        if (wr == 1) PG_BAR;
#endif
    }
    PG_WAIT_V(0);
#if !PG_ALIGN
    if (wr == 0) PG_BAR;
#endif
    PG_BAR;
#undef PG_SA
#undef PG_SB
#undef PG_STAGE
#undef PG_STAGE_A
#undef PG_LDGATHER
#undef PG_LDA
#undef PG_LDB
#undef PG_MMA
#undef PG_WAIT_V
#undef PG_WAIT_L
#undef PG_BAR
#undef PG_SCHED
}
typedef f32x4 Acc[2][2][4][2];
__device__ __forceinline__ u32x4 pack8(const f32x4 a, const f32x4 b) { u32x4 w; w.x = cvt_pk_bf16(a[0], a[1]); w.y = cvt_pk_bf16(a[2], a[3]); w.z = cvt_pk_bf16(b[0], b[1]); w.w = cvt_pk_bf16(b[2], b[3]); return w; }
__device__ __forceinline__ float fsig(float x) { return __builtin_amdgcn_rcpf(1.f + __expf(-x)); }
__device__ __forceinline__ float sig_u8f(float x, float c1) { return fmaf(__builtin_amdgcn_rcpf(1.f + __builtin_amdgcn_exp2f(x * c1)), 255.f, 8388608.f); }

struct SchedSimple {
    static constexpr bool GATHER = false, FP8 = false; GridOrder o; const char* A; const char* B; unsigned lda, ldb; int nt;
    __device__ __forceinline__ bool next(int i, GUnit& u) const { int pm, pn; if (!o.tile(i, pm, pn)) return false; u.A = A + (size_t)pm * 256 * lda; u.B = B + (size_t)pn * 256 * ldb; u.lda = lda; u.ldb = ldb; u.nt = nt; u.pm = pm; u.pn = pn; u.aux = 0; u.ord = i; return true; }
};
struct EpiInproj { static constexpr bool PERM = true, SEG = false; bf16* z; unsigned char* g8;
    __device__ __forceinline__ void operator()(const Acc& acc, const GUnit& u, int wr, int wc, int fr, int fq) const {
        asm volatile("" : "+v"(fr), "+v"(fq));
        const int row0 = u.pm * BM + wr * 64 + fr;
#pragma unroll
        for (int bj = 0; bj < 2; ++bj) { const int colb = u.pn * BM + bj * HALF; const bool sig = colb >= Z_GATE && colb < Z_KR; const int col0 = colb + wc * 32 + 8 * fq;
#pragma unroll
            for (int ai = 0; ai < 2; ++ai)
#pragma unroll
                for (int m = 0; m < 4; ++m) { f32x4 v0 = acc[ai][bj][m][0], v1 = acc[ai][bj][m][1];
                    if (sig) {
#pragma unroll
                        for (int j = 0; j < 4; ++j) { v0[j] = sig_u8f(v0[j], -1.4426950408889634f); v1[j] = sig_u8f(v1[j], -1.4426950408889634f); }
                        uint2 w; w.x = pk4_lowbytes(v0[0], v0[1], v0[2], v0[3]); w.y = pk4_lowbytes(v1[0], v1[1], v1[2], v1[3]);
                        *(uint2*)(g8 + (size_t)(row0 + ai * HALF + m * 16) * 3072 + (col0 - Z_GATE)) = w; }
                    else *(u32x4*)(z + (size_t)(row0 + ai * HALF + m * 16) * ZW + col0) = pack8(v0, v1); } }
    }
};
struct SchedInA { static constexpr bool GATHER = false, FP8 = false; GridOrder o; const char* A; const char* B; unsigned lda, ldb; int nt;
    __device__ __forceinline__ bool next(int i, GUnit& u) const { int pm, pq; if (!o.tile(i, pm, pq)) return false; const int pn = pq < 7 ? pq : 18; u.A = A + (size_t)pm * 256 * lda; u.B = B + (size_t)pn * 256 * ldb; u.lda = lda; u.ldb = ldb; u.nt = nt; u.pm = pm; u.pn = pn; u.aux = 0; u.ord = i; return true; }
};
struct SchedInB { static constexpr bool GATHER = false, FP8 = true; GridOrder o; const char* A; const char* B; unsigned lda, ldb; int nt;
    __device__ __forceinline__ bool next(int i, GUnit& u) const { int pm, pq; long L = (long)i * o.G + o.c;
        if (o.G == 256) { if (i == 1) { if (o.c < 16) return false; L = 240 + o.c; } else if (i == 2) { if (o.c < 24) return false; L = 472 + o.c; } else if (i > 2) return false; }
        if (!o.tileL(L, pm, pq)) return false; u.A = A + (size_t)pm * 256 * lda; u.B = B + (size_t)pq * 256 * ldb; u.lda = lda; u.ldb = ldb; u.nt = nt; u.pm = pm; u.pn = 7 + pq; u.aux = 0; u.ord = i; return true; }
};
struct EpiInprojG { static constexpr bool PERM = true, SEG = false; unsigned char* g8;
    __device__ __forceinline__ void operator()(const Acc& acc, const GUnit& u, int wr, int wc, int fr, int fq) const {
        asm volatile("" : "+v"(fr), "+v"(fq));
        const int row0 = u.pm * BM + wr * 64 + fr;
#pragma unroll
        for (int bj = 0; bj < 2; ++bj) { const int col0 = u.pn * BM + bj * HALF + wc * 32 + 8 * fq - Z_GATE;
#pragma unroll
            for (int ai = 0; ai < 2; ++ai)
#pragma unroll
                for (int m = 0; m < 4; ++m) { f32x4 v0 = acc[ai][bj][m][0], v1 = acc[ai][bj][m][1];
#pragma unroll
                    for (int j = 0; j < 4; ++j) { v0[j] = sig_u8f(v0[j], -1.4426950408889634f / F8_WSC); v1[j] = sig_u8f(v1[j], -1.4426950408889634f / F8_WSC); }
                    uint2 w; w.x = pk4_lowbytes(v0[0], v0[1], v0[2], v0[3]); w.y = pk4_lowbytes(v1[0], v1[1], v1[2], v1[3]);
                    *(uint2*)(g8 + (size_t)(row0 + ai * HALF + m * 16) * 3072 + col0) = w; } }
    }
};
struct SchedMla { static constexpr bool GATHER = false, FP8 = false; int G, c; const char* z; const char* wq; const char* wkv;
    __device__ __forceinline__ bool next(int i, GUnit& u) const {
        const int L = i * G + c; constexpr int NKV = 66 * 4, NQ = 66 * 3; if (L >= NKV + NQ) return false;
        u.ord = i; u.lda = ZW * 2;
        if (L < NKV) { u.pm = L >> 2; u.pn = L & 3; u.aux = 1; u.A = z + (size_t)u.pm * 256 * ZW * 2 + Z_CKV * 2; u.B = wkv + (size_t)u.pn * 256 * KVR * 2; u.ldb = KVR * 2; u.nt = KVR / 64; }
        else { const int q = L - NKV; u.pm = q / 3; u.pn = q % 3; u.aux = 0; u.A = z + (size_t)u.pm * 256 * ZW * 2 + Z_CQ * 2; u.B = wq + (size_t)u.pn * 256 * QR * 2; u.ldb = QR * 2; u.nt = QR / 64; }
        return true; }
};
struct EpiMla { static constexpr bool PERM = true, SEG = false; bf16* q; bf16* Kb; bf16* Vb; const float* rope; const LAS float* rstab;
    __device__ __forceinline__ void operator()(const Acc& acc, const GUnit& u, int wr, int wc, int fr, int fq) const {
        asm volatile("" : "+v"(fr), "+v"(fq));
        const LAS float* rs = rstab + u.ord * 256;
        if (u.aux == 0) {
#pragma unroll
            for (int bj = 0; bj < 2; ++bj) { const int cb = u.pn * BM + bj * HALF + wc * 32; const bool isrope = (cb % QKD) == 64 && u.pm < 64; const int col0 = cb + 8 * fq;
                if (isrope) {
                    const float sgn = (fq & 1) ? 1.f : -1.f; const bool odd = fq & 1;
#pragma unroll
                    for (int am = 0; am < 4; ++am) { const int ai = am >> 1, m0 = (am & 1) * 2;
                        f32x4 tt[4][4];
#pragma unroll
                        for (int m = m0; m < m0 + 2; ++m) { const int row = u.pm * BM + ai * HALF + wr * 64 + m * 16 + fr, t = row & 8191, pos = fq < 2 ? (t >> 6) : 128 + (t & 63); const f32x4* rp = (const f32x4*)(rope + pos * 16);
                            tt[m][0] = rp[0]; tt[m][1] = rp[1]; tt[m][2] = rp[2]; tt[m][3] = rp[3]; }
                        __builtin_amdgcn_sched_barrier(0);
#pragma unroll
                        for (int m = m0; m < m0 + 2; ++m) { const int rl = ai * HALF + wr * 64 + m * 16 + fr, row = u.pm * BM + rl; const float sc = rs[rl] * 0.14724444896f;
                            f32x4 v0 = acc[ai][bj][m][0] * sc, v1 = acc[ai][bj][m][1] * sc, p0, p1;
#pragma unroll
                            for (int j = 0; j < 4; ++j) { auto r0 = __builtin_amdgcn_permlane16_swap(__float_as_uint(v0[j]), __float_as_uint(v0[j]), false, false); auto r1 = __builtin_amdgcn_permlane16_swap(__float_as_uint(v1[j]), __float_as_uint(v1[j]), false, false);
                                p0[j] = __uint_as_float(odd ? r0[0] : r0[1]) * sgn; p1[j] = __uint_as_float(odd ? r1[0] : r1[1]) * sgn; }
                            const f32x4 t0 = tt[m][0], t1 = tt[m][1], t2 = tt[m][2], t3 = tt[m][3];
                            v0[0] = v0[0] * t0[0] + p0[0] * t0[1]; v0[1] = v0[1] * t0[2] + p0[1] * t0[3]; v0[2] = v0[2] * t1[0] + p0[2] * t1[1]; v0[3] = v0[3] * t1[2] + p0[3] * t1[3];
                            v1[0] = v1[0] * t2[0] + p1[0] * t2[1]; v1[1] = v1[1] * t2[2] + p1[1] * t2[3]; v1[2] = v1[2] * t3[0] + p1[2] * t3[1]; v1[3] = v1[3] * t3[2] + p1[3] * t3[3];
                            *(u32x4*)(q + (size_t)row * QW + col0) = pack8(v0, v1); asm volatile("" ::: "memory"); }
                        __builtin_amdgcn_sched_barrier(0); }
                } else {
#pragma unroll
                for (int ai = 0; ai < 2; ++ai)
#pragma unroll
                    for (int m = 0; m < 4; ++m) { const int rl = ai * HALF + wr * 64 + m * 16 + fr, row = u.pm * BM + rl; const float sc = rs[rl] * 0.14724444896f;
                        const f32x4 v0 = acc[ai][bj][m][0] * sc, v1 = acc[ai][bj][m][1] * sc;
                        *(u32x4*)(q + (size_t)row * QW + col0) = pack8(v0, v1); asm volatile("" ::: "memory"); } } }
        } else {
#pragma unroll
            for (int bj = 0; bj < 2; ++bj) { const int head = 2 * u.pn + bj;
#pragma unroll
                for (int ai = 0; ai < 2; ++ai)
#pragma unroll
                    for (int m = 0; m < 4; ++m) { const int rl = ai * HALF + wr * 64 + m * 16 + fr, row = u.pm * BM + rl; const float sc = rs[rl]; const size_t kr = (size_t)row_krow(row);
                        const u32x4 w = pack8(acc[ai][bj][m][0] * sc, acc[ai][bj][m][1] * sc);
                        if (wc < 2) *(u32x4*)(Kb + kr * QW + head * QKD + wc * 32 + 8 * fq) = w; else *(u32x4*)(Vb + kr * AW + head * VD + (wc - 2) * 32 + 8 * fq) = w; asm volatile("" ::: "memory"); } }
        }
    }
};
struct EpiMerge { static constexpr bool PERM = true, SEG = true; const unsigned char* g8; bf16* mo;
    __device__ __forceinline__ f32x4 b4(const unsigned w) const { return (f32x4){(float)(w & 0xffu), (float)((w >> 8) & 0xffu), (float)((w >> 16) & 0xffu), (float)(w >> 24)}; }
    __device__ __forceinline__ void seg(Acc& acc, const GUnit& u, int t, int wr, int wc, int fr, int fq) const {
        if (t != 8 && t != 12) return;
        asm volatile("" : "+v"(fr), "+v"(fq));
        const int br = (t == 8) ? 0 : 1; const int row0 = u.pm * BM + wr * 64 + fr;
#pragma unroll
        for (int bj = 0; bj < 2; ++bj) { const int col0 = u.pn * BM + bj * HALF + wc * 32 + 8 * fq;
#pragma unroll
            for (int ai = 0; ai < 2; ++ai) {
                uint2 ga[4], gb[4];
#pragma unroll
                for (int m = 0; m < 4; ++m) { const unsigned char* zp = g8 + (size_t)(row0 + ai * HALF + m * 16) * 3072 + br * D + col0; ga[m] = *(const uint2*)zp; gb[m] = *(const uint2*)(zp + D); }
#pragma unroll
                for (int m = 0; m < 4; ++m) { const f32x4 a0 = b4(ga[m].x), a1 = b4(ga[m].y), b0 = b4(gb[m].x), b1 = b4(gb[m].y);
#pragma unroll
                    for (int j = 0; j < 4; ++j) { acc[ai][bj][m][0][j] *= a0[j] * __builtin_amdgcn_rcpf(fmaxf(b0[j], 1.f)); acc[ai][bj][m][1][j] *= a1[j] * __builtin_amdgcn_rcpf(fmaxf(b1[j], 1.f)); } }
                asm volatile("" : "+v"(acc[ai][bj][0][0]), "+v"(acc[ai][bj][1][0]), "+v"(acc[ai][bj][2][0]), "+v"(acc[ai][bj][3][0]) :: "memory"); } }
    }
    __device__ __forceinline__ void operator()(const Acc& acc, const GUnit& u, int wr, int wc, int fr, int fq) const {
        asm volatile("" : "+v"(fr), "+v"(fq));
        const int row0 = u.pm * BM + wr * 64 + fr;
#pragma unroll
        for (int bj = 0; bj < 2; ++bj) { const int col0 = u.pn * BM + bj * HALF + wc * 32 + 8 * fq;
#pragma unroll
            for (int ai = 0; ai < 2; ++ai) {
                uint2 g[4];
#pragma unroll
                for (int m = 0; m < 4; ++m) g[m] = *(const uint2*)(g8 + (size_t)(row0 + ai * HALF + m * 16) * 3072 + 2 * D + col0);
#pragma unroll
                for (int m = 0; m < 4; ++m) *(u32x4*)(mo + (size_t)(row0 + ai * HALF + m * 16) * D + col0) = pack8(acc[ai][bj][m][0] * (b4(g[m].x) * (1.f / 255.f)), acc[ai][bj][m][1] * (b4(g[m].y) * (1.f / 255.f)));
                asm volatile("" ::: "memory"); } }
    }
};
struct SchedOut { static constexpr bool GATHER = false, FP8 = false; const int* sel; const LAS int* seltab; GridOrder o; int ksplit; const char* A; const char* B; unsigned lda, ldb; int nt;
    __device__ __forceinline__ bool next(int i, GUnit& u) const { int pm, pn; u.lda = lda; u.ldb = ldb; u.ord = i;
        if (o.tile(i, pm, pn)) { u.A = A + (size_t)pm * 256 * lda; u.B = B + (size_t)pn * 256 * ldb; u.nt = nt; u.pm = pm; u.pn = pn; u.aux = 0; return true; }
        if (!ksplit) return false;
        const long L = (long)i * o.G + o.c - (long)o.nM * o.nN; if (L < 0 || L >= 32) return false;
        const int tile = (int)L >> 2, q = (int)L & 3, pmc = 64 + (tile >> 2), pnc = tile & 3;
        u.A = A + (size_t)pmc * 256 * lda + (size_t)q * 512; u.B = B + (size_t)pnc * 256 * ldb + (size_t)q * 512; u.nt = 4; u.pm = pmc; u.pn = pnc; u.aux = 16 + q; return true; }
};
struct EpiOut { static constexpr bool PERM = false, SEG = false; const float* x; const float* ctx; const float* xa_in; float* xa; const float* mod; int l; float* slab; bf16* dl;
    __device__ __forceinline__ void operator()(const Acc& acc, const GUnit& u, int wr, int wc, int fr, int fq) const {
        asm volatile("" : "+v"(fr), "+v"(fq));
        if (u.aux >= 16) {
            const int rowc = (u.pm - 64) * BM + wr * 64 + fr, col0q = u.pn * BM + wc * 32 + 4 * fq; float* sp = slab + (size_t)(u.aux - 16) * 512 * D;
#pragma unroll
            for (int ai = 0; ai < 2; ++ai)
#pragma unroll
                for (int m = 0; m < 4; ++m)
#pragma unroll
                    for (int bj = 0; bj < 2; ++bj)
#pragma unroll
                        for (int n = 0; n < 2; ++n) *(f32x4*)(sp + (size_t)(rowc + ai * HALF + m * 16) * D + col0q + bj * HALF + n * 16) = acc[ai][bj][m][n];
            return; }
        const int row0 = u.pm * BM + wr * 64 + fr, col0 = u.pn * BM + wc * 32 + 4 * fq; const float* g1 = mod + (u.pm < 32 ? 0 : (u.pm < 64 ? 1 : 2)) * 6144 + 2 * D;
        f32x4 gv[2][2];
#pragma unroll
        for (int bj = 0; bj < 2; ++bj)
#pragma unroll
            for (int n = 0; n < 2; ++n) gv[bj][n] = *(const f32x4*)(g1 + col0 + bj * HALF + n * 16);
#pragma unroll
        for (int ai = 0; ai < 2; ++ai)
#pragma unroll
            for (int m = 0; m < 4; ++m) { const int row = row0 + ai * HALF + m * 16;
#pragma unroll
                for (int bj = 0; bj < 2; ++bj)
#pragma unroll
                    for (int n = 0; n < 2; ++n) { const int c = col0 + bj * HALF + n * 16; const f32x4 v = gv[bj][n] * acc[ai][bj][m][n];
                        uint2 w; w.x = cvt_pk_bf16(v[0], v[1]); w.y = cvt_pk_bf16(v[2], v[3]); *(uint2*)(dl + (size_t)row * D + c) = w; } }
    }
};
template <bool GATHER_> struct SchedMoe { static constexpr bool GATHER = GATHER_, FP8 = true; const int* sel; const LAS int* seltab; GridOrder o; int tpe  ; const char* A; const char* B; unsigned lda, ldb; size_t bstride  ; int nt;
    __device__ __forceinline__ bool next(int i, GUnit& u) const { int pm, pn; if (!o.tile(i, pm, pn)) return false; const int e = pm / tpe, tr = pm % tpe, pmg = e * 9 + tr;
        u.A = GATHER_ ? A : A + (size_t)pmg * 256 * lda; u.B = B + (size_t)e * bstride + (size_t)pn * 256 * ldb; u.lda = lda; u.ldb = ldb; u.nt = nt; u.pm = pmg; u.pn = pn; u.aux = e; u.ord = i; return true; }
};
struct EpiMoeUp { static constexpr bool PERM = true, SEG = false; unsigned char* act;
    __device__ __forceinline__ void operator()(const Acc& acc, const GUnit& u, int wr, int wc, int fr, int fq) const {
        asm volatile("" : "+v"(fr), "+v"(fq));
        const int row0 = u.pm * BM + wr * 64 + fr, col0 = u.pn * HALF + wc * 32 + 8 * fq;
#pragma unroll
        for (int ai = 0; ai < 2; ++ai)
#pragma unroll
            for (int m = 0; m < 4; ++m) { f32x4 o0, o1;
#pragma unroll
                for (int j = 0; j < 4; ++j) { const float g0 = acc[ai][0][m][0][j], g1 = acc[ai][0][m][1][j]; constexpr float C1 = -1.4426950408889634f / F8_WSC, RSO = (F8_WSC * F8_WSC) / F8_ASC;
                    const float e0 = __builtin_amdgcn_exp2f(g0 * C1), e1 = __builtin_amdgcn_exp2f(g1 * C1);
                    o0[j] = clamp_fp8(g0 * acc[ai][1][m][0][j] * __builtin_amdgcn_rcpf(fmaf(e0, RSO, RSO))); o1[j] = clamp_fp8(g1 * acc[ai][1][m][1][j] * __builtin_amdgcn_rcpf(fmaf(e1, RSO, RSO))); }
                uint2 w; w.x = pk4_fp8(o0[0], o0[1], o0[2], o0[3]); w.y = pk4_fp8(o1[0], o1[1], o1[2], o1[3]);
                *(uint2*)(act + (size_t)(row0 + ai * HALF + m * 16) * FF + col0) = w; }
    }
};
struct SchedMoeDown { static constexpr bool GATHER = false, FP8 = true; const int* sel; const LAS int* seltab; GridOrder o; int ksplit; const char* A; const char* B; unsigned lda, ldb; size_t bstride; int nt;
    __device__ __forceinline__ bool next(int i, GUnit& u) const { int pm, pn; u.lda = lda; u.ldb = ldb; u.ord = i;
        if (o.tile(i, pm, pn)) { const int e = pm / o.WGM, tr = pm % o.WGM, pmg = e * 9 + tr;
            u.A = A + (size_t)pmg * 256 * lda; u.B = B + (size_t)e * bstride + (size_t)pn * 256 * ldb; u.nt = nt; u.pm = pmg; u.pn = pn; u.aux = e; return true; }
        if (!ksplit) return false;
        const long L = (long)i * o.G + o.c - (long)o.nM * o.nN; if (L < 0 || L >= 256) return false;
        const int e = (int)L >> 4, pnq = ((int)L >> 2) & 3, q = (int)L & 3, pmg = e * 9 + 8;
        u.A = A + (size_t)pmg * 256 * lda + (size_t)q * 512; u.B = B + (size_t)e * bstride + (size_t)pnq * 256 * ldb + (size_t)q * 512; u.nt = 4; u.pm = pmg; u.pn = pnq; u.aux = 16 + q; return true; }
};
struct EpiMoeDown { static constexpr bool PERM = true, SEG = false; bf16* y; const float* gvx; float* slab;
    __device__ __forceinline__ void operator()(const Acc& acc, const GUnit& u, int wr, int wc, int fr, int fq) const {
        asm volatile("" : "+v"(fr), "+v"(fq));
        const int row0 = u.pm * BM + wr * 64 + fr;
        if (u.aux >= 16) {
            if (wr == 0) { const int q = u.aux - 16, e = u.pm / 9;
#pragma unroll
                for (int m = 0; m < 4; ++m) { const int r64 = m * 16 + fr; const float gv = gvx[row0 + m * 16] * (1.f / (F8_WSC * F8_ASC)); float* sp = slab + (((size_t)q * NE + e) * 64 + r64) * D + u.pn * BM + wc * 32 + 8 * fq;
#pragma unroll
                    for (int bj = 0; bj < 2; ++bj) { *(f32x4*)(sp + bj * HALF) = acc[0][bj][m][0] * gv; *(f32x4*)(sp + bj * HALF + 4) = acc[0][bj][m][1] * gv; } } }
            return; }
        float gvr[2][4];
#pragma unroll
        for (int ai = 0; ai < 2; ++ai)
#pragma unroll
            for (int m = 0; m < 4; ++m) gvr[ai][m] = gvx[row0 + ai * HALF + m * 16];
        __builtin_amdgcn_sched_barrier(0);
#pragma unroll
        for (int ai = 0; ai < 2; ++ai)
#pragma unroll
            for (int m = 0; m < 4; ++m) gvr[ai][m] *= 1.f / (F8_WSC * F8_ASC);
#pragma unroll
        for (int ai = 0; ai < 2; ++ai)
#pragma unroll
            for (int m = 0; m < 4; ++m) { const int row = row0 + ai * HALF + m * 16; const float gv = gvr[ai][m];
#pragma unroll
                for (int bj = 0; bj < 2; ++bj) *(u32x4*)(y + (size_t)row * D + u.pn * BM + bj * HALF + wc * 32 + 8 * fq) = pack8(acc[ai][bj][m][0] * gv, acc[ai][bj][m][1] * gv); }
    }
};
}

constexpr int LDS_RS_OFF = pg::STAGE_BYTES;

__device__ __forceinline__ void ph_inproj_fast(const Params& p, int l, unsigned char* lds_) {
    const int tid = otid();
    { pg::SchedInA S; S.o = pg::GridOrder{T / 256, 8, (int)gridDim.x, oblk(), 8}; S.A = (const char*)(p.ws + WS_H); S.B = (const char*)wl_ptr(p, l, WL_IN); S.lda = D * 2; S.ldb = D * 2; S.nt = D / 64;
      pg::EpiInproj E{(bf16*)(p.ws + WS_Z), g8_ptr(p)};
      pg::gemm_phase((LAS unsigned char*)lds_, S, E); }
    { pg::SchedInB S; S.o = pg::GridOrder{T / 256, 11, (int)gridDim.x, oblk(), 8}; S.A = (const char*)h8_ptr(p); S.B = (const char*)win8_ptr(p, l); S.lda = D; S.ldb = D; S.nt = D / 128;
      pg::EpiInprojG E{g8_ptr(p)};
      pg::gemm_phase((LAS unsigned char*)lds_, S, E); }
}
__device__ __forceinline__ void ph_mlaproj_fast(const Params& p, int l, unsigned char* lds_) {
    const int tid = otid();
    pg::SchedMla S{(int)gridDim.x, oblk(), (const char*)(p.ws + WS_Z), (const char*)wl_ptr(p, l, WL_UQ), (const char*)wl_ptr(p, l, WL_UKV)};
    LAS float* rstab = (LAS float*)((LAS unsigned char*)lds_ + LDS_RS_OFF);
    { pg::GUnit u; const int rl = tid >> 1, hf = tid & 1;
      for (int i = 0; i < 4 && S.next(i, u); ++i) { const int K = u.aux ? KVR : QR; const bf16* zr = (const bf16*)u.A + (size_t)rl * ZW + hf * (K / 2);
          float s = 0.f;
#define RS_ACC(NCH) do { uint4 w_[NCH]; _Pragma("unroll") for (int c_ = 0; c_ < NCH; ++c_) w_[c_] = *(const uint4*)(zr + 8 * c_); __builtin_amdgcn_sched_barrier(0); \
              _Pragma("unroll") for (int c_ = 0; c_ < NCH; ++c_) { const unsigned ww[4] = {w_[c_].x, w_[c_].y, w_[c_].z, w_[c_].w}; \
                  _Pragma("unroll") for (int j = 0; j < 4; ++j) { const float a = __uint_as_float(ww[j] << 16), b = __uint_as_float(ww[j] & 0xffff0000u); s += a * a + b * b; } } } while (0)
          if (u.aux) RS_ACC(KVR / 16); else RS_ACC(QR / 16);
#undef RS_ACC
          s += dppf<DPP_XOR1>(s);
          if (hf == 0) rstab[i * 256 + rl] = rsqrtf(s * (u.aux ? (1.f / KVR) : (1.f / QR)) + EPS); } }
    __syncthreads();
    pg::EpiMla E{(bf16*)(p.ws + WS_Q), (bf16*)(p.ws + WS_KB), (bf16*)(p.ws + WS_VB), (const float*)(p.ws + WS_ROPE), rstab};
    pg::gemm_phase((LAS unsigned char*)lds_, S, E);
    { bf16* Kb = (bf16*)(p.ws + WS_KB); const bf16* z = (const bf16*)(p.ws + WS_Z); const float* rope = (const float*)(p.ws + WS_ROPE);
      for (long it = GTID; it < (long)T * 4; it += GTOT) { const int c = (int)(it & 3), r = (int)(it >> 2);
          const bf16* zr = z + (size_t)r * ZW + Z_KR;
          const uint4 wa = *(const uint4*)(zr + 8 * c), wb = *(const uint4*)(zr + 8 * (c ^ 1));
          const unsigned ua[4] = {wa.x, wa.y, wa.z, wa.w}, ub[4] = {wb.x, wb.y, wb.z, wb.w};
          float o[8];
          if (r < TL) { const int t = r & 8191, pos = (c < 2) ? (t >> 6) : 128 + (t & 63); const float4* rp = (const float4*)(rope + pos * 16);
              const float4 t0 = rp[0], t1 = rp[1], t2 = rp[2], t3 = rp[3];
              const float cs[8] = {t0.x, t0.z, t1.x, t1.z, t2.x, t2.z, t3.x, t3.z}, sn[8] = {t0.y, t0.w, t1.y, t1.w, t2.y, t2.w, t3.y, t3.w};
#pragma unroll
              for (int i = 0; i < 8; ++i) { const float xa = __uint_as_float((i & 1) ? (ua[i >> 1] & 0xffff0000u) : (ua[i >> 1] << 16)), xb = __uint_as_float((i & 1) ? (ub[i >> 1] & 0xffff0000u) : (ub[i >> 1] << 16));
                  o[i] = (c & 1) ? (xa * cs[i] + xb * sn[i]) : (xa * cs[i] - xb * sn[i]); }
          } else {
#pragma unroll
              for (int i = 0; i < 8; ++i) o[i] = __uint_as_float((i & 1) ? (ua[i >> 1] & 0xffff0000u) : (ua[i >> 1] << 16)); }
          uint4 w; w.x = (unsigned)f2bf(o[0]) | ((unsigned)f2bf(o[1]) << 16); w.y = (unsigned)f2bf(o[2]) | ((unsigned)f2bf(o[3]) << 16); w.z = (unsigned)f2bf(o[4]) | ((unsigned)f2bf(o[5]) << 16); w.w = (unsigned)f2bf(o[6]) | ((unsigned)f2bf(o[7]) << 16);
          const size_t kr = (size_t)row_krow(r);
#pragma unroll
          for (int hd = 0; hd < MH; ++hd) *(uint4*)(Kb + kr * QW + hd * QKD + 64 + 8 * c) = w; } }
}
__device__ __forceinline__ void merge_ctx_block(const Params& p, int l, unsigned char* lds_) {
    const int tid = otid(), wid = tid >> 6, lane = tid & 63, fr = lane & 15, fq = lane >> 4;
    const int blk = blockIdx.x, row0 = TL + (blk >> 4) * 32, col0 = (blk & 15) * 64, k0 = wid * 128, br = wid < 4 ? 0 : (wid < 6 ? 1 : 2);
    const bf16* abp = (const bf16*)(p.ws + WS_ABP); const bf16* W = wl_ptr(p, l, WL_CAT); const unsigned char* g8 = g8_ptr(p); bf16* mo = (bf16*)(p.ws + WS_M);
    LAS float* part = (LAS float*)lds_;
    pg::bf16x8 a[2][4], b[4][4]; unsigned g[2][4];
#pragma unroll
    for (int m = 0; m < 2; ++m)
#pragma unroll
        for (int s = 0; s < 4; ++s) a[m][s] = *(const pg::bf16x8*)(abp + (size_t)(row0 + 16 * m + fr) * D + k0 + 32 * s + 8 * fq);
#pragma unroll
    for (int n = 0; n < 4; ++n)
#pragma unroll
        for (int s = 0; s < 4; ++s) b[n][s] = *(const pg::bf16x8*)(W + (size_t)(col0 + 16 * n + fr) * D + k0 + 32 * s + 8 * fq);
#pragma unroll
    for (int m = 0; m < 2; ++m)
#pragma unroll
        for (int n = 0; n < 4; ++n) g[m][n] = *(const unsigned*)(g8 + (size_t)(row0 + 16 * m + fr) * 3072 + br * D + col0 + 16 * n + 4 * fq);
    __syncthreads();
#pragma unroll
    for (int m = 0; m < 2; ++m)
#pragma unroll
        for (int n = 0; n < 4; ++n) { pg::f32x4 acc = {0.f, 0.f, 0.f, 0.f};
#pragma unroll
            for (int s = 0; s < 4; ++s) acc = __builtin_amdgcn_mfma_f32_16x16x32_bf16(b[n][s], a[m][s], acc, 0, 0, 0);
            const unsigned gw = g[m][n]; const pg::f32x4 gv = (pg::f32x4){(float)(gw & 0xffu), (float)((gw >> 8) & 0xffu), (float)((gw >> 16) & 0xffu), (float)(gw >> 24)} * (1.f / 255.f);
            *(LAS pg::f32x4*)(part + (wid * 32 + 16 * m + fr) * 68 + 16 * n + 4 * fq) = acc * gv; }
    __syncthreads();
    { const int row = tid >> 4, c4 = (tid & 15) * 4; pg::f32x4 sum = *(const LAS pg::f32x4*)(part + row * 68 + c4);
#pragma unroll
      for (int w = 1; w < 8; ++w) sum += *(const LAS pg::f32x4*)(part + (w * 32 + row) * 68 + c4);
      uint2 o; o.x = cvtpk2(sum[0], sum[1]); o.y = cvtpk2(sum[2], sum[3]);
      *(uint2*)(mo + (size_t)(row0 + row) * D + col0 + c4) = o; }
    __syncthreads();
}
__device__ __forceinline__ void ph_merge_fast(const Params& p, int l, unsigned char* lds_) {
    const int tid = otid();
    const bool ctxblk = (l != DEPTH - 1) && gridDim.x == 256;
    const int nM = (l == DEPTH - 1 || ctxblk) ? TL / 256 : T / 256;
    pg::SchedSimple S; S.o = pg::GridOrder{nM, D / 256, (int)gridDim.x, oblk(), 8}; S.A = (const char*)(p.ws + WS_ABP); S.B = (const char*)wl_ptr(p, l, WL_CAT); S.lda = D * 2; S.ldb = D * 2; S.nt = D / 64;
    pg::EpiMerge E{g8_ptr(p), (bf16*)(p.ws + WS_M)};
    pg::gemm_phase((LAS unsigned char*)lds_, S, E);
    if (ctxblk) merge_ctx_block(p, l, lds_);
}
__device__ __forceinline__ void ph_outproj_fast(const Params& p, int l, unsigned char* lds_) {
    const int tid = otid();
    const bool ksplit = (l != DEPTH - 1) && gridDim.x == 256;
    const int nM = (l == DEPTH - 1 || ksplit) ? TL / 256 : T / 256;
    pg::SchedOut S; S.sel = nullptr; S.seltab = nullptr; S.o = pg::GridOrder{nM, D / 256, (int)gridDim.x, oblk(), 8}; S.ksplit = ksplit ? 1 : 0; S.A = (const char*)(p.ws + WS_M); S.B = (const char*)wl_ptr(p, l, WL_OUT); S.lda = D * 2; S.ldb = D * 2; S.nt = D / 64;
    pg::EpiOut E{p.in[I_X], p.in[I_CTX], (const float*)(p.ws + WS_XA), (float*)(p.ws + WS_XA), (const float*)(p.ws + WS_MOD) + (size_t)l * 3 * 6144, l, (float*)(p.ws + WS_SLAB), (bf16*)g8_ptr(p)};
    pg::gemm_phase((LAS unsigned char*)lds_, S, E);
}
__device__ __forceinline__ void ph_moeup_fast(const Params& p, int l, unsigned char* lds_) {
    const int tid = otid();
    const int tpe = (l == DEPTH - 1) ? 8 : 9;
    pg::SchedMoe<true> S; S.sel = (const int*)(p.ws + WS_SEL); S.o = pg::GridOrder{NE * tpe, 2 * FF / 256, (int)gridDim.x, oblk(), 4}; S.tpe = tpe; S.A = (const char*)(p.ws + WS_H); S.B = (const char*)wl_ptr(p, l, WL_GU);
    S.lda = D; S.ldb = D; S.bstride = (size_t)2 * FF * D; S.nt = D / 128;
    { LAS int* tab = (LAS int*)((LAS unsigned char*)lds_ + LDS_RS_OFF); S.seltab = tab; pg::GUnit u;
      __syncthreads();
      int pmv[12], tv[12];
#pragma unroll
      for (int i = 0; i < 12; ++i) pmv[i] = S.next(i, u) ? u.pm : -1;
#pragma unroll
      for (int i = 0; i < 12; ++i) tv[i] = (pmv[i] >= 0 && tid < 256) ? S.sel[pmv[i] * 256 + tid] : 0;
      __builtin_amdgcn_sched_barrier(0);
#pragma unroll
      for (int i = 0; i < 12; ++i) if (pmv[i] >= 0 && tid < 256) tab[i * 256 + tid] = tv[i];
      __syncthreads(); }
    pg::EpiMoeUp E{(unsigned char*)(p.ws + WS_ACT)};
    pg::gemm_phase((LAS unsigned char*)lds_, S, E);
}
__device__ __forceinline__ void ph_moedown_fast(const Params& p, int l, unsigned char* lds_) {
    const int tid = otid();
    const bool ksplit = (l != DEPTH - 1) && gridDim.x == 256;
    const int tpe = (l == DEPTH - 1 || ksplit) ? 8 : 9;
    pg::SchedMoeDown S; S.sel = nullptr; S.seltab = nullptr; S.o = pg::GridOrder{NE * tpe, D / 256, (int)gridDim.x, oblk(), tpe}; S.ksplit = ksplit ? 1 : 0; S.A = (const char*)(p.ws + WS_ACT); S.B = (const char*)wl_ptr(p, l, WL_DN);
    S.lda = FF; S.ldb = FF; S.bstride = (size_t)D * FF; S.nt = FF / 128;
    pg::EpiMoeDown E{(bf16*)(p.ws + WS_Y), (const float*)(p.ws + WS_GVX), (float*)(p.ws + WS_SLAB)};
    pg::gemm_phase((LAS unsigned char*)lds_, S, E);
}

namespace mla {
using bf16x8 = __attribute__((ext_vector_type(8))) short;
using s16x4  = __attribute__((ext_vector_type(4))) short;
using f32x16 = __attribute__((ext_vector_type(16))) float;
using u32x4  = __attribute__((ext_vector_type(4))) unsigned;
constexpr int KVBLK = 64;
constexpr float SCALE = 0.10206207261596575f, THR = 8.f;
constexpr int SHM_V = 64 * 64 * 2, SHM_K = 64 * 256;
constexpr int LDS_BYTES = 2 * SHM_V + 2 * SHM_K + 8 * 64 * 4;
#define KSWZ(row, colB) ((row) * 256 + ((colB) ^ (((row) & 15) << 4)))
#define SBAR() __builtin_amdgcn_sched_barrier(0)
__device__ __forceinline__ int crow(int r, int hi) { return (r & 3) + 8 * (r >> 2) + 4 * hi; }
__device__ __forceinline__ unsigned cvtpk(float lo, float hi) { unsigned r; asm volatile("v_cvt_pk_bf16_f32 %0, %1, %2" : "=v"(r) : "v"(lo), "v"(hi)); return r; }
__device__ __forceinline__ void store_tile_rows(char* wl, const f32x16& o0, const f32x16& o1, bf16* dst, long stride, int lane) {
    const int r32 = lane & 31, hi = lane >> 5; unsigned short* w = (unsigned short*)wl;
#pragma unroll
    for (int r = 0; r < 16; ++r) { const unsigned v = cvtpk(o0[r], o1[r]); const int row = crow(r, hi); w[row * 72 + r32] = (unsigned short)(v & 0xffffu); w[row * 72 + 32 + r32] = (unsigned short)(v >> 16); }
    asm volatile("s_waitcnt lgkmcnt(0)" ::: "memory");
#pragma unroll
    for (int i = 0; i < 4; ++i) { const int row = i * 8 + (lane >> 3), ch = lane & 7; const u32x4 v = *(const u32x4*)(wl + row * 144 + ch * 16); *(u32x4*)(dst + (long)row * stride + ch * 8) = v; }
    asm volatile("s_waitcnt lgkmcnt(0)" ::: "memory");
}
constexpr float THR2 = THR * 1.4426950408889634f;
__device__ __forceinline__ void partialSM(f32x16& p0, f32x16& p1, float& m_reg, float& mn, float& alpha) {
    float pmax = p0[0];
#pragma unroll
    for (int r = 1; r < 16; ++r) pmax = fmaxf(pmax, p0[r]);
#pragma unroll
    for (int r = 0; r < 16; ++r) pmax = fmaxf(pmax, p1[r]);
    { auto rr = __builtin_amdgcn_permlane32_swap(__float_as_uint(pmax), __float_as_uint(pmax), false, false); pmax = fmaxf(__uint_as_float(rr[0]), __uint_as_float(rr[1])); }
    if (__builtin_expect(__all(pmax - m_reg <= THR2), 1)) { mn = m_reg; alpha = 1.f; }
    else { mn = fmaxf(m_reg, pmax); alpha = __builtin_amdgcn_exp2f(m_reg - mn); m_reg = mn; }
#pragma unroll
    for (int r = 0; r < 16; ++r) p0[r] -= mn;
#pragma unroll
    for (int r = 0; r < 16; ++r) p1[r] -= mn;
#pragma unroll
    for (int r = 0; r < 16; ++r) p0[r] = __builtin_amdgcn_exp2f(p0[r]);
}
__device__ __forceinline__ float expsum(f32x16& p0, f32x16& p1) {
#pragma unroll
    for (int r = 0; r < 16; ++r) p0[r] = __builtin_amdgcn_exp2f(p0[r]);
#pragma unroll
    for (int r = 0; r < 16; ++r) p1[r] = __builtin_amdgcn_exp2f(p1[r]);
    float sa = 0;
#pragma unroll
    for (int r = 0; r < 16; ++r) sa += p0[r];
#pragma unroll
    for (int r = 0; r < 16; ++r) sa += p1[r];
    { auto rr = __builtin_amdgcn_permlane32_swap(__float_as_uint(sa), __float_as_uint(sa), false, false); sa = __uint_as_float(rr[0]) + __uint_as_float(rr[1]); }
    return sa;
}
__device__ __forceinline__ void packP(const f32x16& p0, const f32x16& p1, bf16x8& pa0, bf16x8& pa1, bf16x8& pa2, bf16x8& pa3) {
#define PK4(P, BASE, OUT) do { unsigned a0 = cvtpk(P[BASE + 0], P[BASE + 1]), a1 = cvtpk(P[BASE + 2], P[BASE + 3]);   \
    unsigned b0 = cvtpk(P[BASE + 4], P[BASE + 5]), b1 = cvtpk(P[BASE + 6], P[BASE + 7]);                              \
    auto r0 = __builtin_amdgcn_permlane32_swap(a0, b0, false, false); auto r1 = __builtin_amdgcn_permlane32_swap(a1, b1, false, false); \
    u32x4 w = {r0[0], r1[0], r0[1], r1[1]}; OUT = *reinterpret_cast<bf16x8*>(&w); } while (0)
    PK4(p0, 0, pa0); PK4(p0, 8, pa1); PK4(p1, 0, pa2); PK4(p1, 8, pa3);
#undef PK4
}
__device__ __forceinline__ void finishSM(f32x16& p0, f32x16& p1, float alpha, float& l_reg, bf16x8& pa0, bf16x8& pa1, bf16x8& pa2, bf16x8& pa3) {
#pragma unroll
    for (int r = 0; r < 16; ++r) p1[r] = __builtin_amdgcn_exp2f(p1[r]);
    float ps = 0;
#pragma unroll
    for (int r = 0; r < 16; ++r) ps += p0[r];
#pragma unroll
    for (int r = 0; r < 16; ++r) ps += p1[r];
    { auto rr = __builtin_amdgcn_permlane32_swap(__float_as_uint(ps), __float_as_uint(ps), false, false); ps = __uint_as_float(rr[0]) + __uint_as_float(rr[1]); }
    l_reg = l_reg * alpha + ps;
#define PK4(P, BASE, OUT) do { unsigned a0 = cvtpk(P[BASE + 0], P[BASE + 1]), a1 = cvtpk(P[BASE + 2], P[BASE + 3]);   \
    unsigned b0 = cvtpk(P[BASE + 4], P[BASE + 5]), b1 = cvtpk(P[BASE + 6], P[BASE + 7]);                              \
    auto r0 = __builtin_amdgcn_permlane32_swap(a0, b0, false, false); auto r1 = __builtin_amdgcn_permlane32_swap(a1, b1, false, false); \
    u32x4 w = {r0[0], r1[0], r0[1], r1[1]}; OUT = *reinterpret_cast<bf16x8*>(&w); } while (0)
    PK4(p0, 0, pa0); PK4(p0, 8, pa1); PK4(p1, 0, pa2); PK4(p1, 8, pa3);
#undef PK4
}
__device__ __forceinline__ void qkt(f32x16& p0, f32x16& p1, const char* Ks, const bf16x8* qr, int r32, int hi) {
    p0 = f32x16{}; p1 = f32x16{};
#pragma unroll
    for (int d0 = 0; d0 < 6; ++d0) { const int cb = (d0 * 16 + hi * 8) * 2;
        bf16x8 b0 = *reinterpret_cast<const bf16x8*>(Ks + KSWZ(r32, cb));
        bf16x8 b1 = *reinterpret_cast<const bf16x8*>(Ks + KSWZ(32 + r32, cb));
        p0 = __builtin_amdgcn_mfma_f32_32x32x16_bf16(b0, qr[d0], p0, 0, 0, 0);
        p1 = __builtin_amdgcn_mfma_f32_32x32x16_bf16(b1, qr[d0], p1, 0, 0, 0); }
}
__device__ __forceinline__ int v_st(int k, int c) { const int kk = (k & ~0xC) | ((k & 4) << 1) | ((k & 8) >> 1); return ((kk >> 3) * 2 + (c >> 5)) * 512 + ((kk & 7) * 32 + (c & 31)) * 2; }
__device__ __forceinline__ int v_rd_base(int lane) { return ((lane & 3) << 3) | (((lane >> 2) & 3) << 6) | (((lane >> 4) & 1) << 5) | (((lane >> 5) & 1) << 8); }
constexpr int v_rd_off(int d0, int ks, int half) { return d0 * 512 + ks * 2048 + half * 1024; }
template <int OFF> __device__ __forceinline__ s16x4 tr_read(int vb) { s16x4 r; asm volatile("ds_read_b64_tr_b16 %0, %1 offset:%2" : "=&v"(r) : "v"(vb), "i"(OFF) : "memory"); return r; }
template <int D0> __device__ __forceinline__ void pv_one(f32x16& od, int vb, bf16x8 pa0, bf16x8 pa1, bf16x8 pa2, bf16x8 pa3) {
    const s16x4 l0 = tr_read<v_rd_off(D0, 0, 0)>(vb), h0 = tr_read<v_rd_off(D0, 0, 1)>(vb), l1 = tr_read<v_rd_off(D0, 1, 0)>(vb), h1 = tr_read<v_rd_off(D0, 1, 1)>(vb);
    const s16x4 l2 = tr_read<v_rd_off(D0, 2, 0)>(vb), h2 = tr_read<v_rd_off(D0, 2, 1)>(vb), l3 = tr_read<v_rd_off(D0, 3, 0)>(vb), h3 = tr_read<v_rd_off(D0, 3, 1)>(vb);
    asm volatile("s_waitcnt lgkmcnt(0)" ::: "memory"); SBAR();
#define PK(L, H) (bf16x8){L[0], L[1], L[2], L[3], H[0], H[1], H[2], H[3]}
    od = __builtin_amdgcn_mfma_f32_32x32x16_bf16(pa0, PK(l0, h0), od, 0, 0, 0);
    od = __builtin_amdgcn_mfma_f32_32x32x16_bf16(pa1, PK(l1, h1), od, 0, 0, 0);
    od = __builtin_amdgcn_mfma_f32_32x32x16_bf16(pa2, PK(l2, h2), od, 0, 0, 0);
    od = __builtin_amdgcn_mfma_f32_32x32x16_bf16(pa3, PK(l3, h3), od, 0, 0, 0);
#undef PK
}
__device__ __forceinline__ void pv_d0(f32x16& o0, f32x16& o1, int vb, bf16x8 pa0, bf16x8 pa1, bf16x8 pa2, bf16x8 pa3) { pv_one<0>(o0, vb, pa0, pa1, pa2, pa3); pv_one<1>(o1, vb, pa0, pa1, pa2, pa3); }

__device__ __forceinline__ void attn_unit(const bf16* __restrict__ Qb, const bf16* __restrict__ Kh, const bf16* __restrict__ Vh, bf16* __restrict__ Ob, int nkeys, char* lds, int tid) {
    asm volatile("" : "+v"(tid));
    const int wid = __builtin_amdgcn_readfirstlane(tid >> 6), lane = tid & 63, r32 = lane & 31, hi = lane >> 5;
    char* V_lds = lds; char* K_lds = lds + 2 * SHM_V;
    float* ws = (float*)(lds + 2 * SHM_V + 2 * SHM_K) + wid * 64; float* li_l = ws; float* al_l = ws + 32;
    float m_reg = -1e30f, l_reg = 0; f32x16 o0 = {}, o1 = {}; bf16x8 qr[6];
    const bf16* Qw = Qb + (long)(wid * 32 + r32) * QW + hi * 8;
#pragma unroll
    for (int d0 = 0; d0 < 6; ++d0) qr[d0] = *reinterpret_cast<const bf16x8*>(Qw + d0 * 16);
    const int kr0 = tid / 12, kc0 = tid % 12, kr1 = (tid + 512) / 12, kc1 = (tid + 512) % 12, vr = tid >> 3, vc = tid & 7;
    const bool two = wid < 4;
    const int kst0 = KSWZ(kr0, kc0 * 16), kst1 = KSWZ(kr1, kc1 * 16), vst = v_st(vr, vc * 8);
    const bf16* kg0 = Kh + (long)kr0 * QW + kc0 * 8; const bf16* kg1 = Kh + (long)kr1 * QW + kc1 * 8; const bf16* vg = Vh + (long)vr * AW + vc * 8;
    const int vb0 = (int)(uintptr_t)V_lds + v_rd_base(lane);
    bf16x8 sk0[2], sk1[2], sv[2];
#define SLOAD(i, k0) do { sv[i] = *reinterpret_cast<const bf16x8*>(vg + (long)(k0) * AW); sk0[i] = *reinterpret_cast<const bf16x8*>(kg0 + (long)(k0) * QW); if (two) sk1[i] = *reinterpret_cast<const bf16x8*>(kg1 + (long)(k0) * QW); } while (0)
#define SWRITE(b, i) do { *(bf16x8*)(V_lds + (b) * SHM_V + vst) = sv[i]; *(bf16x8*)(K_lds + (b) * SHM_K + kst0) = sk0[i]; if (two) *(bf16x8*)(K_lds + (b) * SHM_K + kst1) = sk1[i]; } while (0)
#define SWAIT() do { if (two) asm volatile("s_waitcnt vmcnt(3)" ::: "memory"); else asm volatile("s_waitcnt vmcnt(2)" ::: "memory"); } while (0)
#define RESC(a) do { if (__any((a) < 1.f)) { if (hi == 0) al_l[r32] = (a); asm volatile("s_waitcnt lgkmcnt(0)" ::: "memory"); \
    _Pragma("unroll") for (int r = 0; r < 16; ++r) { const float f = al_l[crow(r, hi)]; o0[r] *= f; o1[r] *= f; } } } while (0)
    f32x16 pA0, pA1, pB0, pB1; float mnA, mnB, alA, alB; bf16x8 pa0, pa1, pa2, pa3; const int NTL = nkeys / KVBLK;
    __syncthreads();
    SLOAD(0, 0); asm volatile("s_waitcnt vmcnt(0)" ::: "memory"); SWRITE(0, 0); __syncthreads();
    qkt(pA0, pA1, K_lds, qr, r32, hi); partialSM(pA0, pA1, m_reg, mnA, alA);
    SLOAD(1, KVBLK); if (2 < NTL) SLOAD(0, 2 * KVBLK);
    SWAIT(); SWRITE(1, 1); __syncthreads();
    for (int j = 1; j + 1 < NTL; j += 2) {
        SBAR(); qkt(pB0, pB1, K_lds + SHM_K, qr, r32, hi);
        finishSM(pA0, pA1, alA, l_reg, pa0, pa1, pa2, pa3); SBAR();
        SLOAD(1, (j + 2) * KVBLK); SBAR();
        pv_d0(o0, o1, vb0, pa0, pa1, pa2, pa3); partialSM(pB0, pB1, m_reg, mnB, alB);
        __syncthreads(); SWAIT(); SWRITE(0, 0);
        RESC(alB); __syncthreads();
        SBAR(); qkt(pA0, pA1, K_lds, qr, r32, hi);
        finishSM(pB0, pB1, alB, l_reg, pa0, pa1, pa2, pa3); SBAR();
        if (j + 3 < NTL) SLOAD(0, (j + 3) * KVBLK); SBAR();
        pv_d0(o0, o1, vb0 + SHM_V, pa0, pa1, pa2, pa3); partialSM(pA0, pA1, m_reg, mnA, alA);
        __syncthreads(); SWAIT(); SWRITE(1, 1);
        RESC(alA); __syncthreads();
    }
    SBAR(); qkt(pB0, pB1, K_lds + SHM_K, qr, r32, hi);
    finishSM(pA0, pA1, alA, l_reg, pa0, pa1, pa2, pa3); SBAR();
    pv_d0(o0, o1, vb0, pa0, pa1, pa2, pa3); partialSM(pB0, pB1, m_reg, mnB, alB);
    __syncthreads(); RESC(alB);
    finishSM(pB0, pB1, alB, l_reg, pa0, pa1, pa2, pa3); SBAR();
    pv_d0(o0, o1, vb0 + SHM_V, pa0, pa1, pa2, pa3);
    if (hi == 0) li_l[r32] = l_reg; asm volatile("s_waitcnt lgkmcnt(0)" ::: "memory");
#pragma unroll
    for (int r = 0; r < 16; ++r) { const float rl = __builtin_amdgcn_rcpf(li_l[crow(r, hi)]); o0[r] *= rl; o1[r] *= rl; }
    __syncthreads();
    store_tile_rows(lds + wid * 4608, o0, o1, Ob + (long)(wid * 32) * D, D, lane);
#undef SLOAD
#undef SWRITE
#undef SWAIT
#undef RESC
}

struct CvtSide {
    const float* wg; long du, dd; unsigned char* gu; unsigned char* dn; int on;
    __device__ __forceinline__ void setup(int e, int sub, int run, int tid, const char*& sb, char*& db, unsigned& slo, unsigned& dlo, int& sh) const {
        const int nl = (tid >> 6) * 16 + (tid & 15), kp = (tid & 63) >> 4; const bool isdn = run == 2;
        const int N = isdn ? D : FF, K = isdn ? FF : D; sh = isdn ? 12 : 13;
        const size_t so = (size_t)e * D * FF + (isdn ? (size_t)((sub & 1) * 1024) * D + (sub >> 1) * 128 : (size_t)sub * 128);
        sb = (const char*)(wg + (run == 1 ? du : 0) + (isdn ? dd : 0) + so);
        db = (char*)((isdn ? dn : gu) + (isdn ? (size_t)e * D * FF + (size_t)((sub >> 1) * 128) * FF + (sub & 1) * 1024 : (size_t)e * 2 * FF * D + (size_t)(256 * sub + 128 * run) * D));
        slo = (unsigned)(kp * 8 * N + nl) * 4u; dlo = (unsigned)(nl * K + kp * 8);
    }
    __device__ __forceinline__ void load(const char*& sb, unsigned slo, int sh, float (&v)[8]) const {
#pragma unroll
        for (int i = 0; i < 8; ++i) v[i] = *(const float*)(sb + (slo + ((unsigned)i << sh)));
        sb += (size_t)32 << sh;
    }
    __device__ __forceinline__ void store(char*& db, unsigned dlo, const float (&v)[8]) const {
        uint2 w; w.x = pk4_fp8(v[0] * F8_WSC, v[1] * F8_WSC, v[2] * F8_WSC, v[3] * F8_WSC); w.y = pk4_fp8(v[4] * F8_WSC, v[5] * F8_WSC, v[6] * F8_WSC, v[7] * F8_WSC);
        *(uint2*)(db + dlo) = w; db += 32;
    }
};

template <int D0> __device__ __forceinline__ void pv_one2(f32x16& oa, f32x16& ob, int vb, bf16x8 a0, bf16x8 a1, bf16x8 a2, bf16x8 a3, bf16x8 b0, bf16x8 b1, bf16x8 b2, bf16x8 b3) {
    const s16x4 l0 = tr_read<v_rd_off(D0, 0, 0)>(vb), h0 = tr_read<v_rd_off(D0, 0, 1)>(vb), l1 = tr_read<v_rd_off(D0, 1, 0)>(vb), h1 = tr_read<v_rd_off(D0, 1, 1)>(vb);
    const s16x4 l2 = tr_read<v_rd_off(D0, 2, 0)>(vb), h2 = tr_read<v_rd_off(D0, 2, 1)>(vb), l3 = tr_read<v_rd_off(D0, 3, 0)>(vb), h3 = tr_read<v_rd_off(D0, 3, 1)>(vb);
    asm volatile("s_waitcnt lgkmcnt(0)" ::: "memory"); SBAR();
#define PK(L, H) (bf16x8){L[0], L[1], L[2], L[3], H[0], H[1], H[2], H[3]}
    const bf16x8 v0 = PK(l0, h0), v1 = PK(l1, h1), v2 = PK(l2, h2), v3 = PK(l3, h3);
    oa = __builtin_amdgcn_mfma_f32_32x32x16_bf16(a0, v0, oa, 0, 0, 0); ob = __builtin_amdgcn_mfma_f32_32x32x16_bf16(b0, v0, ob, 0, 0, 0);
    oa = __builtin_amdgcn_mfma_f32_32x32x16_bf16(a1, v1, oa, 0, 0, 0); ob = __builtin_amdgcn_mfma_f32_32x32x16_bf16(b1, v1, ob, 0, 0, 0);
    oa = __builtin_amdgcn_mfma_f32_32x32x16_bf16(a2, v2, oa, 0, 0, 0); ob = __builtin_amdgcn_mfma_f32_32x32x16_bf16(b2, v2, ob, 0, 0, 0);
    oa = __builtin_amdgcn_mfma_f32_32x32x16_bf16(a3, v3, oa, 0, 0, 0); ob = __builtin_amdgcn_mfma_f32_32x32x16_bf16(b3, v3, ob, 0, 0, 0);
#undef PK
}
__device__ __forceinline__ void attn_unit2(const bf16* __restrict__ Qb, const bf16* __restrict__ Kh, const bf16* __restrict__ Vh, bf16* __restrict__ Ob, int nkeys, char* lds, int tid, const CvtSide& side, int cbase) {
    asm volatile("" : "+v"(tid));
    const int wid = __builtin_amdgcn_readfirstlane(tid >> 6), lane = tid & 63, r32 = lane & 31, hi = lane >> 5;
    char* V_lds = lds; char* K_lds = lds + 4 * SHM_V;
    float* ws = (float*)(lds + 4 * SHM_V + 4 * SHM_K) + wid * 128; float* liA = ws; float* liB = ws + 32; float* alA_l = ws + 64; float* alB_l = ws + 96;
    float mA = 0.f, lA = 0, mB = 0.f, lB = 0; bool slow = false; f32x16 oA0 = {}, oA1 = {}, oB0 = {}, oB1 = {}; bf16x8 qA[6], qB[6];
    const bf16* Qw = Qb + (long)(wid * 64 + r32) * QW + hi * 8;
#pragma unroll
    for (int d0 = 0; d0 < 6; ++d0) { qA[d0] = *reinterpret_cast<const bf16x8*>(Qw + d0 * 16); qB[d0] = *reinterpret_cast<const bf16x8*>(Qw + 32 * QW + d0 * 16); }
    const int kr0 = tid / 12, kc0 = tid % 12, kr1 = (tid + 512) / 12, kc1 = (tid + 512) % 12, vr = tid >> 3, vc = tid & 7;
    const bool two = wid < 4;
    const int kst0 = KSWZ(kr0, kc0 * 16), kst1 = KSWZ(kr1, kc1 * 16), vst = v_st(vr, vc * 8);
    const bf16* kg0 = Kh + (long)kr0 * QW + kc0 * 8; const bf16* kg1 = Kh + (long)kr1 * QW + kc1 * 8; const bf16* vg = Vh + (long)vr * AW + vc * 8;
    const int vb0 = (int)(uintptr_t)V_lds + v_rd_base(lane);
    bf16x8 sk0, sk1, sv;
#define SLOAD2(k0) do { sv = *reinterpret_cast<const bf16x8*>(vg + (long)(k0) * AW); sk0 = *reinterpret_cast<const bf16x8*>(kg0 + (long)(k0) * QW); if (two) sk1 = *reinterpret_cast<const bf16x8*>(kg1 + (long)(k0) * QW); } while (0)
#define TBUF(t) (((((t) >> 1) & 1) << 1) | ((t) & 1))
#define SWRITE2(b) do { *(bf16x8*)(V_lds + (b) * SHM_V + vst) = sv; *(bf16x8*)(K_lds + (b) * SHM_K + kst0) = sk0; if (two) *(bf16x8*)(K_lds + (b) * SHM_K + kst1) = sk1; } while (0)
#define RESC2(a, al_l, o0, o1) do { if (__any((a) < 1.f)) { if (hi == 0) al_l[r32] = (a); asm volatile("s_waitcnt lgkmcnt(0)" ::: "memory"); \
    _Pragma("unroll") for (int r = 0; r < 16; ++r) { const float f = al_l[crow(r, hi)]; o0[r] *= f; o1[r] *= f; } } } while (0)
    const int NTL = nkeys / KVBLK;
    __syncthreads();
    SLOAD2(0); SWRITE2(TBUF(0)); SLOAD2(KVBLK); SWRITE2(TBUF(1)); SLOAD2(2 * KVBLK);
    if (wid >= 4) __builtin_amdgcn_s_setprio(1);
    const char* sd_sb = nullptr; char* sd_db = nullptr; unsigned sd_slo = 0, sd_dlo = 0; int sd_sh = 12;
    for (int j = 0; j < NTL; ++j) {
        if ((j & 1) == 0) __syncthreads();
        if (j + 2 < NTL) { SWRITE2(TBUF(j + 2)); if (j + 3 < NTL) SLOAD2((j + 3) * KVBLK); }
        float cv[8]; const bool cvt_on = side.on && j < 96;
        if (cvt_on) { if ((j & 31) == 0) side.setup(cbase >> 4, cbase & 15, j >> 5, tid, sd_sb, sd_db, sd_slo, sd_dlo, sd_sh); side.load(sd_sb, sd_slo, sd_sh, cv); }
        const char* Ks = K_lds + TBUF(j) * SHM_K; const int vb = vb0 + TBUF(j) * SHM_V;
        float mn, al; bf16x8 a0, a1, a2, a3, c0, c1, c2, c3;
        if (__builtin_expect(!slow, 1)) {
            float psA, psB;
#if MLA_ILV
            {
                f32x16 pA0, pA1; qkt(pA0, pA1, Ks, qA, r32, hi);
                f32x16 pB0 = {}, pB1 = {}; float sA = 0.f;
#define BSTEP(d0) do { const int cb_ = ((d0) * 16 + hi * 8) * 2; const bf16x8 b0_ = *reinterpret_cast<const bf16x8*>(Ks + KSWZ(r32, cb_)), b1_ = *reinterpret_cast<const bf16x8*>(Ks + KSWZ(32 + r32, cb_)); \
                    pB0 = __builtin_amdgcn_mfma_f32_32x32x16_bf16(b0_, qB[d0], pB0, 0, 0, 0); pB1 = __builtin_amdgcn_mfma_f32_32x32x16_bf16(b1_, qB[d0], pB1, 0, 0, 0); } while (0)
#define ACHUNK(P, BASE, OUT) do { _Pragma("unroll") for (int r_ = 0; r_ < 8; ++r_) { P[BASE + r_] = __builtin_amdgcn_exp2f(P[BASE + r_]); sA += P[BASE + r_]; } \
                    unsigned x0_ = cvtpk(P[BASE + 0], P[BASE + 1]), x1_ = cvtpk(P[BASE + 2], P[BASE + 3]), y0_ = cvtpk(P[BASE + 4], P[BASE + 5]), y1_ = cvtpk(P[BASE + 6], P[BASE + 7]); \
                    auto r0_ = __builtin_amdgcn_permlane32_swap(x0_, y0_, false, false); auto r1_ = __builtin_amdgcn_permlane32_swap(x1_, y1_, false, false); \
                    u32x4 w_ = {r0_[0], r1_[0], r0_[1], r1_[1]}; OUT = *reinterpret_cast<bf16x8*>(&w_); } while (0)
                BSTEP(0); ACHUNK(pA0, 0, a0); SBAR();
                BSTEP(1); ACHUNK(pA0, 8, a1); SBAR();
                BSTEP(2); ACHUNK(pA1, 0, a2); SBAR();
                BSTEP(3); ACHUNK(pA1, 8, a3); SBAR();
                BSTEP(4); BSTEP(5);
#undef BSTEP
#undef ACHUNK
                { auto rr = __builtin_amdgcn_permlane32_swap(__float_as_uint(sA), __float_as_uint(sA), false, false); psA = __uint_as_float(rr[0]) + __uint_as_float(rr[1]); }
                psB = expsum(pB0, pB1); packP(pB0, pB1, c0, c1, c2, c3);
            }
#else
            { f32x16 p0, p1; qkt(p0, p1, Ks, qA, r32, hi); psA = expsum(p0, p1); packP(p0, p1, a0, a1, a2, a3); }
            { f32x16 p0, p1; qkt(p0, p1, Ks, qB, r32, hi); psB = expsum(p0, p1); packP(p0, p1, c0, c1, c2, c3); }
#endif
            const bool bad = !(psA < 1.0e12f) || !(psB < 1.0e12f) || (j == 0 && (!(psA > 1.0e-18f) || !(psB > 1.0e-18f)));
            if (__builtin_expect(__any(bad), 0)) { slow = true; if (j == 0) { mA = -1e30f; mB = -1e30f; } }
            else { lA += psA; lB += psB; }
        }
        if (__builtin_expect(slow, 0)) {
            { f32x16 p0, p1; qkt(p0, p1, Ks, qA, r32, hi); partialSM(p0, p1, mA, mn, al); RESC2(al, alA_l, oA0, oA1); finishSM(p0, p1, al, lA, a0, a1, a2, a3); }
            { f32x16 p0, p1; qkt(p0, p1, Ks, qB, r32, hi); partialSM(p0, p1, mB, mn, al); RESC2(al, alB_l, oB0, oB1); finishSM(p0, p1, al, lB, c0, c1, c2, c3); }
        }
        pv_one2<0>(oA0, oB0, vb, a0, a1, a2, a3, c0, c1, c2, c3);
        pv_one2<1>(oA1, oB1, vb, a0, a1, a2, a3, c0, c1, c2, c3);
        if (cvt_on) side.store(sd_db, sd_dlo, cv);
    }
    __builtin_amdgcn_s_setprio(0);
    if (hi == 0) { liA[r32] = lA; liB[r32] = lB; } asm volatile("s_waitcnt lgkmcnt(0)" ::: "memory");
#pragma unroll
    for (int r = 0; r < 16; ++r) { const int orow = crow(r, hi); const float ra = __builtin_amdgcn_rcpf(liA[orow]), rb = __builtin_amdgcn_rcpf(liB[orow]); oA0[r] *= ra; oA1[r] *= ra; oB0[r] *= rb; oB1[r] *= rb; }
    __syncthreads();
    store_tile_rows(lds + wid * 9216, oA0, oA1, Ob + (long)(wid * 64) * D, D, lane);
    store_tile_rows(lds + wid * 9216 + 4608, oB0, oB1, Ob + (long)(wid * 64 + 32) * D, D, lane);
#undef SLOAD2
#undef SWRITE2
#undef TBUF
#undef RESC2
}
#undef KSWZ
#undef SBAR
}

__device__ __forceinline__ void ph_mla_fast(const Params& p, int l, unsigned char* lds_) {
    const int tid = otid();
    const bf16* q = (const bf16*)(p.ws + WS_Q); const bf16* Kb = (const bf16*)(p.ws + WS_KB); const bf16* Vb = (const bf16*)(p.ws + WS_VB); bf16* abp = (bf16*)(p.ws + WS_ABP);
#if MLA_V2
    const mla::CvtSide side{p.in[I_WGATE] + (size_t)l * NE * D * FF, (long)(p.in[I_WUP] - p.in[I_WGATE]), (long)(p.in[I_WDOWN] - p.in[I_WGATE]), (unsigned char*)wl_ptr(p, l, WL_GU), (unsigned char*)wl_ptr(p, l, WL_DN), (gridDim.x == 256) ? 1 : 0};
    for (int u = blockIdx.x; u < 256; u += gridDim.x) { const int hd = u & 7, jj = u >> 3, b = jj >> 4, row0 = b * SEQ + (jj & 15) * 512;
        mla::attn_unit2(q + (size_t)row0 * QW + hd * QKD, Kb + (size_t)b * NKEY * QW + hd * QKD, Vb + (size_t)b * NKEY * AW + hd * VD, abp + (size_t)row0 * D + hd * VD, NKEY, (char*)lds_, tid, side, u); }
    if (l == 0) for (int c = blockIdx.x; c < 16; c += gridDim.x) { const int b = c >> 3, hd = c & 7, row0 = TL + b * CTX;
        mla::attn_unit(q + (size_t)row0 * QW + hd * QKD, Kb + (size_t)b * NKEY * QW + hd * QKD, Vb + (size_t)b * NKEY * AW + hd * VD, abp + (size_t)row0 * D + hd * VD, CTX, (char*)lds_, tid); }
#else
    for (int u = blockIdx.x; u < 512 + (l == 0 ? 16 : 0); u += gridDim.x) {
        int b, hd, row0, nkeys;
        if (u < 512) { const int c = u & 255; b = u >> 8; hd = c & 7; row0 = b * SEQ + (c >> 3) * 256; nkeys = NKEY; }
        else { const int c = u - 512; b = c >> 3; hd = c & 7; row0 = TL + b * CTX; nkeys = CTX; }
        mla::attn_unit(q + (size_t)row0 * QW + hd * QKD, Kb + (size_t)b * NKEY * QW + hd * QKD, Vb + (size_t)b * NKEY * AW + hd * VD, abp + (size_t)row0 * D + hd * VD, nkeys, (char*)lds_, tid);
    }
#endif
}

namespace na {
using mla::bf16x8; using mla::s16x4; using mla::f32x16; using mla::u32x4;
constexpr int TILE_B = 65536;
constexpr int OFF_RPB = 2 * TILE_B, OFF_WS = OFF_RPB + (64 + 4 * 15 * 32 + 64) * 4, LDS_BYTES = OFF_WS + 8 * 64 * 4;
#define KSWZ64(row, colB) ((row) * 128 + ((colB) ^ (((row) & 7) << 4)))
__device__ __forceinline__ void qkt64(f32x16& p0, f32x16& p1, const char* Ks, const bf16x8* qr, int r32, int hi) {
    p0 = f32x16{}; p1 = f32x16{};
    bf16x8 kb0[4], kb1[4];
#pragma unroll
    for (int d0 = 0; d0 < 4; ++d0) { const int cb = (d0 * 16 + hi * 8) * 2;
        kb0[d0] = *reinterpret_cast<const bf16x8*>(Ks + KSWZ64(r32, cb)); kb1[d0] = *reinterpret_cast<const bf16x8*>(Ks + KSWZ64(32 + r32, cb)); }
    __builtin_amdgcn_sched_barrier(0);
#pragma unroll
    for (int d0 = 0; d0 < 4; ++d0) {
        p0 = __builtin_amdgcn_mfma_f32_32x32x16_bf16(kb0[d0], qr[d0], p0, 0, 0, 0);
        p1 = __builtin_amdgcn_mfma_f32_32x32x16_bf16(kb1[d0], qr[d0], p1, 0, 0, 0); }
}
__device__ __forceinline__ void na_unit(const Params& p, int l, int qrow0, bool lat, int b, int gr0, int hp, char* lds, int tid) {
    asm volatile("" : "+v"(tid));
    const bf16* z = (const bf16*)(p.ws + WS_Z); bf16* abp = (bf16*)(p.ws + WS_ABP);
    const int wid = __builtin_amdgcn_readfirstlane(tid >> 6), lane = tid & 63, r32 = lane & 31, hi = lane >> 5, hl = wid >> 2, rsel = (wid >> 1) & 1, qh = wid & 1, hd = hp * 2 + hl;
    float* rpbs = (float*)(lds + OFF_RPB); float* ws = (float*)(lds + OFF_WS) + wid * 64; float* li_l = ws; float* al_l = ws + 32;
    const int gr = gr0 + rsel;
    int sr0 = gr0 - 4; sr0 = sr0 < 0 ? 0 : (sr0 > 120 ? 120 : sr0);
    int sr1 = gr0 - 3; sr1 = sr1 < 0 ? 0 : (sr1 > 120 ? 120 : sr1);
    const int srw = rsel ? sr1 : sr0;
    const int ntile = lat ? 12 + (sr1 != sr0 ? 1 : 0) : 4;
    const int cq = qh * 32 + r32; int sc = cq - 8; sc = sc < 0 ? 0 : (sc > 48 ? 48 : sc);
    __syncthreads();
    bf16x8 qr[4];
    const int srow = tid >> 4, sch = tid & 15, shd = sch >> 3, sc8 = sch & 7;
    bf16x8 skA[2], svA[2], skB[2], svB[2];
#define TROW(j) ((lat && (j) >= 4) ? (b * SEQ + (sr0 + (j) - 4) * GW) : (TL + b * CTX + (j) * 64))
#define NLOAD(j, SK, SV) do { const bf16* g = z + (size_t)(TROW(j) + srow) * ZW + Z_NA + 256 + hp * 128 + sch * 8; _Pragma("unroll") for (int i = 0; i < 2; ++i) { SK[i] = *reinterpret_cast<const bf16x8*>(g + (size_t)(32 * i) * ZW); SV[i] = *reinterpret_cast<const bf16x8*>(g + (size_t)(32 * i) * ZW + 256); } } while (0)
#define NWRITE(bu, SK, SV) do { char* kb = lds + (bu) * TILE_B + shd * 8192; char* vb_ = kb + 16384; _Pragma("unroll") for (int i = 0; i < 2; ++i) { const int row = srow + 32 * i; \
        *(bf16x8*)(kb + KSWZ64(row, sc8 * 16)) = SK[i]; *(bf16x8*)(vb_ + mla::v_st(row, sc8 * 8)) = SV[i]; } } while (0)
    float m_reg = -1e30f, l_reg = 0; f32x16 o0 = {}, o1 = {};
    constexpr float C = 0.125f * 1.4426950408889634f;
    NLOAD(0, skA, svA); if (2 < ntile) NLOAD(2, skB, svB);
    { const float* rpb = p.in[I_RPB] + (size_t)l * 4 * 15 * 31; float tb[5];
#pragma unroll
      for (int q = 0; q < 5; ++q) { const int i = tid + q * NT, t_ = i - 64, c = t_ & 31; tb[q] = (t_ >= 0 && t_ < 4 * 15 * 32 && c < 31) ? rpb[(t_ >> 5) * 31 + c] : 0.f; }
      __builtin_amdgcn_sched_barrier(0);
#pragma unroll
      for (int q = 0; q < 5; ++q) { const int i = tid + q * NT; if (i < 64 + 4 * 15 * 32 + 64) rpbs[i] = tb[q]; } }
    { const bf16* Qw = z + (size_t)(qrow0 + rsel * 64 + cq) * ZW + Z_NA + hd * 64 + hi * 8;
#pragma unroll
      for (int d0 = 0; d0 < 4; ++d0) qr[d0] = *reinterpret_cast<const bf16x8*>(Qw + d0 * 16); }
    NWRITE(0, skA, svA); NLOAD(1, skA, svA); __syncthreads();
#define PK4(P, BASE, OUT) do { unsigned a0 = mla::cvtpk(P[BASE + 0], P[BASE + 1]), a1 = mla::cvtpk(P[BASE + 2], P[BASE + 3]);   \
    unsigned b0 = mla::cvtpk(P[BASE + 4], P[BASE + 5]), b1 = mla::cvtpk(P[BASE + 6], P[BASE + 7]);                              \
    auto r0 = __builtin_amdgcn_permlane32_swap(a0, b0, false, false); auto r1 = __builtin_amdgcn_permlane32_swap(a1, b1, false, false); \
    u32x4 w = {r0[0], r1[0], r0[1], r1[1]}; OUT = *reinterpret_cast<bf16x8*>(&w); } while (0)
#define NA_TILE(j, SK, SV) do { \
        const int krow = sr0 + (j) - 4;                                            \
        if (!(lat && (j) >= 4) || (krow >= srw && krow < srw + 8)) { \
        const char* Kt = lds + ((j) & 1) * TILE_B + hl * 8192; const int vb = (int)(uintptr_t)(lds + ((j) & 1) * TILE_B + 16384 + hl * 8192) + mla::v_rd_base(lane); \
        f32x16 p0, p1; qkt64(p0, p1, Kt, qr, r32, hi); \
        if (lat && (j) >= 4) { const float* brow = rpbs + 64 + (hd * 15 + (krow - gr + 7)) * 32 + (4 * hi - cq + 15); const int vb2 = 4 * hi - sc; \
            float bb0[16], bb1[16];                                                  \
_Pragma("unroll") \
            for (int r = 0; r < 16; ++r) { const int k0 = (r & 3) + 8 * (r >> 2); bb0[r] = brow[k0]; bb1[r] = brow[k0 + 32]; } \
            __builtin_amdgcn_sched_barrier(0); \
_Pragma("unroll") \
            for (int r = 0; r < 16; ++r) { const int k0 = (r & 3) + 8 * (r >> 2); \
                p0[r] = ((unsigned)(vb2 + k0) < 16u) ? p0[r] + 8.f * bb0[r] : -1e30f; p1[r] = ((unsigned)(vb2 + k0 + 32) < 16u) ? p1[r] + 8.f * bb1[r] : -1e30f; } } \
        float pmax = p0[0]; \
_Pragma("unroll") \
        for (int r = 1; r < 16; ++r) pmax = fmaxf(pmax, p0[r]); \
_Pragma("unroll") \
        for (int r = 0; r < 16; ++r) pmax = fmaxf(pmax, p1[r]); \
        { auto rr = __builtin_amdgcn_permlane32_swap(__float_as_uint(pmax), __float_as_uint(pmax), false, false); pmax = fmaxf(__uint_as_float(rr[0]), __uint_as_float(rr[1])); } \
        const float mn = fmaxf(m_reg, pmax), alpha = __builtin_amdgcn_exp2f((m_reg - mn) * C); m_reg = mn; const float mnC = -mn * C; \
        float ps = 0.f; \
_Pragma("unroll") \
        for (int r = 0; r < 16; ++r) { p0[r] = __builtin_amdgcn_exp2f(fmaf(p0[r], C, mnC)); p1[r] = __builtin_amdgcn_exp2f(fmaf(p1[r], C, mnC)); ps += p0[r] + p1[r]; } \
        { auto rr = __builtin_amdgcn_permlane32_swap(__float_as_uint(ps), __float_as_uint(ps), false, false); ps = __uint_as_float(rr[0]) + __uint_as_float(rr[1]); } \
        l_reg = l_reg * alpha + ps; \
        if (hi == 0) al_l[r32] = alpha; asm volatile("s_waitcnt lgkmcnt(0)" ::: "memory"); \
_Pragma("unroll") \
        for (int r = 0; r < 16; ++r) { const float f = al_l[mla::crow(r, hi)]; o0[r] *= f; o1[r] *= f; } \
        mla::bf16x8 pa0, pa1, pa2, pa3; \
        PK4(p0, 0, pa0); PK4(p0, 8, pa1); PK4(p1, 0, pa2); PK4(p1, 8, pa3); \
        mla::pv_d0(o0, o1, vb, pa0, pa1, pa2, pa3); } \
        if ((j) + 1 < ntile) { NWRITE(((j) + 1) & 1, SK, SV); if ((j) + 3 < ntile) NLOAD((j) + 3, SK, SV); } \
        __syncthreads(); } while (0)
    for (int j = 0; j < ntile; j += 2) { NA_TILE(j, skA, svA); if (j + 1 < ntile) NA_TILE(j + 1, skB, svB); }
#undef NA_TILE
#undef PK4
    if (hi == 0) li_l[r32] = l_reg; asm volatile("s_waitcnt lgkmcnt(0)" ::: "memory");
#pragma unroll
    for (int r = 0; r < 16; ++r) { const float rl = __builtin_amdgcn_rcpf(li_l[mla::crow(r, hi)]); o0[r] *= rl; o1[r] *= rl; }
    mla::store_tile_rows(lds + wid * 4608, o0, o1, abp + (size_t)(qrow0 + rsel * 64 + qh * 32) * D + 512 + hd * 64, D, lane);
#undef TROW
#undef NLOAD
#undef NWRITE
}
#undef KSWZ64
}
__device__ __forceinline__ void ph_na_fast(const Params& p, int l, unsigned char* lds_) {
    const int tid = otid();
    for (int u = blockIdx.x; u < 256; u += gridDim.x) {
        const int v = (gridDim.x == 256) ? (u & 7) * 32 + (u >> 3) : u, hp = v & 1, rp = (v >> 1) & 63, b = v >> 7;
        na::na_unit(p, l, b * SEQ + rp * 2 * GW, true, b, rp * 2, hp, (char*)lds_, tid);
    }
    if (l == 0) {
        const int first = gridDim.x >= 24 ? 16 : 0;
        for (int c = (int)blockIdx.x - first; c >= 0 && c < 8; c += gridDim.x) { const int b = c >> 2; na::na_unit(p, l, TL + b * CTX + ((c >> 1) & 1) * 128, false, b, 0, c & 1, (char*)lds_, tid); }
    }
}
__device__ __forceinline__ void ph_pool_fast(const Params& p, int l, unsigned char* lds_) {
    const int tid = otid();
    using mla::bf16x8; using mla::f32x16;
    const bf16* z = (const bf16*)(p.ws + WS_Z); bf16* abp = (bf16*)(p.ws + WS_ABP); const bf16* wpt = wl_ptr(p, l, WL_POOL); const float* ps = p.in[I_PSCALE] + l * PW;
    const int lane = tid & 63, r32 = lane & 31, hi = lane >> 5;
    const int nrow = (l == DEPTH - 1) ? TL : T;
    for (int it = GWAVE; it < (nrow / 32) * 4; it += GNW) {
        const int g = it & 3, row0 = (it >> 2) * 32, w = 2 << g, row = row0 + r32;
        int base, n, t; if (row < TL) { base = row & ~8191; n = SEQ; t = row & 8191; } else { base = TL + ((row - TL) & ~255); n = CTX; t = (row - TL) & 255; }
        int lo = t - w / 2; lo = lo < 0 ? 0 : lo; int hi_ = t + w / 2; hi_ = hi_ > n ? n : hi_;
        const float invn = 1.f / (float)(hi_ - lo);
        f32x16 acc0 = {}, acc1 = {};
        float a8[4][8];
#pragma unroll
        for (int s4 = 0; s4 < 4; ++s4)
#pragma unroll
            for (int j = 0; j < 8; ++j) a8[s4][j] = 0.f;
        const bf16* zc = z + Z_POOL + g * 64 + 8 * hi;
        for (int i = 0; i < w; i += 2) {
            const int ta = t - w / 2 + i, tb = ta + 1;
            const float fa = (ta >= 0 && ta < n) ? 1.f : 0.f, fb = (tb >= 0 && tb < n) ? 1.f : 0.f;
            const int tac = ta < 0 ? 0 : (ta >= n ? n - 1 : ta), tbc = tb < 0 ? 0 : (tb >= n ? n - 1 : tb);
            uint4 va[4], vb[4];
#pragma unroll
            for (int s4 = 0; s4 < 4; ++s4) { va[s4] = *(const uint4*)(zc + (size_t)(base + tac) * ZW + 16 * s4); vb[s4] = *(const uint4*)(zc + (size_t)(base + tbc) * ZW + 16 * s4); }
#pragma unroll
            for (int s4 = 0; s4 < 4; ++s4) { const unsigned xa_[4] = {va[s4].x, va[s4].y, va[s4].z, va[s4].w}, xb_[4] = {vb[s4].x, vb[s4].y, vb[s4].z, vb[s4].w};
#pragma unroll
                for (int j = 0; j < 4; ++j) { a8[s4][2 * j] += fa * __uint_as_float(xa_[j] << 16) + fb * __uint_as_float(xb_[j] << 16); a8[s4][2 * j + 1] += fa * __uint_as_float(xa_[j] & 0xffff0000u) + fb * __uint_as_float(xb_[j] & 0xffff0000u); } }
        }
#pragma unroll
        for (int s4 = 0; s4 < 4; ++s4) {
            const uint4 ov = *(const uint4*)(zc + (size_t)row * ZW + 16 * s4); const unsigned oo[4] = {ov.x, ov.y, ov.z, ov.w};
            mla::u32x4 aw;
#pragma unroll
            for (int j = 0; j < 4; ++j) aw[j] = mla::cvtpk(a8[s4][2 * j] * invn - __uint_as_float(oo[j] << 16), a8[s4][2 * j + 1] * invn - __uint_as_float(oo[j] & 0xffff0000u));
            const bf16x8 af = *reinterpret_cast<bf16x8*>(&aw);
            const bf16x8 b0 = *reinterpret_cast<const bf16x8*>(wpt + (size_t)(g * 64 + r32) * 64 + 16 * s4 + 8 * hi), b1 = *reinterpret_cast<const bf16x8*>(wpt + (size_t)(g * 64 + 32 + r32) * 64 + 16 * s4 + 8 * hi);
            acc0 = __builtin_amdgcn_mfma_f32_32x32x16_bf16(af, b0, acc0, 0, 0, 0);
            acc1 = __builtin_amdgcn_mfma_f32_32x32x16_bf16(af, b1, acc1, 0, 0, 0);
        }
        const float s0 = ps[g * 64 + r32], s1 = ps[g * 64 + 32 + r32];
        acc0 = acc0 * s0; acc1 = acc1 * s1;
        mla::store_tile_rows((char*)lds_ + (tid >> 6) * 4608, acc0, acc1, abp + (size_t)row0 * D + 768 + g * 64, D, lane);
    }
}


#define XB_TMO      128
#define XB_XCNT(j)  (256  + 64 * (j))
#define XB_XSUB(j)  (1280 + 64 * (j))
#define XB_XGEN(j)  (2304 + 64 * (j))
#define XB_TOP      3328
#define XB_TOPGEN   3392
#define XCD_BAR_WORDS 3456
#define XB_SPIN_CAP (1u << 18)
__device__ __forceinline__ unsigned xb_ld(unsigned* p)              { return __hip_atomic_load(p, __ATOMIC_RELAXED, __HIP_MEMORY_SCOPE_AGENT); }
__device__ __forceinline__ unsigned xb_add(unsigned* p, unsigned v) { return __hip_atomic_fetch_add(p, v, __ATOMIC_RELAXED, __HIP_MEMORY_SCOPE_AGENT); }
__device__ __forceinline__ unsigned xb_xcc_id() { return (unsigned)__builtin_amdgcn_s_getreg((3 << 11) | 20) & 0xFu; }
#define XB_SPIN(cond, bar) do { unsigned _sp = 0; while (cond) { __builtin_amdgcn_s_sleep(1); \
    if ((++_sp & 255u) == 0u) { if (xb_ld(&(bar)[XB_TMO])) break; if (_sp > XB_SPIN_CAP) { atomicAdd(&(bar)[XB_TMO], 1u); break; } } } } while (0)
struct XcdBarrier { unsigned* bar; unsigned x; volatile LAS unsigned* st; };
__device__ __forceinline__ XcdBarrier xcd_barrier_post(unsigned* bar, volatile LAS unsigned* st) {
    XcdBarrier b; b.bar = bar; b.x = xb_xcc_id(); b.st = st;
    if (threadIdx.x == 0) (void)xb_add(&bar[XB_XCNT(b.x)], 1u);
    return b;
}
__device__ __forceinline__ void xcd_barrier_complete(unsigned* bar, unsigned x, unsigned& nloc, unsigned& nx) {
    const unsigned G = gridDim.x * gridDim.y * gridDim.z;
    unsigned sum, cnt, mine, sp = 0u;
    for (;;) {
        sum = 0u; cnt = 0u; mine = 0u;
#pragma unroll
        for (unsigned j = 0; j < 16; ++j) { const unsigned c = xb_ld(&bar[XB_XCNT(j)]); sum += c; cnt += (c > 0u) ? 1u : 0u; mine = (j == x) ? c : mine; }
        if (sum == G) break;
        __builtin_amdgcn_s_sleep(1);
        if ((++sp & 255u) == 0u) { if (xb_ld(&bar[XB_TMO])) break; if (sp > XB_SPIN_CAP) { atomicAdd(&bar[XB_TMO], 1u); break; } }
    }
    nloc = mine > 0u ? mine : 1u; nx = cnt > 0u ? cnt : 1u;
}
__device__ __forceinline__ void xcd_barrier(const XcdBarrier& b) {
    asm volatile("s_waitcnt vmcnt(0)" ::: "memory");
    __syncthreads();
    if (threadIdx.x == 0) {
        unsigned* bar = b.bar;
        __builtin_amdgcn_s_waitcnt(0);
        unsigned nloc = b.st[0], nx = b.st[1];
        if (nloc == 0u) { xcd_barrier_complete(bar, b.x, nloc, nx); b.st[0] = nloc; b.st[1] = nx; }
        const unsigned old = xb_add(&bar[XB_XSUB(b.x)], 1u);
        const unsigned gen = old / nloc;
        if (old + 1u == (gen + 1u) * nloc) {
            __builtin_amdgcn_fence(__ATOMIC_RELEASE, "agent");
            asm volatile("s_waitcnt vmcnt(0)" ::: "memory");
            const unsigned og = xb_add(&bar[XB_TOP], 1u);
            const unsigned tg = og / nx;
            if (og + 1u == (tg + 1u) * nx) xb_add(&bar[XB_TOPGEN], 1u);
            else XB_SPIN(xb_ld(&bar[XB_TOPGEN]) == tg, bar);
            __builtin_amdgcn_fence(__ATOMIC_ACQUIRE, "agent");
            xb_add(&bar[XB_XGEN(b.x)], 1u);
            asm volatile("s_waitcnt vmcnt(0)" ::: "memory");
        } else {
            XB_SPIN(xb_ld(&bar[XB_XGEN(b.x)]) == gen, bar);
            __builtin_amdgcn_fence(__ATOMIC_ACQUIRE, "agent");
            asm volatile("s_waitcnt vmcnt(0)" ::: "memory");
        }
    }
    __syncthreads();
}

#ifndef FAST_INPROJ
#define FAST_INPROJ 1
#endif
#ifndef FAST_MLAPROJ
#define FAST_MLAPROJ 1
#endif
#ifndef FAST_MERGE
#define FAST_MERGE 1
#endif
#ifndef FAST_OUTPROJ
#define FAST_OUTPROJ 1
#endif
#ifndef FAST_MOEUP
#define FAST_MOEUP 1
#endif
#ifndef FAST_MOEDOWN
#define FAST_MOEDOWN 1
#endif
#ifndef FAST_MLA
#define FAST_MLA 1
#endif
#ifndef MLA_V2
#define MLA_V2 1
#endif
#ifndef FAST_NA
#define FAST_NA 1
#endif
#ifndef FAST_POOL
#define FAST_POOL 1
#endif
#ifndef PROBE_PHASE
#define PROBE_PHASE -1
#endif
#ifndef PROBE_N
#define PROBE_N 1
#endif
constexpr int LDS_BYTES = 147456;
__global__ void __launch_bounds__(NT) mega(Params p) {
    extern __shared__ __attribute__((aligned(16))) unsigned char lds[];
    cg::grid_group grid = cg::this_grid();
    { volatile LAS unsigned* st = (volatile LAS unsigned*)((LAS unsigned char*)lds + LDS_BYTES - 16); if (threadIdx.x < 4) st[threadIdx.x] = 0u; }
    __syncthreads();
    const XcdBarrier xbar = xcd_barrier_post((unsigned*)(p.ws + WS_CTL), (volatile LAS unsigned*)((LAS unsigned char*)lds + LDS_BYTES - 16));
#define GSYNC() xcd_barrier(xbar)
#define REPS(k) (1 + ((PROBE_PHASE == (k)) ? PROBE_N : 0))
    for (int rep = 0; rep < REPS(0); ++rep) {
        ph_mod(p, lds);
        if (gridDim.x != 256) grid.sync(); else GSYNC();
        ph_h1(p, 0);
        { const int tid = otid(); ph_cvt(p, lds, 0, gridDim.x == 256 ? CVT_PER_LAYER : 2 * CVT_PER_LAYER, GWAVE, GNW); }
        GSYNC();
    }
    for (int rep = 0; rep < REPS(10) - 1; ++rep) { GSYNC(); GSYNC(); GSYNC(); GSYNC(); GSYNC(); GSYNC(); GSYNC(); GSYNC(); GSYNC(); GSYNC(); }
    for (int l = 0; l < DEPTH; ++l) {
        for (int rep = 0; rep < REPS(1); ++rep) { ph_inproj_fast(p, l, lds); GSYNC(); }
        for (int rep = 0; rep < REPS(2); ++rep) { ph_mlaproj_fast(p, l, lds); GSYNC(); }
        for (int rep = 0; rep < REPS(3); ++rep) {
            for (int r2 = 0; r2 < REPS(11); ++r2) ph_mla_fast(p, l, lds);
            for (int r2 = 0; r2 < REPS(12); ++r2) ph_na_fast(p, l, lds);
            for (int r2 = 0; r2 < REPS(13); ++r2) ph_pool_fast(p, l, lds);
            GSYNC();
        }
        for (int rep = 0; rep < REPS(4); ++rep) { ph_merge_fast(p, l, lds); GSYNC(); }
        ph_outproj_fast(p, l, lds);
        GSYNC();
        for (int rep = 0; rep < REPS(6); ++rep) { ph_h2router(p, l, lds); GSYNC(); }
        for (int rep = 0; rep < REPS(7); ++rep) { ph_topk(p, lds);
            if (l == 0 && gridDim.x == 256 && blockIdx.x >= 64) { const int tid = otid(); ph_cvt(p, lds, CVT_PER_LAYER, 2 * CVT_PER_LAYER, (oblk() - 64) * (NT / 64) + (tid >> 6), 192 * (NT / 64)); }
            GSYNC(); }
        for (int rep = 0; rep < REPS(8); ++rep) { ph_moeup_fast(p, l, lds); GSYNC(); }
        for (int rep = 0; rep < REPS(9); ++rep) { ph_moedown_fast(p, l, lds); GSYNC(); }
        ph_combine(p, l);
        GSYNC();
    }
}

extern "C" void kernel_launch(void* const* d_in, const int* in_sizes, int n_in, void* d_out, int out_size, void* d_ws, size_t ws_size, hipStream_t stream) {
    static int grid_blocks = 0;
    if (grid_blocks == 0) {
        if (n_in != 25 || ws_size < WS_END) { fprintf(stderr, "kernel_launch: n_in %d ws %zu (need %zu)\n", n_in, ws_size, (size_t)WS_END); grid_blocks = -1; return; }
        int dev = 0, cus = 0, per_cu = 0;
        (void)hipGetDevice(&dev);
        (void)hipDeviceGetAttribute(&cus, hipDeviceAttributeMultiprocessorCount, dev);
        if (hipFuncSetAttribute((const void*)mega, hipFuncAttributeMaxDynamicSharedMemorySize, LDS_BYTES) != hipSuccess) { fprintf(stderr, "kernel_launch: hipFuncSetAttribute failed\n"); grid_blocks = -1; return; }
        (void)hipOccupancyMaxActiveBlocksPerMultiprocessor(&per_cu, (const void*)mega, NT, LDS_BYTES);
        if (per_cu < 1) { fprintf(stderr, "kernel_launch: occupancy query says %d\n", per_cu); grid_blocks = -1; return; }
        grid_blocks = cus;
    }
    if (grid_blocks < 0) return;
    if (hipMemsetAsync((char*)d_ws + WS_CTL, 0, CTL_BYTES, stream) != hipSuccess) { fprintf(stderr, "kernel_launch: memset failed\n"); return; }
    Params p{};
    for (int i = 0; i < 25; ++i) p.in[i] = (const float*)d_in[i];
    p.out = (float*)d_out; p.ws = (unsigned char*)d_ws;
    void* args[] = {&p};
    hipError_t e = hipLaunchCooperativeKernel((const void*)mega, dim3(grid_blocks), dim3(NT), args, LDS_BYTES, stream);
    if (e != hipSuccess) fprintf(stderr, "cooperative launch failed: %s (grid %d)\n", hipGetErrorString(e), grid_blocks);
}
```
